# Optimizing an MI355X kernel written in HIP

```python
import math
import jax, jax.numpy as jnp
from jax import lax
import numpy as np

D_MODEL = 1024
BATCH = 8
SEQ = 2048
DEPTH = 2
DEC_BATCH = 16
DEC_SEQ = 16
PAST_LEN = 4096

CHUNK = 64
N_EVEN = (DEPTH + 1) // 2
N_ODD = DEPTH // 2
H_A = 4
DK_A = 64
DV_A = 128
R_A = 16
GATE_NORM_A = 16.0
A_QK = H_A * DK_A
A_V = H_A * DV_A
H_B = 8
D_B = 64
B_W = H_B * D_B
BAND_CHUNKS = 8
WIN_B = BAND_CHUNKS * CHUNK
MAX_REL = 128
H_C = 16
D_C = 64
C_W = H_C * D_C
Q_BLOCK = 128
FOX_BIAS_INIT = 2.0
D_FF = 2816
EPS = 1e-6
E_IN = 2 * A_QK + 2 * A_V + R_A + 3 * B_W
O_IN = 3 * C_W + H_C

kernel_name = "hybrid_streaming_gla_band_fox_macaron"


def rmsnorm(x, g):
    xf = x.astype(jnp.float32)
    y = xf * lax.rsqrt(jnp.mean(xf * xf, axis=-1, keepdims=True) + EPS)
    return (y * g.astype(jnp.float32)).astype(x.dtype)


def swiglu(x, w_gu, w_down):
    g, u = jnp.split(x @ w_gu, 2, axis=-1)
    return (jax.nn.silu(g) * u) @ w_down


def split_cols(h, sizes):
    idx = np.cumsum(sizes)[:-1].tolist()
    return jnp.split(h, idx, axis=-1)


def gla_blocked(q, k, v, log_a, s0):
    B, T, H, _ = q.shape
    L = min(CHUNK, T)
    n = T // L
    f32 = jnp.float32

    def blk(t):
        return t.astype(f32).reshape(B, n, L, H, -1).transpose(1, 0, 3, 2, 4)

    qc, kc, vc, ac = blk(q), blk(k), blk(v), blk(log_a)
    bcum = jnp.cumsum(ac, axis=-2)
    b_last = bcum[..., -1:, :]
    q_in = qc * jnp.exp(bcum)
    k_in = kc * jnp.exp(-bcum)
    causal = np.tril(np.ones((L, L), dtype=bool))
    att = jnp.where(causal, jnp.einsum('nbhik,nbhjk->nbhij', q_in, k_in), 0.0)
    o_intra = jnp.einsum('nbhij,nbhjv->nbhiv', att, vc)
    k_state = kc * jnp.exp(b_last - bcum)
    a_total = jnp.exp(b_last[..., 0, :])

    def step(s, inp):
        qi, ks, vi, at = inp
        o = jnp.einsum('bhik,bhkv->bhiv', qi, s)
        s = at[..., None] * s + jnp.einsum('bhjk,bhjv->bhkv', ks, vi)
        return s, o

    s_fin, o_inter = lax.scan(step, s0.astype(f32), (q_in, k_state, vc, a_total))
    o = (o_intra + o_inter).transpose(1, 0, 3, 2, 4).reshape(B, T, H, -1)
    return o, s_fin


def band_attention_prompt(q, k, v, rel_bias):
    B, T, H, D = q.shape
    n = T // CHUNK
    P = BAND_CHUNKS
    pad = ((0, 0), (P * CHUNK, 0), (0, 0), (0, 0))
    kp = jnp.pad(k, pad).reshape(B, n + P, CHUNK, H, D)
    vp = jnp.pad(v, pad).reshape(B, n + P, CHUNK, H, D)
    kb = jnp.concatenate([kp[:, o:o + n] for o in range(P + 1)], axis=2)
    vb = jnp.concatenate([vp[:, o:o + n] for o in range(P + 1)], axis=2)
    qc = q.reshape(B, n, CHUNK, H, D)
    s = jnp.einsum('bnihd,bnjhd->bnhij', qc, kb).astype(jnp.float32) * (D ** -0.5)
    i = np.arange(CHUNK)[:, None]
    j = np.arange((P + 1) * CHUNK)[None, :]
    dist = i - (j - P * CHUNK)
    bias = rel_bias[:, np.clip(dist, -MAX_REL, MAX_REL) + MAX_REL].astype(jnp.float32)
    kpos = (np.arange(n)[:, None] - P) * CHUNK + j
    valid = (kpos >= 0)[None, :, None, None, :]
    s = jnp.where(valid, s + bias[None, None], -jnp.inf)
    p = jax.nn.softmax(s, axis=-1).astype(v.dtype)
    return jnp.einsum('bnhij,bnjhd->bnihd', p, vb).reshape(B, T, H * D)


def band_attention_sample(q, k, v, ck, cv, rel_bias):
    B, S, H, D = q.shape
    Lc = ck.shape[1]
    kk = jnp.concatenate([ck, k], axis=1)
    vv = jnp.concatenate([cv, v], axis=1)
    s = jnp.einsum('bihd,bjhd->bhij', q, kk).astype(jnp.float32) * (D ** -0.5)
    qpos = PAST_LEN + np.arange(S)
    kpos = np.concatenate([PAST_LEN - Lc + np.arange(Lc), PAST_LEN + np.arange(S)])
    dist = qpos[:, None] - kpos[None, :]
    bias = rel_bias[:, np.clip(dist, -MAX_REL, MAX_REL) + MAX_REL].astype(jnp.float32)
    p = jax.nn.softmax(s + bias[None], axis=-1).astype(vv.dtype)
    return jnp.einsum('bhij,bjhd->bihd', p, vv).reshape(B, S, H * D)


def fox_prompt(q, k, v, logf):
    B, T, H, D = q.shape
    nq = T // Q_BLOCK
    F = jnp.cumsum(logf, axis=1)
    Fk = F.transpose(0, 2, 1)[:, :, None, :]
    qb = q.reshape(B, nq, Q_BLOCK, H, D).transpose(1, 0, 2, 3, 4)
    Fb = F.reshape(B, nq, Q_BLOCK, H).transpose(1, 0, 3, 2)
    kpos = jnp.arange(T)

    def one(args):
        qi, Fi, bi = args
        s = jnp.einsum('bihd,bjhd->bhij', qi, k).astype(jnp.float32) * (D ** -0.5)
        s = s + Fi[..., :, None] - Fk
        qpos = bi * Q_BLOCK + jnp.arange(Q_BLOCK)
        s = jnp.where(qpos[:, None] >= kpos[None, :], s, -jnp.inf)
        p = jax.nn.softmax(s, axis=-1).astype(v.dtype)
        return jnp.einsum('bhij,bjhd->bihd', p, v)

    o = lax.map(one, (qb, Fb, jnp.arange(nq)))
    return o.transpose(1, 0, 2, 3, 4).reshape(B, T, H * D)


def fox_sample(q, k, v, logf, ck, cv, clogf):
    B, S, H, D = q.shape
    Lc = ck.shape[1]
    clogf = clogf.astype(jnp.float32)
    fq = jnp.cumsum(logf, axis=1)
    c_after = lax.cumsum(clogf, axis=1, reverse=True) - clogf
    fk = jnp.concatenate([-c_after, fq], axis=1)
    kk = jnp.concatenate([ck, k], axis=1)
    vv = jnp.concatenate([cv, v], axis=1)
    s = jnp.einsum('bihd,bjhd->bhij', q, kk).astype(jnp.float32) * (D ** -0.5)
    s = s + fq.transpose(0, 2, 1)[..., :, None] - fk.transpose(0, 2, 1)[..., None, :]
    valid = np.concatenate([np.ones((S, Lc), dtype=bool), np.tril(np.ones((S, S), dtype=bool))], axis=1)
    s = jnp.where(valid, s, -jnp.inf)
    p = jax.nn.softmax(s, axis=-1).astype(vv.dtype)
    return jnp.einsum('bhij,bjhd->bihd', p, vv).reshape(B, S, H * D)


def even_mixer(xn, w_in, w_alpha_up, b_alpha, gla_g, rel_bias, w_out, state):
    B, T, _ = xn.shape
    aq, ak, av, ag, ar, bq, bk, bv = split_cols(xn @ w_in, [A_QK, A_QK, A_V, A_V, R_A, B_W, B_W, B_W])
    q = aq.reshape(B, T, H_A, DK_A) * (DK_A ** -0.5)
    k = ak.reshape(B, T, H_A, DK_A)
    v = av.reshape(B, T, H_A, DV_A)
    log_a = (jax.nn.log_sigmoid((ar @ w_alpha_up + b_alpha).astype(jnp.float32)) / GATE_NORM_A).reshape(B, T, H_A, DK_A)
    s0 = jnp.zeros((B, H_A, DK_A, DV_A), jnp.float32) if state is None else state[0]
    o_a, s_fin = gla_blocked(q, k, v, log_a, s0)
    o_a = rmsnorm(o_a, gla_g).reshape(B, T, A_V).astype(xn.dtype) * jax.nn.silu(ag)
    qb = bq.reshape(B, T, H_B, D_B)
    kb = bk.reshape(B, T, H_B, D_B)
    vb = bv.reshape(B, T, H_B, D_B)
    if state is None:
        o_b = band_attention_prompt(qb, kb, vb, rel_bias)
        keep = min(WIN_B, T)
        nk, nv = kb[:, T - keep:], vb[:, T - keep:]
    else:
        o_b = band_attention_sample(qb, kb, vb, state[1], state[2], rel_bias)
        nk, nv = kb, vb
    y = jnp.concatenate([o_a, o_b], axis=-1) @ w_out
    return y, (s_fin, nk, nv)


def odd_mixer(xn, w_in, b_f, w_out, state):
    B, T, _ = xn.shape
    cq, ck, cv, cf = split_cols(xn @ w_in, [C_W, C_W, C_W, H_C])
    q = cq.reshape(B, T, H_C, D_C)
    k = ck.reshape(B, T, H_C, D_C)
    v = cv.reshape(B, T, H_C, D_C)
    logf = jax.nn.log_sigmoid((cf + b_f).astype(jnp.float32))
    if state is None:
        o = fox_prompt(q, k, v, logf)
    else:
        o = fox_sample(q, k, v, logf, state[0], state[1], state[2])
    return o @ w_out, (k, v, logf)


def trunk(x, layer_states, norm_g, ffn_w_gu, ffn_w_down, even_w_in, gla_w_alpha_up, gla_b_alpha,
          gla_norm_g, band_rel_bias, even_w_out, odd_w_in, fox_b_f, odd_w_out, final_norm_g):
    new_states = []
    for l in range(DEPTH):
        x = x + 0.5 * swiglu(rmsnorm(x, norm_g[l, 0]), ffn_w_gu[l, 0], ffn_w_down[l, 0])
        xn = rmsnorm(x, norm_g[l, 1])
        st = None if layer_states is None else layer_states[l]
        i = l // 2
        if l % 2 == 0:
            y, ns = even_mixer(xn, even_w_in[i], gla_w_alpha_up[i], gla_b_alpha[i], gla_norm_g[i],
                               band_rel_bias[i], even_w_out[i], st)
        else:
            y, ns = odd_mixer(xn, odd_w_in[i], fox_b_f[i], odd_w_out[i], st)
        x = x + y
        x = x + 0.5 * swiglu(rmsnorm(x, norm_g[l, 2]), ffn_w_gu[l, 1], ffn_w_down[l, 1])
        new_states.append(ns)
    return rmsnorm(x, final_norm_g), new_states


def setup_inputs(seed: int = 0) -> dict:
    key = jax.random.key(seed)
    ks = iter(jax.random.split(key, 32))

    def nrm(shape, scale):
        return jax.random.normal(next(ks), shape, jnp.float32) * scale

    lb = min(WIN_B, PAST_LEN)
    return {
        "x_prompt": nrm((BATCH, SEQ, D_MODEL), 1.0),
        "x_sample": nrm((DEC_BATCH, DEC_SEQ, D_MODEL), 1.0),
        "state_gla": nrm((N_EVEN, DEC_BATCH, H_A, DK_A, DV_A), 0.5),
        "cache_band_k": nrm((N_EVEN, DEC_BATCH, lb, H_B, D_B), 1.0),
        "cache_band_v": nrm((N_EVEN, DEC_BATCH, lb, H_B, D_B), 1.0),
        "cache_fox_k": nrm((N_ODD, DEC_BATCH, PAST_LEN, H_C, D_C), 1.0),
        "cache_fox_v": nrm((N_ODD, DEC_BATCH, PAST_LEN, H_C, D_C), 1.0),
        "cache_fox_logf": jax.nn.log_sigmoid(FOX_BIAS_INIT + nrm((N_ODD, DEC_BATCH, PAST_LEN, H_C), 1.0)),
        "norm_g": 1.0 + nrm((DEPTH, 3, D_MODEL), 0.05),
        "ffn_w_gu": nrm((DEPTH, 2, D_MODEL, 2 * D_FF), D_MODEL ** -0.5),
        "ffn_w_down": nrm((DEPTH, 2, D_FF, D_MODEL), D_FF ** -0.5),
        "even_w_in": nrm((N_EVEN, D_MODEL, E_IN), D_MODEL ** -0.5),
        "gla_w_alpha_up": nrm((N_EVEN, R_A, A_QK), R_A ** -0.5),
        "gla_b_alpha": nrm((N_EVEN, A_QK), 0.1),
        "gla_norm_g": 1.0 + nrm((N_EVEN, DV_A), 0.05),
        "band_rel_bias": nrm((N_EVEN, H_B, 2 * MAX_REL + 1), 0.5),
        "even_w_out": nrm((N_EVEN, A_V + B_W, D_MODEL), (A_V + B_W) ** -0.5),
        "odd_w_in": nrm((N_ODD, D_MODEL, O_IN), D_MODEL ** -0.5),
        "fox_b_f": FOX_BIAS_INIT + nrm((N_ODD, H_C), 0.1),
        "odd_w_out": nrm((N_ODD, C_W, D_MODEL), C_W ** -0.5),
        "final_norm_g": 1.0 + nrm((D_MODEL,), 0.05),
    }


def reference(x_prompt, x_sample, state_gla, cache_band_k, cache_band_v, cache_fox_k, cache_fox_v,
              cache_fox_logf, norm_g, ffn_w_gu, ffn_w_down, even_w_in, gla_w_alpha_up, gla_b_alpha,
              gla_norm_g, band_rel_bias, even_w_out, odd_w_in, fox_b_f, odd_w_out, final_norm_g):
    weights = (norm_g, ffn_w_gu, ffn_w_down, even_w_in, gla_w_alpha_up, gla_b_alpha, gla_norm_g,
               band_rel_bias, even_w_out, odd_w_in, fox_b_f, odd_w_out, final_norm_g)
    sample_states = []
    for l in range(DEPTH):
        i = l // 2
        if l % 2 == 0:
            sample_states.append((state_gla[i], cache_band_k[i], cache_band_v[i]))
        else:
            sample_states.append((cache_fox_k[i], cache_fox_v[i], cache_fox_logf[i]))
    y_prompt, ns_p = trunk(x_prompt, None, *weights)
    y_sample, ns_s = trunk(x_sample, sample_states, *weights)
    ev = range(0, DEPTH, 2)
    od = range(1, DEPTH, 2)
    p_state_gla = jnp.stack([ns_p[l][0] for l in ev])
    p_band_k = jnp.stack([ns_p[l][1] for l in ev])
    p_band_v = jnp.stack([ns_p[l][2] for l in ev])
    p_fox_k = jnp.stack([ns_p[l][0] for l in od])
    p_fox_v = jnp.stack([ns_p[l][1] for l in od])
    p_fox_logf = jnp.stack([ns_p[l][2] for l in od])
    s_state_gla = jnp.stack([ns_s[l][0] for l in ev])
    s_band_k = jnp.stack([ns_s[l][1] for l in ev])
    s_band_v = jnp.stack([ns_s[l][2] for l in ev])
    s_fox_k = jnp.stack([ns_s[l][0] for l in od])
    s_fox_v = jnp.stack([ns_s[l][1] for l in od])
    s_fox_logf = jnp.stack([ns_s[l][2] for l in od])
    return (y_prompt, y_sample, p_state_gla, p_band_k, p_band_v, p_fox_k, p_fox_v, p_fox_logf,
            s_state_gla, s_band_k, s_band_v, s_fox_k, s_fox_v, s_fox_logf)
```

```cpp
#include <hip/hip_runtime.h>
#include <hip/hip_cooperative_groups.h>
#include <cstdio>
#include <cstdint>
namespace cg = cooperative_groups;

constexpr int DM = 1024, TSEQ = 2048, NBATCH = 8, SBATCH = 16, SSEQ = 16, PAST = 4096, FF = 2816;
constexpr int MP = NBATCH * TSEQ;
constexpr int MS = SBATCH * SSEQ;
constexpr int MT = MP + MS;
constexpr int NIN = 3328;
constexpr float LOG2E = 1.4426950408889634f;
constexpr float QSCALE2 = 0.125f * LOG2E;
constexpr float EPS = 1e-6f;

constexpr size_t O_YP = 0, O_YS = O_YP + (size_t)MP * DM, O_PSG = O_YS + (size_t)MS * DM, O_PBK = O_PSG + 8 * 4 * 64 * 128, O_PBV = O_PBK + 8 * 512 * 512,
                 O_PFK = O_PBV + 8 * 512 * 512, O_PFV = O_PFK + (size_t)MP * 1024, O_PFL = O_PFV + (size_t)MP * 1024, O_SSG = O_PFL + (size_t)MP * 16,
                 O_SBK = O_SSG + 16 * 4 * 64 * 128, O_SBV = O_SBK + (size_t)MS * 512, O_SFK = O_SBV + (size_t)MS * 512, O_SFV = O_SFK + (size_t)MS * 1024,
                 O_SFL = O_SFV + (size_t)MS * 1024, O_END = O_SFL + (size_t)MS * 16;
constexpr size_t MiB = 1u << 20;
constexpr size_t WS_WGU = 2 * MiB, SZ_WGU = (size_t)2 * FF * DM * 2;
constexpr size_t WS_WDN = 46 * MiB, SZ_WDN = (size_t)DM * FF * 2;
constexpr size_t WS_WIN = 68 * MiB, SZ_WIN = (size_t)NIN * DM * 2;
constexpr size_t WS_WOUT = 81 * MiB, SZ_WOUT = (size_t)DM * DM * 2;
constexpr size_t WS_X = 96 * MiB;
constexpr size_t WS_XB = 161 * MiB;
constexpr size_t WS_H = 194 * MiB;
constexpr size_t WS_EB = 284 * MiB;
constexpr size_t WS_OAB = 390 * MiB;
constexpr size_t WS_LOGA = 423 * MiB;
constexpr size_t WS_LOGF = 440 * MiB;
constexpr size_t WS_PART = 442 * MiB, SZ_PART = (size_t)MT * 4;
constexpr size_t WS_GU = 450 * MiB;
constexpr size_t WS_GA = 482 * MiB;
constexpr size_t WS_QIN = 484 * MiB, WS_KIN = 492 * MiB;
constexpr size_t WS_GT = 500 * MiB;
constexpr size_t WS_GAG = 508 * MiB;
constexpr size_t WS_END = 510 * MiB;
static_assert(WS_WGU + 4 * SZ_WGU <= WS_WDN && WS_WDN + 4 * SZ_WDN <= WS_WIN && WS_WIN + 2 * SZ_WIN <= WS_WOUT && WS_WOUT + 2 * SZ_WOUT <= WS_X, "ws map 1");
static_assert(WS_X + (size_t)MT * DM * 4 <= WS_XB && WS_XB + (size_t)MT * DM * 2 <= WS_H && WS_H + (size_t)MT * FF * 2 <= WS_EB && WS_EB + (size_t)MT * NIN * 2 <= WS_OAB, "ws map 2");
static_assert(WS_OAB + (size_t)MT * DM * 2 <= WS_LOGA && WS_LOGA + (size_t)MT * 256 * 4 <= WS_LOGF && WS_LOGF + (size_t)MT * 16 * 4 <= WS_PART && WS_PART + 7 * SZ_PART <= WS_END, "ws map 3");

namespace pg8 {
#define PG8_LAS __attribute__((address_space(3)))
typedef unsigned short bf16_t;
typedef short bf16x8 __attribute__((ext_vector_type(8)));
typedef float f32x4 __attribute__((ext_vector_type(4)));
typedef unsigned u32x4 __attribute__((ext_vector_type(4)));
constexpr int BM = 256, BK = 64, HALF = 128, HTB = HALF * BK * 2  , STAGE_BYTES = 8 * HTB, NXCD = 8, WGM = 4;

__host__ __device__ __forceinline__ int lds_byte(int r, int c) { const int st = (r >> 4) * 2 + (c >> 5), rr = r & 15, cc = c & 31, ob = rr * 64 + cc * 2; return st * 1024 + (ob ^ (((ob >> 9) & 1) << 5)); }
__host__ __device__ __forceinline__ void stage_rc(int b, int& R, int& C) { const int st = b / 1024, sb = b % 1024, swz = sb ^ (((sb >> 9) & 1) << 5); R = (st >> 1) * 16 + swz / 64; C = (st & 1) * 32 + (swz % 64) / 2; }
__host__ __device__ __forceinline__ int perm32(int rho) { const int n = rho >> 4, i = rho & 15; return 8 * (i >> 2) + 4 * n + (i & 3); }

struct Unit { int pm, pn; };
struct Gemm { const bf16_t* A; const bf16_t* Bt; int M, N, K; };

struct StaticOrder {
    int nM, nN, nwg, G, c, mix;
    __host__ __device__ void init(int M, int N, int G_, int c_, int mix_ = 0) { nM = M / BM; nN = N / BM; nwg = nM * nN; G = G_; c = c_; mix = mix_; }
    __host__ __device__ bool next(int i, Unit& u) const {
        const long L = (long)i * G + c; if (L >= nwg) return false;
        int wgid = (int)L; { const int q = nwg / NXCD, r = nwg % NXCD, xcd = wgid % NXCD, off = wgid / NXCD; wgid = (xcd < r ? xcd * (q + 1) : r * (q + 1) + (xcd - r) * q) + off; }
        const int nig = WGM * nN, gid = wgid / nig, fm = gid * WGM, gsz = (nM - fm) < WGM ? (nM - fm) : WGM;
        u.pm = fm + ((wgid % nig) % gsz); u.pn = (wgid % nig) / gsz;
        if (mix == 1 && u.pn < 12) u.pn = (u.pn % 3) * 4 + u.pn / 3;
        if (mix == 2 && u.pn >= 6) ++u.pn;
        return true;
    }
    __device__ __forceinline__ void a_ready(const Unit&) const {}
    __device__ __forceinline__ void done(const Unit&) const {}
};

__device__ __forceinline__ unsigned cvt_pk_bf16(float lo, float hi) { unsigned r; asm volatile("v_cvt_pk_bf16_f32 %0, %1, %2" : "=v"(r) : "v"(lo), "v"(hi)); return r; }
typedef float f32x2 __attribute__((ext_vector_type(2)));
typedef float f32x2 __attribute__((ext_vector_type(2)));
typedef unsigned u32x2 __attribute__((ext_vector_type(2)));
__device__ __forceinline__ float row_rinv(const float* part, int row) { return __builtin_amdgcn_rsqf(part[row] * (1.0f / 1024.0f) + EPS); }
constexpr int PRE_LDS = 131072 + 2048;
struct PreRows { const PG8_LAS float* b; };
__device__ __forceinline__ void pre_rows_load(PreRows& p, const float* part, const Unit& u, int wr, int lane, PG8_LAS unsigned char* lds) {
    PG8_LAS unsigned char* dst = lds + PRE_LDS + wr * 512;
    __builtin_amdgcn_global_load_lds((const unsigned*)(part + u.pm * BM + wr * 64 + lane), (PG8_LAS unsigned*)dst, 4, 0, 0);
    __builtin_amdgcn_global_load_lds((const unsigned*)(part + u.pm * BM + HALF + wr * 64 + lane), (PG8_LAS unsigned*)(dst + 256), 4, 0, 0);
    p.b = (const PG8_LAS float*)dst;
}
__device__ __forceinline__ float pre_rinv(const PreRows& p, int ai, int m, int fr) {
    return __builtin_amdgcn_rsqf(p.b[ai * 64 + m * 16 + fr] * (1.0f / 1024.0f) + EPS);
}
struct PreNone {};
__device__ __forceinline__ float silu_f(float x) { return x * __builtin_amdgcn_rcpf(1.0f + __builtin_amdgcn_exp2f(-x * LOG2E)); }
__device__ __forceinline__ float logsigmoid_f(float x) { return fminf(x, 0.f) - __logf(1.0f + __expf(-fabsf(x))); }

__device__ __forceinline__ void st_wt16(void* p, const u32x4 v) { asm volatile("global_store_dwordx4 %0, %1, off sc0 sc1\n\ts_nop 1" :: "v"(p), "v"(v) : "memory"); }
__device__ __forceinline__ void st_wt16(void* p, const f32x4 v) { asm volatile("global_store_dwordx4 %0, %1, off sc0 sc1\n\ts_nop 1" :: "v"(p), "v"(v) : "memory"); }
__device__ __forceinline__ void st_wt8(void* p, const u32x2 v)  { asm volatile("global_store_dwordx2 %0, %1, off sc0 sc1" :: "v"(p), "v"(v) : "memory"); }
struct EpiGU {
    static constexpr bool PERM = true, AFTER_DRAIN = false;
    unsigned char* ws; int pin; PG8_LAS unsigned char* lds;
    typedef PreRows Pre;
    __device__ __forceinline__ void pre_load(Pre& p, const Unit& u, int wr, int lane) const { pre_rows_load(p, (const float*)(ws + WS_PART + (size_t)pin * SZ_PART), u, wr, lane, lds); }
    __device__ __forceinline__ void operator()(const f32x4 (&acc)[2][2][4][2], const Unit& u, int wr, int wc, int fr, int fq, const Pre& pre) const {
        bf16_t* H = (bf16_t*)(ws + WS_H); const float* part = (const float*)(ws + WS_PART + (size_t)pin * SZ_PART);
        const int col0 = u.pn * 128 + wc * 32 + 8 * fq;
        float rr[2][4];
#pragma unroll
        for (int ai = 0; ai < 2; ++ai)
#pragma unroll
            for (int m = 0; m < 4; ++m) rr[ai][m] = pre_rinv(pre, ai, m, fr);
#pragma unroll
        for (int ai = 0; ai < 2; ++ai)
#pragma unroll
            for (int m = 0; m < 4; ++m) {
                const int row = u.pm * BM + ai * HALF + wr * 64 + m * 16 + fr;
                const float r = rr[ai][m];
                u32x4 w;
#pragma unroll
                for (int n = 0; n < 2; ++n) {
                    const f32x4 g4 = acc[ai][0][m][n], u4 = acc[ai][1][m][n];
                    const float rl = -r * LOG2E;
                    f32x4 t4 = g4 * rl;
#pragma unroll
                    for (int i = 0; i < 4; ++i) t4[i] = __builtin_amdgcn_exp2f(t4[i]);
                    t4 = t4 + 1.0f;
#pragma unroll
                    for (int i = 0; i < 4; ++i) t4[i] = __builtin_amdgcn_rcpf(t4[i]);
                    const f32x4 h4 = (g4 * u4) * (t4 * (r * r));
                    if (n == 0) { w.x = cvt_pk_bf16(h4[0], h4[1]); w.y = cvt_pk_bf16(h4[2], h4[3]); } else { w.z = cvt_pk_bf16(h4[0], h4[1]); w.w = cvt_pk_bf16(h4[2], h4[3]); }
                }
                st_wt16(H + (size_t)row * FF + col0, w);
            }
    }
};
__device__ __forceinline__ f32x4 bf4_to_f32(const u32x2 w) {
    return (f32x4){__builtin_bit_cast(float, w.x << 16), __builtin_bit_cast(float, w.x & 0xffff0000u), __builtin_bit_cast(float, w.y << 16), __builtin_bit_cast(float, w.y & 0xffff0000u)};
}
struct EpiRes {
    static constexpr bool PERM = false, AFTER_DRAIN = false;
    unsigned char* ws; int pout; float coef;
    typedef PreNone Pre;
    __device__ __forceinline__ void pre_load(Pre&, const Unit&, int, int) const {}
    __device__ __forceinline__ void operator()(const f32x4 (&acc)[2][2][4][2], const Unit& u, int wr, int wc, int fr, int fq, const Pre&) const {
        bf16_t* XB = (bf16_t*)(ws + WS_XB); float* part_out = (float*)(ws + WS_PART + (size_t)pout * SZ_PART);
        const int ln = fq * 16 + fr;
#pragma unroll
        for (int ai = 0; ai < 2; ++ai) {
            u32x2 xo[4][2][2];
#pragma unroll
            for (int m = 0; m < 4; ++m)
#pragma unroll
                for (int bj = 0; bj < 2; ++bj)
#pragma unroll
                    for (int n = 0; n < 2; ++n)
                        xo[m][bj][n] = *(const u32x2*)(XB + (size_t)(u.pm * BM + ai * HALF + wr * 64 + m * 16 + fr) * DM + u.pn * BM + bj * HALF + wc * 32 + n * 16 + 4 * fq);
#pragma unroll
            for (int m = 0; m < 4; ++m) {
                const int row = u.pm * BM + ai * HALF + wr * 64 + m * 16 + fr;
                float ss = 0.f;
#pragma unroll
                for (int bj = 0; bj < 2; ++bj)
#pragma unroll
                    for (int n = 0; n < 2; ++n) {
                        const int c = u.pn * BM + bj * HALF + wc * 32 + n * 16 + 4 * fq;
                        const f32x4 xn = bf4_to_f32(xo[m][bj][n]) + acc[ai][bj][m][n] * coef;
                        u32x2 w; w.x = cvt_pk_bf16(xn[0], xn[1]); w.y = cvt_pk_bf16(xn[2], xn[3]);
                        *(u32x2*)(XB + (size_t)row * DM + c) = w;
                        ss += (xn[0] * xn[0] + xn[1] * xn[1]) + (xn[2] * xn[2] + xn[3] * xn[3]);
                    }
                ss += __builtin_bit_cast(float, __builtin_amdgcn_ds_bpermute((ln ^ 16) << 2, __builtin_bit_cast(int, ss)));
                ss += __builtin_bit_cast(float, __builtin_amdgcn_ds_bpermute((ln ^ 32) << 2, __builtin_bit_cast(int, ss)));
                if (fq == 0) atomicAdd(part_out + row, ss);
            }
        }
    }
};
struct EpiFinal {
    static constexpr bool PERM = false, AFTER_DRAIN = true;
    unsigned char* ws; float* out; const float* gain; float coef;
    typedef PreNone Pre;
    __device__ __forceinline__ void pre_load(Pre&, const Unit&, int, int) const {}
    __device__ __forceinline__ void fused(f32x4 (&acc)[2][2][4][2], const Unit& u, int wr, int wc, int fr, int fq, PG8_LAS unsigned char*, int, int) const {
        const bf16_t* XB = (const bf16_t*)(ws + WS_XB); float* part = (float*)(ws + WS_PART + 6 * SZ_PART);
        unsigned* cnt = (unsigned*)(ws + 32768) + 16 * u.pm;
        const int ln = fq * 16 + fr;
#pragma unroll
        for (int ai = 0; ai < 2; ++ai) {
            u32x2 xo[4][2][2];
#pragma unroll
            for (int m = 0; m < 4; ++m)
#pragma unroll
                for (int bj = 0; bj < 2; ++bj)
#pragma unroll
                    for (int n = 0; n < 2; ++n)
                        xo[m][bj][n] = *(const u32x2*)(XB + (size_t)(u.pm * BM + ai * HALF + wr * 64 + m * 16 + fr) * DM + u.pn * BM + bj * HALF + wc * 32 + n * 16 + 4 * fq);
#pragma unroll
            for (int m = 0; m < 4; ++m) {
                const int row = u.pm * BM + ai * HALF + wr * 64 + m * 16 + fr;
                float ss = 0.f;
#pragma unroll
                for (int bj = 0; bj < 2; ++bj)
#pragma unroll
                    for (int n = 0; n < 2; ++n) {
                        const f32x4 xn = bf4_to_f32(xo[m][bj][n]) + acc[ai][bj][m][n] * coef;
                        acc[ai][bj][m][n] = xn;
                        ss += (xn[0] * xn[0] + xn[1] * xn[1]) + (xn[2] * xn[2] + xn[3] * xn[3]);
                    }
                ss += __builtin_bit_cast(float, __builtin_amdgcn_ds_bpermute((ln ^ 16) << 2, __builtin_bit_cast(int, ss)));
                ss += __builtin_bit_cast(float, __builtin_amdgcn_ds_bpermute((ln ^ 32) << 2, __builtin_bit_cast(int, ss)));
                if (fq == 0) atomicAdd(part + row, ss);
            }
        }
        asm volatile("s_waitcnt vmcnt(0)" ::: "memory");
        if (ln == 0) __hip_atomic_fetch_add(cnt, 1u, __ATOMIC_RELAXED, __HIP_MEMORY_SCOPE_AGENT);
        if (wr == 0 && wc == 0) {
            for (unsigned spins = 0; spins < (1u << 22); ++spins) {
                if ((unsigned)__builtin_amdgcn_readfirstlane((int)__hip_atomic_load(cnt, __ATOMIC_RELAXED, __HIP_MEMORY_SCOPE_AGENT)) >= 32u) break;
                __builtin_amdgcn_s_sleep(2);
            }
            __builtin_amdgcn_fence(__ATOMIC_ACQUIRE, "agent");
        }
        asm volatile("s_waitcnt vmcnt(0) lgkmcnt(0)" ::: "memory"); __builtin_amdgcn_s_barrier(); asm volatile("" ::: "memory");
        float ssr[2][4]; f32x4 gv[2][2];
#pragma unroll
        for (int ai = 0; ai < 2; ++ai)
#pragma unroll
            for (int m = 0; m < 4; ++m) ssr[ai][m] = part[u.pm * BM + ai * HALF + wr * 64 + m * 16 + fr];
#pragma unroll
        for (int bj = 0; bj < 2; ++bj)
#pragma unroll
            for (int n = 0; n < 2; ++n) gv[bj][n] = *(const f32x4*)(gain + u.pn * BM + bj * HALF + wc * 32 + n * 16 + 4 * fq);
#pragma unroll
        for (int ai = 0; ai < 2; ++ai)
#pragma unroll
            for (int m = 0; m < 4; ++m) {
                const int row = u.pm * BM + ai * HALF + wr * 64 + m * 16 + fr;
                const float r = __builtin_amdgcn_rsqf(ssr[ai][m] * (1.0f / 1024.0f) + EPS);
#pragma unroll
                for (int bj = 0; bj < 2; ++bj)
#pragma unroll
                    for (int n = 0; n < 2; ++n) {
                        const int c = u.pn * BM + bj * HALF + wc * 32 + n * 16 + 4 * fq;
                        *(f32x4*)(out + (size_t)row * DM + c) = acc[ai][bj][m][n] * r * gv[bj][n];
                    }
            }
    }
};
template <int KIND>
__device__ __forceinline__ void in_tile(const f32x4 (&acc)[2][2][4][2], const Unit& u, int wr, int wc, int fr, int fq, const PreRows& pre, bf16_t* EB, int dcol0  ,
                                        float sc, float* o_p, float* o_s, int ocol0  , int opitch, const float* bias, float* LG) {
    float rr[2][4];
#pragma unroll
    for (int ai = 0; ai < 2; ++ai)
#pragma unroll
        for (int m = 0; m < 4; ++m) rr[ai][m] = pre_rinv(pre, ai, m, fr);
    f32x4 bia[2][2] = {};
    if (KIND == 4 || KIND == 5) {
#pragma unroll
        for (int bj = 0; bj < 2; ++bj) { const int cl = bj * HALF + wc * 32 + 8 * fq;
            if (KIND == 4 || cl < 16) { bia[bj][0] = *(const f32x4*)(bias + cl); bia[bj][1] = *(const f32x4*)(bias + cl + 4); } }
    }
#pragma unroll
    for (int ai = 0; ai < 2; ++ai)
#pragma unroll
        for (int m = 0; m < 4; ++m) {
            const int row = u.pm * BM + ai * HALF + wr * 64 + m * 16 + fr;
            const float r = rr[ai][m] * sc;
#pragma unroll
            for (int bj = 0; bj < 2; ++bj) {
                const int cl = bj * HALF + wc * 32 + 8 * fq;
                float v[8];
#pragma unroll
                for (int n = 0; n < 2; ++n)
#pragma unroll
                    for (int i = 0; i < 4; ++i) v[4 * n + i] = acc[ai][bj][m][n][i] * r;
                if (KIND == 4) {
                    const f32x4 b0 = bia[bj][0], b1 = bia[bj][1];
                    f32x4 o0, o1;
#pragma unroll
                    for (int i = 0; i < 4; ++i) { o0[i] = logsigmoid_f(v[i] + b0[i]) * (1.0f / 16.0f); o1[i] = logsigmoid_f(v[4 + i] + b1[i]) * (1.0f / 16.0f); }
                    *(f32x4*)(LG + (size_t)row * 256 + cl) = o0; *(f32x4*)(LG + (size_t)row * 256 + cl + 4) = o1;
                } else if (KIND == 5) {
                    if (cl < 16) {
                        const f32x4 b0 = bia[bj][0], b1 = bia[bj][1];
                        f32x4 o0, o1;
#pragma unroll
                        for (int i = 0; i < 4; ++i) { o0[i] = logsigmoid_f(v[i] + b0[i]); o1[i] = logsigmoid_f(v[4 + i] + b1[i]); }
                        *(f32x4*)(LG + (size_t)row * 16 + cl) = o0; *(f32x4*)(LG + (size_t)row * 16 + cl + 4) = o1;
                        float* dst = (row < MP) ? o_p + (size_t)row * 16 + cl : o_s + (size_t)(row - MP) * 16 + cl;
                        *(f32x4*)dst = o0; *(f32x4*)(dst + 4) = o1;
                    }
                } else {
                    if (KIND == 1) {
                        float t[8];
#pragma unroll
                        for (int e = 0; e < 8; ++e) t[e] = __builtin_amdgcn_exp2f(v[e] * -LOG2E);
#pragma unroll
                        for (int e = 0; e < 8; ++e) t[e] = __builtin_amdgcn_rcpf(t[e] + 1.0f);
#pragma unroll
                        for (int e = 0; e < 8; ++e) v[e] *= t[e];
                    }
                    u32x4 w; w.x = cvt_pk_bf16(v[0], v[1]); w.y = cvt_pk_bf16(v[2], v[3]); w.z = cvt_pk_bf16(v[4], v[5]); w.w = cvt_pk_bf16(v[6], v[7]);
                    st_wt16(EB + (size_t)row * NIN + dcol0 + cl, w);
                    if (KIND == 2) {
                        float* dst = (row < MP) ? o_p + (size_t)row * opitch + ocol0 + cl : o_s + (size_t)(row - MP) * opitch + ocol0 + cl;
                        *(f32x4*)dst = (f32x4){v[0], v[1], v[2], v[3]}; *(f32x4*)(dst + 4) = (f32x4){v[4], v[5], v[6], v[7]};
                    }
                    if (KIND == 3) {
                        float* dst = nullptr;
                        if (row >= MP) dst = o_s + (size_t)(row - MP) * 512 + ocol0 + cl;
                        else { const int t = row & (TSEQ - 1), b = row >> 11; if (t >= TSEQ - 512) dst = o_p + ((size_t)(b * 512 + (t - (TSEQ - 512))) * 512 + ocol0 + cl); }
                        if (dst) { *(f32x4*)dst = (f32x4){v[0], v[1], v[2], v[3]}; *(f32x4*)(dst + 4) = (f32x4){v[4], v[5], v[6], v[7]}; }
                    }
                }
            }
        }
}
struct EpiInEven {
    static constexpr bool PERM = true, AFTER_DRAIN = false;
    unsigned char* ws; float* out; PG8_LAS unsigned char* lds;
    typedef PreRows Pre;
    __device__ __forceinline__ void pre_load(Pre& p, const Unit& u, int wr, int lane) const { pre_rows_load(p, (const float*)(ws + WS_PART + 1 * SZ_PART), u, wr, lane, lds); }
    __device__ __forceinline__ void operator()(const f32x4 (&acc)[2][2][4][2], const Unit& u, int wr, int wc, int fr, int fq, const Pre& part) const {
        const int pn = u.pn;
        bf16_t* EB = (bf16_t*)(ws + WS_EB);
        if (pn == 4 || pn == 5) in_tile<1>(acc, u, wr, wc, fr, fq, part, EB, pn * BM, 1.0f, nullptr, nullptr, 0, 0, nullptr, nullptr);
        else if (pn >= 9) { const bool isv = pn >= 11; in_tile<3>(acc, u, wr, wc, fr, fq, part, EB, pn * BM, 1.0f, out + (isv ? O_PBV : O_PBK), out + (isv ? O_SBV : O_SBK), pn * BM - (isv ? 2816 : 2304), 512, nullptr, nullptr); }
        else in_tile<0>(acc, u, wr, wc, fr, fq, part, EB, pn * BM, (pn == 0) ? 0.125f : ((pn >= 7) ? QSCALE2 : 1.0f), nullptr, nullptr, 0, 0, nullptr, nullptr);
    }
};
struct EpiInOdd {
    static constexpr bool PERM = true, AFTER_DRAIN = false;
    unsigned char* ws; float* out; PG8_LAS unsigned char* lds;
    typedef PreRows Pre;
    __device__ __forceinline__ void pre_load(Pre& p, const Unit& u, int wr, int lane) const { pre_rows_load(p, (const float*)(ws + WS_PART + 4 * SZ_PART), u, wr, lane, lds); }
    __device__ __forceinline__ void operator()(const f32x4 (&acc)[2][2][4][2], const Unit& u, int wr, int wc, int fr, int fq, const Pre& part) const {
        const int pn = u.pn;
        bf16_t* EB = (bf16_t*)(ws + WS_EB);
        if (pn >= 4) { const bool isv = pn >= 8; in_tile<2>(acc, u, wr, wc, fr, fq, part, EB, pn * BM, 1.0f, out + (isv ? O_PFV : O_PFK), out + (isv ? O_SFV : O_SFK), pn * BM - (isv ? 2048 : 1024), 1024, nullptr, nullptr); }
        else in_tile<0>(acc, u, wr, wc, fr, fq, part, EB, pn * BM, QSCALE2, nullptr, nullptr, 0, 0, nullptr, nullptr);
    }
};
template <class Epi, class Sched, bool ALIGN_EPI = false, bool SP2 = false>
__device__ __forceinline__ void gemm_phase(PG8_LAS unsigned char* lds, const Gemm g, const Sched& S, const Epi& E) {
    int tid_ = threadIdx.x; asm volatile("" : "+v"(tid_));
    const int tid = tid_, wid = __builtin_amdgcn_readfirstlane(tid >> 6), lane = tid & 63, wr = wid >> 2, wc = wid & 3, fr = lane & 15, fq = lane >> 4;
    const int K = g.K, nt = K / BK;
    unsigned voffA[2], voffB[2];
#pragma unroll
    for (int i = 0; i < 2; ++i) { int R, C; stage_rc(tid * 16 + i * 8192, R, C); const int Rb = Epi::PERM ? ((R & ~31) + perm32(R & 31)) : R;
        voffA[i] = (unsigned)(R * K + C) * 2u; voffB[i] = (unsigned)(Rb * K + C) * 2u; }
    const size_t kstep = (size_t)(BK * 2);
    const size_t hstep = (size_t)HALF * K * 2;
    const size_t tstep = 2 * hstep;
    const unsigned ldsw = (unsigned)wid * 1024u;
    const int aoff = lds_byte(wr * 64 + fr, fq * 8), boff = lds_byte(wc * 32 + fr, fq * 8);
#define PG8_SA(b, h) (((b) * 2 + (h)) * HTB)
#define PG8_SB(b, h) ((4 + (b) * 2 + (h)) * HTB)
#define PG8_STAGE(bufoff, gbase, voff) do { _Pragma("unroll") for (int _i = 0; _i < 2; ++_i) \
        __builtin_amdgcn_global_load_lds((const unsigned*)((const char*)(gbase) + (voff)[_i]), (PG8_LAS unsigned*)(lds + (bufoff) + ldsw + _i * 8192), 16, 0, 0); } while (0)
#define PG8_LDA(dst, b, h) do { _Pragma("unroll") for (int m = 0; m < 4; ++m) _Pragma("unroll") for (int k = 0; k < 2; ++k) dst[m][k] = *(const PG8_LAS bf16x8*)(lds + PG8_SA(b, h) + aoff + m * 2048 + k * 1024); } while (0)
#define PG8_LDB(dst, b, h) do { _Pragma("unroll") for (int n = 0; n < 2; ++n) _Pragma("unroll") for (int k = 0; k < 2; ++k) dst[n][k] = *(const PG8_LAS bf16x8*)(lds + PG8_SB(b, h) + boff + n * 2048 + k * 1024); } while (0)
#define PG8_MMA(ai, bj, At, Bt) do { __builtin_amdgcn_s_setprio(1); _Pragma("unroll") for (int m = 0; m < 4; ++m) _Pragma("unroll") for (int n = 0; n < 2; ++n) _Pragma("unroll") for (int k = 0; k < 2; ++k) \
        acc[ai][bj][m][n] = __builtin_amdgcn_mfma_f32_16x16x32_bf16(Bt[n][k], At[m][k], acc[ai][bj][m][n], 0, 0, 0); __builtin_amdgcn_s_setprio(0); } while (0)
#define PG8_WAIT_V(n) asm volatile("s_waitcnt vmcnt(" #n ")" ::: "memory")
#define PG8_WAIT_L(n) asm volatile("s_waitcnt lgkmcnt(" #n ")" ::: "memory")
#define PG8_BAR __builtin_amdgcn_s_barrier()
#define PG8_SCHED __builtin_amdgcn_sched_barrier(0)
    Unit cur, nxt; int ui = 0;
    typename Epi::Pre pre{};
    if (!S.next(0, cur)) return;
    f32x4 acc[2][2][4][2];
#pragma unroll
    for (int a = 0; a < 2; ++a)
#pragma unroll
        for (int b = 0; b < 2; ++b)
#pragma unroll
            for (int m = 0; m < 4; ++m)
#pragma unroll
                for (int n = 0; n < 2; ++n) acc[a][b][m][n] = (f32x4){0.f, 0.f, 0.f, 0.f};
    bf16x8 At[4][2], B0[2][2], B1[2][2];
    const char* cA = (const char*)g.A + (size_t)cur.pm * tstep; const char* cB = (const char*)g.Bt + (size_t)cur.pn * tstep;
    S.a_ready(cur);
    if constexpr (SP2) {
        PG8_STAGE(PG8_SB(0, 0), cB, voffB); PG8_STAGE(PG8_SB(0, 1), cB + hstep, voffB); PG8_STAGE(PG8_SA(0, 0), cA, voffA); PG8_STAGE(PG8_SA(0, 1), cA + hstep, voffA);
        if (wr == 1) PG8_BAR;
        PG8_WAIT_V(2); PG8_BAR;
        PG8_STAGE(PG8_SB(1, 0), cB + kstep, voffB); PG8_STAGE(PG8_SA(1, 0), cA + kstep, voffA); PG8_STAGE(PG8_SB(1, 1), cB + hstep + kstep, voffB);
        PG8_WAIT_V(6); PG8_BAR;
    } else {
        PG8_STAGE(PG8_SB(0, 0), cB, voffB); PG8_STAGE(PG8_SA(0, 0), cA, voffA); PG8_STAGE(PG8_SB(0, 1), cB + hstep, voffB); PG8_STAGE(PG8_SA(0, 1), cA + hstep, voffA);
        if (wr == 1) PG8_BAR;
        PG8_WAIT_V(4); PG8_BAR;
        PG8_STAGE(PG8_SB(1, 0), cB + kstep, voffB); PG8_STAGE(PG8_SA(1, 0), cA + kstep, voffA); PG8_STAGE(PG8_SB(1, 1), cB + hstep + kstep, voffB);
        PG8_WAIT_V(6); PG8_BAR;
    }
    for (;;) {
        const bool has_next = S.next(ui + 1, nxt);
        const char* nA = has_next ? (const char*)g.A + (size_t)nxt.pm * tstep : cA; const char* nB = has_next ? (const char*)g.Bt + (size_t)nxt.pn * tstep : cB;
        for (int t = 0; t < nt; t += 2) {
            const bool last = (t == nt - 2);
            const char* a1 = cA + (size_t)(t + 1) * kstep;
            const char* a2 = last ? nA : cA + (size_t)(t + 2) * kstep; const char* b2 = last ? nB : cB + (size_t)(t + 2) * kstep;
            const char* a3 = a2 + kstep; const char* b3 = b2 + kstep;
            if (last && has_next) S.a_ready(nxt);
            if (last) E.pre_load(pre, cur, wr, lane);
            if constexpr (SP2) {
            PG8_LDB(B0, 0, 0); PG8_LDB(B1, 0, 1); PG8_SCHED; PG8_LDA(At, 0, 0); PG8_STAGE(PG8_SA(1, 1), a1 + hstep, voffA);
            PG8_WAIT_V(8); PG8_WAIT_L(0); PG8_BAR; PG8_MMA(0, 0, At, B0); PG8_MMA(0, 1, At, B1); PG8_BAR; PG8_SCHED;
            PG8_LDA(At, 0, 1); PG8_STAGE(PG8_SB(0, 0), b2, voffB); PG8_STAGE(PG8_SB(0, 1), b2 + hstep, voffB); PG8_STAGE(PG8_SA(0, 0), a2, voffA);
            PG8_WAIT_V(8); PG8_WAIT_L(0); PG8_BAR; PG8_MMA(1, 0, At, B0); PG8_MMA(1, 1, At, B1); PG8_BAR; PG8_SCHED;
            PG8_LDB(B0, 1, 0); PG8_LDB(B1, 1, 1); PG8_SCHED; PG8_LDA(At, 1, 0); PG8_STAGE(PG8_SA(0, 1), a2 + hstep, voffA);
            PG8_WAIT_V(8); PG8_WAIT_L(0); PG8_BAR; PG8_MMA(0, 0, At, B0); PG8_MMA(0, 1, At, B1); PG8_BAR; PG8_SCHED;
            PG8_LDA(At, 1, 1); PG8_STAGE(PG8_SB(1, 0), b3, voffB); PG8_STAGE(PG8_SB(1, 1), b3 + hstep, voffB); PG8_STAGE(PG8_SA(1, 0), a3, voffA);
            PG8_WAIT_V(8); PG8_WAIT_L(0); PG8_BAR; PG8_MMA(1, 0, At, B0); PG8_MMA(1, 1, At, B1); PG8_BAR; PG8_SCHED;
            } else {
            PG8_LDB(B0, 0, 0); PG8_SCHED; PG8_LDA(At, 0, 0); PG8_STAGE(PG8_SA(1, 1), a1 + hstep, voffA);
            PG8_WAIT_L(8); PG8_BAR; PG8_WAIT_L(0); PG8_MMA(0, 0, At, B0); PG8_BAR; PG8_SCHED;
            PG8_LDB(B1, 0, 1); PG8_STAGE(PG8_SB(0, 0), b2, voffB);
            PG8_BAR; PG8_WAIT_L(0); PG8_MMA(0, 1, At, B1); PG8_BAR;
            PG8_LDA(At, 0, 1); PG8_STAGE(PG8_SA(0, 0), a2, voffA);
            PG8_BAR; PG8_WAIT_L(0); PG8_MMA(1, 0, At, B0); PG8_BAR; PG8_SCHED;
            PG8_STAGE(PG8_SB(0, 1), b2 + hstep, voffB);
            PG8_WAIT_V(6); PG8_BAR; PG8_MMA(1, 1, At, B1); PG8_BAR;
            PG8_LDB(B0, 1, 0); PG8_SCHED; PG8_LDA(At, 1, 0); PG8_STAGE(PG8_SA(0, 1), a2 + hstep, voffA);
            PG8_WAIT_L(8); PG8_BAR; PG8_WAIT_L(0); PG8_MMA(0, 0, At, B0); PG8_BAR; PG8_SCHED;
            PG8_LDB(B1, 1, 1); PG8_STAGE(PG8_SB(1, 0), b3, voffB);
            PG8_BAR; PG8_WAIT_L(0); PG8_MMA(0, 1, At, B1); PG8_BAR;
            PG8_LDA(At, 1, 1); PG8_STAGE(PG8_SA(1, 0), a3, voffA);
            PG8_BAR; PG8_WAIT_L(0); PG8_MMA(1, 0, At, B0); PG8_BAR; PG8_SCHED;
            PG8_STAGE(PG8_SB(1, 1), b3 + hstep, voffB);
            PG8_WAIT_V(6); PG8_BAR; PG8_MMA(1, 1, At, B1); PG8_BAR;
            }
        }
        if constexpr (ALIGN_EPI) { if (wr == 0) PG8_BAR; }
        if constexpr (!Epi::AFTER_DRAIN) { E(acc, cur, wr, wc, fr, fq, pre); S.done(cur); }
        if (!has_next) break;
#pragma unroll
        for (int a = 0; a < 2; ++a)
#pragma unroll
            for (int b = 0; b < 2; ++b)
#pragma unroll
                for (int m = 0; m < 4; ++m)
#pragma unroll
                    for (int n = 0; n < 2; ++n) acc[a][b][m][n] = (f32x4){0.f, 0.f, 0.f, 0.f};
        cur = nxt; cA = nA; cB = nB; ++ui;
        if constexpr (ALIGN_EPI) { if (wr == 1) PG8_BAR; }
    }
    PG8_WAIT_V(0);
    if constexpr (!ALIGN_EPI) { if (wr == 0) PG8_BAR; }
    PG8_BAR;
    if constexpr (Epi::AFTER_DRAIN) { E.fused(acc, cur, wr, wc, fr, fq, lds, wid, lane); S.done(cur); }
#undef PG8_SA
#undef PG8_SB
#undef PG8_STAGE
#undef PG8_LDA
#undef PG8_LDB
#undef PG8_MMA
#undef PG8_WAIT_V
#undef PG8_WAIT_L
#undef PG8_BAR
#undef PG8_SCHED
}
}
#include <hip/hip_bf16.h>
#include <cmath>
namespace attn_body {
using bf16=__hip_bfloat16;
using bf16x8=__attribute__((ext_vector_type(8)))short;
using s16x4=__attribute__((ext_vector_type(4)))short;
using f32x16=__attribute__((ext_vector_type(16)))float;
using u32x4=__attribute__((ext_vector_type(4)))unsigned;
typedef float f32x4_t __attribute__((ext_vector_type(4)));
constexpr int BATCH=8,NHEAD=16,SEQ=2048,D=64,DM=NHEAD*D,PQ=3328;
constexpr int NW=8,QBLK=32,QB=QBLK*NW,KVBLK=64,NQB=SEQ/QB;
constexpr int ATTN_UNIT_ROWS=QB;
__device__ __forceinline__ int crow(int r,int hi){return (r&3)+8*(r>>2)+4*hi;}
#define SBAR() __builtin_amdgcn_sched_barrier(0)
__device__ __forceinline__ void cmask(f32x16&p0,f32x16&p1,int jb,int qrel,int hi){
  const float NEG=-INFINITY; int kb=64*jb+4*hi;
  #pragma unroll
  for(int r=0;r<16;++r){int kv=kb+(r&3)+8*(r>>2); if(kv>qrel)p0[r]=NEG; if(kv+32>qrel)p1[r]=NEG;}
}

constexpr int NSLOT=3, SLOTB=8192;
constexpr float FOX_SKIP2_=160.0f*1.4426950408889634f;
constexpr int LDS_K=0, LDS_V=NSLOT*SLOTB, LDS_WS=2*NSLOT*SLOTB, LDS_OST=LDS_WS+NW*64*4, LDS_BYTES=LDS_OST+NW*4096;
constexpr float C2=0.125f*1.4426950408889634f;
__device__ __forceinline__ void glds16(const void*gsrc,unsigned lds_dst){unsigned keep;
  asm volatile("s_mov_b32 %0, m0\n\ts_mov_b32 m0, %2\n\ts_nop 0\n\tglobal_load_lds_dwordx4 %1, off\n\ts_mov_b32 m0, %0":"=&s"(keep):"v"(gsrc),"s"(lds_dst):"memory");}
__device__ __forceinline__ float max3f(float a,float b,float c){float r;asm("v_max3_f32 %0, %1, %2, %3":"=v"(r):"v"(a),"v"(b),"v"(c));return r;}
__device__ __forceinline__ float max2f(float a,float b){float r;asm("v_max_f32_e32 %0, %1, %2":"=v"(r):"v"(a),"v"(b));return r;}
__device__ __forceinline__ float fadd_s(float a,float b){float r;asm("v_add_f32_e32 %0, %1, %2":"=v"(r):"v"(a),"v"(b));return r;}
__device__ __forceinline__ float fsub_s(float a,float b){float r;asm("v_sub_f32_e32 %0, %1, %2":"=v"(r):"v"(a),"v"(b));return r;}
typedef float f32x2_t __attribute__((ext_vector_type(2))); typedef __bf16 bf16x2_t __attribute__((ext_vector_type(2)));
__device__ __forceinline__ unsigned cvtpk_s(float lo,float hi){f32x2_t v={lo,hi};bf16x2_t b=__builtin_convertvector(v,bf16x2_t);return __builtin_bit_cast(unsigned,b);}
#define WAIT_BAR(N) asm volatile("s_waitcnt vmcnt(" #N ") lgkmcnt(0)\n\ts_barrier":::"memory")

__device__ __forceinline__ void qkt(f32x16&p0,f32x16&p1,const char*Kslot,const bf16x8*qr,int r32,int hi){
  const char*kb=Kslot+hi*1024+r32*16;
  #pragma unroll
  for(int d0=0;d0<4;++d0){
    const bf16x8 b0=*reinterpret_cast<const bf16x8*>(kb+d0*2048);
    const bf16x8 b1=*reinterpret_cast<const bf16x8*>(kb+d0*2048+512);
    {p0=__builtin_amdgcn_mfma_f32_32x32x16_bf16(b0,qr[d0],p0,0,0,0);p1=__builtin_amdgcn_mfma_f32_32x32x16_bf16(b1,qr[d0],p1,0,0,0);}}
}
typedef __attribute__((address_space(3))) const char* lds_cptr;
typedef short v4i16_t __attribute__((ext_vector_type(4)));
__device__ __forceinline__ void kload8(bf16x8*kf,lds_cptr kp){
  kf[0]=*(const __attribute__((address_space(3))) bf16x8*)(kp);      kf[1]=*(const __attribute__((address_space(3))) bf16x8*)(kp+512);
  kf[2]=*(const __attribute__((address_space(3))) bf16x8*)(kp+2048); kf[3]=*(const __attribute__((address_space(3))) bf16x8*)(kp+2560);
  kf[4]=*(const __attribute__((address_space(3))) bf16x8*)(kp+4096); kf[5]=*(const __attribute__((address_space(3))) bf16x8*)(kp+4608);
  kf[6]=*(const __attribute__((address_space(3))) bf16x8*)(kp+6144); kf[7]=*(const __attribute__((address_space(3))) bf16x8*)(kp+6656);
}
__device__ __forceinline__ void kload2(bf16x8*kf,lds_cptr kp,int j){ kf[2*j]=*(const __attribute__((address_space(3))) bf16x8*)(kp+j*2048); kf[2*j+1]=*(const __attribute__((address_space(3))) bf16x8*)(kp+j*2048+512); }
__device__ __forceinline__ s16x4 vtr(lds_cptr p){ return __builtin_bit_cast(s16x4,__builtin_amdgcn_ds_read_tr16_b64_v4i16((__attribute__((address_space(3))) v4i16_t*)p)); }
__device__ __forceinline__ float rowmax(const f32x16&p0,const f32x16&p1){
  float a=max3f(p0[0],p0[1],p1[0]),b=max3f(p0[2],p0[3],p1[1]);a=max3f(a,p1[2],p1[3]);
  #pragma unroll
  for(int r=4;r<16;r+=4){a=max3f(a,p0[r],p0[r+1]);b=max3f(b,p0[r+2],p0[r+3]);a=max3f(a,p1[r],p1[r+1]);b=max3f(b,p1[r+2],p1[r+3]);}
  const float m=max2f(a,b);
  auto rr=__builtin_amdgcn_permlane32_swap(__float_as_uint(m),__float_as_uint(m),false,false);
  return max2f(__uint_as_float(rr[0]),__uint_as_float(rr[1]));
}
__device__ __forceinline__ void pv(f32x16*o,int vb,bf16x8 pa0,bf16x8 pa1,bf16x8 pa2,bf16x8 pa3){
  #pragma unroll
  for(int d0=0;d0<2;++d0){s16x4 lo[4],hi[4];
    #pragma unroll
    for(int ks=0;ks<4;++ks){
      asm volatile("ds_read_b64_tr_b16 %0,%1 offset:%c2":"=&v"(lo[ks]):"v"(vb),"i"(d0*4096+ks*1024):"memory");
      asm volatile("ds_read_b64_tr_b16 %0,%1 offset:%c2":"=&v"(hi[ks]):"v"(vb),"i"(d0*4096+ks*1024+512):"memory");}
    asm volatile("s_waitcnt lgkmcnt(0)":::"memory");SBAR();
    #define PK(k) (bf16x8){lo[k][0],lo[k][1],lo[k][2],lo[k][3],hi[k][0],hi[k][1],hi[k][2],hi[k][3]}
    o[d0]=__builtin_amdgcn_mfma_f32_32x32x16_bf16(pa0,PK(0),o[d0],0,0,0);
    o[d0]=__builtin_amdgcn_mfma_f32_32x32x16_bf16(pa1,PK(1),o[d0],0,0,0);
    o[d0]=__builtin_amdgcn_mfma_f32_32x32x16_bf16(pa2,PK(2),o[d0],0,0,0);
    o[d0]=__builtin_amdgcn_mfma_f32_32x32x16_bf16(pa3,PK(3),o[d0],0,0,0);
    #undef PK
  }
}

#ifndef ATTN_STORE16
#define ATTN_STORE16(p,v) (*(u32x4*)(p)=(v))
#endif
template<int THRL,int MODE> __device__ __forceinline__ void attn_unit(int b,int h,int qb,const bf16*Q,const bf16*K,const bf16*V,bf16*O,char*shm,const __attribute__((address_space(3))) float*F2){
  int tid_=threadIdx.x; asm volatile("":"+v"(tid_));
  const int tid=tid_,lane=tid&63,r32=lane&31,hi=lane>>5; const int wid=__builtin_amdgcn_readfirstlane(tid>>6);
  const long rowbase=(long)b*SEQ; const int q0=qb*QB;
  int t_lo=(MODE==1&&qb>=2)?4*qb-8:0;
  if(MODE==0){
    const float lim=F2[qb*QB]+FOX_SKIP2_;
    while(t_lo+2<=4*qb && __builtin_amdgcn_readfirstlane(F2[64*(t_lo+2)-1]>lim)) t_lo+=2; }
  const bf16*Qw=Q+(rowbase+q0+wid*QBLK)*PQ+h*D;
  const bf16*Kh=K+(rowbase+64*t_lo)*PQ+h*D,*Vh=V+(rowbase+64*t_lo)*PQ+h*D;
  const unsigned lds0=(unsigned)(uintptr_t)shm;
  float*wsf=(float*)(shm+LDS_WS)+wid*64;
  const bf16*ksrc=Kh+(long)lane*PQ+wid*8;
  const bf16*vsrc=Vh+(long)(16*(wid&3)+(lane>>2))*PQ+(wid>>2)*32+(lane&3)*8;
  const unsigned kdst=lds0+LDS_K+wid*1024, vdst=lds0+LDS_V+wid*1024;
  #define DMA_K(t,slot) glds16(ksrc+(long)(t)*KVBLK*PQ,(unsigned)__builtin_amdgcn_readfirstlane(kdst+(slot)))
  #define DMA_V(t,slot) glds16(vsrc+(long)(t)*KVBLK*PQ,(unsigned)__builtin_amdgcn_readfirstlane(vdst+(slot)))
  const int vb0=(int)(lds0+LDS_V)+((lane>>4)&1)*32+(lane&3)*8+(4*hi+((lane&15)>>2))*64;
  const char*Kbase=shm+LDS_K; bf16x8 kf[8];
  const lds_cptr shm3=(lds_cptr)shm; const lds_cptr kp0=shm3+LDS_K+hi*1024+r32*16; const lds_cptr vp0=shm3+LDS_V+((lane>>4)&1)*32+(lane&3)*8+(4*hi+((lane&15)>>2))*64;
  const int NT=(q0+QB)/KVBLK-t_lo;
  DMA_K(0,0);DMA_V(0,0);DMA_K(1,SLOTB);
  bf16x8 qr[4];
  #pragma unroll
  for(int d0=0;d0<4;++d0)qr[d0]=*reinterpret_cast<const bf16x8*>(&Qw[(long)r32*PQ+d0*16+hi*8]);
  float mhat=0.f,l_reg=0.f;f32x16 o[2];o[0]=f32x16{};o[1]=f32x16{};
  #define BIAS(C0,C1,t) do{ const float nm_=f2q-mhat;          \
    if(MODE==0){ const __attribute__((address_space(3))) float*fp_=F2+64*(t_lo+(t))+4*hi; \
      _Pragma("unroll") for(int g_=0;g_<4;++g_){ const f32x4_t a_=*(const __attribute__((address_space(3))) f32x4_t*)(fp_+8*g_), b_=*(const __attribute__((address_space(3))) f32x4_t*)(fp_+32+8*g_); \
        _Pragma("unroll") for(int i_=0;i_<4;++i_){ C0[4*g_+i_]=nm_-a_[i_]; C1[4*g_+i_]=nm_-b_[i_]; } } } \
    else{ const int dl_=4*qb+(wid>>1)-(t_lo+(t));              \
      if(dl_<0||dl_>8){ const float c_=nm_-4096.f; _Pragma("unroll") for(int r=0;r<16;++r){C0[r]=c_;C1[r]=c_;} } \
      else if(dl_>=3){ const float c_=nm_+F2[256]; _Pragma("unroll") for(int r=0;r<16;++r){C0[r]=c_;C1[r]=c_;} } \
      else{ const __attribute__((address_space(3))) float*tp_=F2+64*dl_+128+32*(wid&1)+r32-4*hi;     \
        _Pragma("unroll") for(int r=0;r<16;++r){ const int j_=(r&3)+8*(r>>2); C0[r]=nm_+tp_[-j_]; C1[r]=nm_+tp_[-j_-32]; } } } }while(0)
  const int qrel=wid*QBLK+r32;
  const float f2q=(MODE==0)?F2[q0+qrel]:0.f;
  #define CMASK(P0,P1,t) do{ if(MODE==0){int jb_=(t)-(NT-4); if(jb_>=0)cmask(P0,P1,jb_,qrel,hi);} }while(0)
  bool resc=false;
  #define START(P0,P1) do{ const float rm=rowmax(P0,P1); resc=false; \
    { const float dl=__builtin_fmaxf(rm,0.f); mhat=fadd_s(mhat,dl); \
      _Pragma("unroll") for(int r=0;r<16;++r){P0[r]=fsub_s(P0[r],dl);P1[r]=fsub_s(P1[r],dl);} \
      } \
    _Pragma("unroll") for(int r=0;r<16;++r)P0[r]=__builtin_amdgcn_exp2f(P0[r]); }while(0)
  #define RESC() do{ if(resc){ asm volatile("s_waitcnt lgkmcnt(0)":::"memory"); \
      _Pragma("unroll") for(int d_=0;d_<2;++d_) _Pragma("unroll") for(int r=0;r<16;++r)o[d_][r]*=wsf[crow(r,hi)]; } }while(0)
  f32x16 pA0,pA1,pB0,pB1;
  int sl_prev=0,sl_cur=0,sl_next=SLOTB;
  #define ROT() do{sl_prev=sl_cur;sl_cur=sl_next;sl_next=(sl_next==(NSLOT-1)*SLOTB)?0:sl_next+SLOTB;}while(0)
  DMA_K(2,2*SLOTB);
  WAIT_BAR(3);
  BIAS(pA0,pA1,0); qkt(pA0,pA1,Kbase,qr,r32,hi);asm volatile("s_nop 15\n\ts_nop 7":"+v"(pA0),"+v"(pA1));CMASK(pA0,pA1,0);
  START(pA0,pA1);
  _Pragma("unroll") for(int r=0;r<16;++r)pA1[r]=__builtin_amdgcn_exp2f(pA1[r]);
  WAIT_BAR(0);
  DMA_K(3,0);DMA_V(1,SLOTB);
  ROT();
  kload8(kf,kp0+sl_cur);
  WAIT_BAR(2);
  s16x4 vlo[8],vhi[8]; u32x4 pw0,pw1,pw2,pw3;
  #define PKW(P,B) cvtpk_s(P[B],P[B+1])
  #define PAF(k) __builtin_bit_cast(bf16x8,pw##k)
  #define VFR(i) (bf16x8){vlo[i][0],vlo[i][1],vlo[i][2],vlo[i][3],vhi[i][0],vhi[i][1],vhi[i][2],vhi[i][3]}
  #define PIN(x) asm volatile("":"+v"(x))
  #define MX3(a,b,c) __builtin_fmaxf(__builtin_fmaxf((a),(b)),(c))
  #define GAPA(MF,A0,A1,A2,A3,W0,W1,PW) do{ MF; sacc+=A0; sacc+=A1; sacc+=A2; sacc+=A3; PIN(sacc); W0; W1; PIN(PW); SBAR(); }while(0)
  #define EX(v) __builtin_amdgcn_exp2f(v)
  #define GAPB(MF,X,B) do{ MF; X[B]=EX(X[B]); X[B+1]=EX(X[B+1]); X[B+2]=EX(X[B+2]); X[B+3]=EX(X[B+3]); PIN(X); SBAR(); }while(0)
  #define VRD(i) do{ vlo[i]=vtr(vp_+(((i)>>2)*4096+((i)&3)*1024)); vhi[i]=vtr(vp_+(((i)>>2)*4096+((i)&3)*1024+512)); }while(0)
  #define KRD(G,j) do{ if(G){ kload2(kf,kp0+sl_next,j); SBAR(); } }while(0)
  #define STEP(C0,C1,P0,P1,t,GK,GV,GL) do{ BIAS(C0,C1,t); SBAR(); \
    const lds_cptr vp_=vp0+sl_prev; \
    VRD(0); SBAR(); float sacc=(P0[0]+P0[1]); \
    GAPA(C0=__builtin_amdgcn_mfma_f32_32x32x16_bf16(kf[0],qr[0],C0,0,0,0), P0[2],P0[3],P0[4],P0[5],     pw0[0]=PKW(P0,0), pw0[1]=PKW(P0,2), pw0); \
    VRD(4); SBAR(); GAPA(C1=__builtin_amdgcn_mfma_f32_32x32x16_bf16(kf[1],qr[0],C1,0,0,0), P0[6],P0[7],P0[8],P0[9],     pw0[2]=PKW(P0,4), pw0[3]=PKW(P0,6), pw0); \
    VRD(1); SBAR(); GAPA(C0=__builtin_amdgcn_mfma_f32_32x32x16_bf16(kf[2],qr[1],C0,0,0,0),   P0[10],P0[11],P0[12],P0[13], pw1[0]=PKW(P0,8), pw1[1]=PKW(P0,10), pw1); \
    VRD(5); SBAR(); GAPA(C1=__builtin_amdgcn_mfma_f32_32x32x16_bf16(kf[3],qr[1],C1,0,0,0),   P0[14],P0[15],P1[0],P1[1],   pw1[2]=PKW(P0,12),pw1[3]=PKW(P0,14), pw1); \
    VRD(2); SBAR(); GAPA(C0=__builtin_amdgcn_mfma_f32_32x32x16_bf16(kf[4],qr[2],C0,0,0,0),   P1[2],P1[3],P1[4],P1[5],     pw2[0]=PKW(P1,0), pw2[1]=PKW(P1,2), pw2); \
    VRD(6); SBAR(); GAPA(C1=__builtin_amdgcn_mfma_f32_32x32x16_bf16(kf[5],qr[2],C1,0,0,0),   P1[6],P1[7],P1[8],P1[9],     pw2[2]=PKW(P1,4), pw2[3]=PKW(P1,6), pw2); \
    VRD(3); SBAR(); GAPA(C0=__builtin_amdgcn_mfma_f32_32x32x16_bf16(kf[6],qr[3],C0,0,0,0),   P1[10],P1[11],P1[12],P1[13], pw3[0]=PKW(P1,8), pw3[1]=PKW(P1,10), pw3); \
    VRD(7); SBAR(); GAPA(C1=__builtin_amdgcn_mfma_f32_32x32x16_bf16(kf[7],qr[3],C1,0,0,0),   P1[14],P1[15],0.f,0.f,       pw3[2]=PKW(P1,12),pw3[3]=PKW(P1,14), pw3); \
    l_reg+=sacc; \
    if(GK){DMA_K((t)+3,sl_cur);} if(GV){DMA_V((t)+1,sl_next);} \
    CMASK(C0,C1,t); \
    { float a=MX3(C0[0],C0[1],C1[0]),b=MX3(C0[2],C0[3],C1[1]); a=MX3(a,C1[2],C1[3]); \
      _Pragma("unroll") for(int r=4;r<16;r+=4){a=MX3(a,C0[r],C0[r+1]);b=MX3(b,C0[r+2],C0[r+3]);a=MX3(a,C1[r],C1[r+1]);b=MX3(b,C1[r+2],C1[r+3]);} \
      float rm=__builtin_fmaxf(a,b); { auto rr=__builtin_amdgcn_permlane32_swap(__float_as_uint(rm),__float_as_uint(rm),false,false); rm=__builtin_fmaxf(__uint_as_float(rr[0]),__uint_as_float(rr[1])); } \
      resc=false; \
      if(__builtin_expect(__any(rm>(float)THRL),0)){ const float dl=__builtin_fmaxf(rm,0.f); mhat+=dl; \
        _Pragma("unroll") for(int r=0;r<16;++r){C0[r]-=dl;C1[r]-=dl;} \
        const float f=__builtin_amdgcn_exp2f(-dl); l_reg*=f; if(hi==0)wsf[r32]=f; resc=true; } } \
    SBAR(); \
    GAPB(o[0]=__builtin_amdgcn_mfma_f32_32x32x16_bf16(PAF(0),VFR(0),o[0],0,0,0), C0,0); \
    GAPB(o[1]=__builtin_amdgcn_mfma_f32_32x32x16_bf16(PAF(0),VFR(4),o[1],0,0,0), C0,4); \
    KRD(GL,0); GAPB(o[0]=__builtin_amdgcn_mfma_f32_32x32x16_bf16(PAF(1),VFR(1),o[0],0,0,0), C0,8); \
    KRD(GL,1); GAPB(o[1]=__builtin_amdgcn_mfma_f32_32x32x16_bf16(PAF(1),VFR(5),o[1],0,0,0), C0,12); \
    KRD(GL,2); GAPB(o[0]=__builtin_amdgcn_mfma_f32_32x32x16_bf16(PAF(2),VFR(2),o[0],0,0,0), C1,0); \
    KRD(GL,3); GAPB(o[1]=__builtin_amdgcn_mfma_f32_32x32x16_bf16(PAF(2),VFR(6),o[1],0,0,0), C1,4); \
    GAPB(o[0]=__builtin_amdgcn_mfma_f32_32x32x16_bf16(PAF(3),VFR(3),o[0],0,0,0), C1,8); \
    GAPB(o[1]=__builtin_amdgcn_mfma_f32_32x32x16_bf16(PAF(3),VFR(7),o[1],0,0,0), C1,12); \
    }while(0)
  int t=1;
  #undef CMASK
  #define CMASK(P0,P1,t) do{}while(0)
  for(;t+5<NT;t+=2){
    STEP(pB0,pB1,pA0,pA1,t,true,true,true);     WAIT_BAR(2); RESC(); ROT();
    STEP(pA0,pA1,pB0,pB1,t+1,true,true,true);   WAIT_BAR(2); RESC(); ROT();
  }
  #undef CMASK
  #define CMASK(P0,P1,t) do{ if(MODE==0){int jb_=(t)-(NT-4); if(jb_>=0)cmask(P0,P1,jb_,qrel,hi);} }while(0)
  #define ENDW(tt) do{ if((tt)+3<NT){WAIT_BAR(2);} else if((tt)+2<NT){WAIT_BAR(1);} else {WAIT_BAR(0);} }while(0)
  for(;t+1<NT;t+=2){
    STEP(pB0,pB1,pA0,pA1,t,(t+3<NT),(t+1<NT),(t+1<NT));       ENDW(t);   RESC(); ROT();
    STEP(pA0,pA1,pB0,pB1,t+1,(t+4<NT),(t+2<NT),(t+2<NT));     ENDW(t+1); RESC(); ROT();
  }
  STEP(pB0,pB1,pA0,pA1,NT-1,false,false,false); RESC();
  { float sacc=pB0[0]+pB0[1]; _Pragma("unroll") for(int r=2;r<16;++r)sacc+=pB0[r]; _Pragma("unroll") for(int r=0;r<16;++r)sacc+=pB1[r]; l_reg+=sacc;
    pw0=(u32x4){PKW(pB0,0),PKW(pB0,2),PKW(pB0,4),PKW(pB0,6)};pw1=(u32x4){PKW(pB0,8),PKW(pB0,10),PKW(pB0,12),PKW(pB0,14)};pw2=(u32x4){PKW(pB1,0),PKW(pB1,2),PKW(pB1,4),PKW(pB1,6)};pw3=(u32x4){PKW(pB1,8),PKW(pB1,10),PKW(pB1,12),PKW(pB1,14)};
    SBAR(); pv(o,vb0+sl_cur,PAF(0),PAF(1),PAF(2),PAF(3)); }
  #undef PKW
  #undef PAF
  #undef VFR
  #undef PIN
  #undef MX3
  #undef GAPA
  #undef GAPB
  #undef EX
  #undef VRD
  #undef KRD
  #undef STEP
  #undef ENDW
  {auto rr=__builtin_amdgcn_permlane32_swap(__float_as_uint(l_reg),__float_as_uint(l_reg),false,false);l_reg=__uint_as_float(rr[0])+__uint_as_float(rr[1]);}
  if(hi==0)wsf[32+r32]=l_reg;asm volatile("s_waitcnt lgkmcnt(0)":::"memory");
  float rli[16];
  #pragma unroll
  for(int r=0;r<16;++r)rli[r]=__builtin_amdgcn_rcpf(wsf[32+crow(r,hi)]);
  bf16*Ow=O+(rowbase+q0+wid*QBLK)*DM+h*D;
  { bf16*stg=(bf16*)(shm+LDS_OST)+wid*2048;
    #pragma unroll
    for(int r=0;r<16;++r){const int orow=crow(r,hi);
      #pragma unroll
      for(int d0=0;d0<2;++d0)stg[orow*64+d0*32+r32]=__float2bfloat16(o[d0][r]*rli[r]);}
    asm volatile("s_waitcnt lgkmcnt(0)":::"memory");
    #pragma unroll
    for(int i=0;i<4;++i){const int row=i*8+(lane>>3),ch=lane&7; const u32x4 v=*(const u32x4*)(stg+row*64+ch*8); ATTN_STORE16(Ow+(long)row*DM+ch*8,v);} }
  asm volatile("s_waitcnt lgkmcnt(0)\n\ts_barrier":::"memory");
  #undef DMA_K
  #undef DMA_V
  #undef CMASK
  #undef START
  #undef RESC
  #undef ROT
  #undef BIAS
}
constexpr int ATTN_LDS_BYTES=LDS_BYTES;
#undef SBAR
#undef WAIT_BAR
}

typedef unsigned short bf16_t;
typedef float f32x4 __attribute__((ext_vector_type(4)));
typedef unsigned u32x4 __attribute__((ext_vector_type(4)));
typedef unsigned u32x2 __attribute__((ext_vector_type(2)));
#define LAS __attribute__((address_space(3)))

constexpr int LDS_BYTES = 147456;
constexpr int NWAVES = 8;

__device__ __forceinline__ unsigned f2bf(float f) { unsigned u = __builtin_bit_cast(unsigned, f); return (u + 0x7fffu + ((u >> 16) & 1u)) >> 16; }
typedef float f32x2_c __attribute__((ext_vector_type(2))); typedef __bf16 bf16x2_c __attribute__((ext_vector_type(2)));
__device__ __forceinline__ unsigned pk2(float lo, float hi) { const f32x2_c v = {lo, hi}; return __builtin_bit_cast(unsigned, __builtin_convertvector(v, bf16x2_c)); }
__device__ __forceinline__ float bf2f(unsigned short h) { return __builtin_bit_cast(float, (unsigned)h << 16); }
__device__ __forceinline__ float shfl_idx(float v, int src_lane) { return __builtin_bit_cast(float, __builtin_amdgcn_ds_bpermute(src_lane << 2, __builtin_bit_cast(int, v))); }
__device__ __forceinline__ float wave_sum(float v, int lane) {
#pragma unroll
    for (int o = 1; o < 64; o <<= 1) v += shfl_idx(v, lane ^ o);
    return v;
}
__device__ __forceinline__ float wave_max(float v, int lane) {
#pragma unroll
    for (int o = 1; o < 64; o <<= 1) v = fmaxf(v, shfl_idx(v, lane ^ o));
    return v;
}
__device__ __forceinline__ float lane_bcast(float v, int l) { return __builtin_bit_cast(float, __builtin_amdgcn_readlane(__builtin_bit_cast(int, v), l)); }

struct Args { const float* in[21]; float* out; unsigned char* ws; int ph_lo, ph_hi; };

struct WDesc { const float* W; const float* g; const float* W2; bf16_t* WT; int K, Nsrc, Ndst, kind; };
__device__ __forceinline__ void prep_item(const WDesc& d, int item, LAS float* scr, int lane) {
    const int nblk = d.Ndst / 32, kb = item / nblk, nb = item % nblk, k0 = 64 * kb, n0 = 32 * nb;
    int sc0 = n0, lim = d.Nsrc;
    if (d.kind == 1) { const int t = n0 >> 8, half = (n0 >> 7) & 1; sc0 = half * FF + t * 128 + (n0 & 127); }
    else if (d.kind == 2) { if (n0 >= 1792) sc0 = n0 - 240; else if (n0 > 1536) {
            if (n0 == 1568 && kb == 0) {
                bf16_t* T = d.WT + (size_t)1600 * d.K;
#pragma unroll
                for (int i = 0; i < 4; ++i) { const int n = 4 * lane + i; float w[16];
#pragma unroll
                    for (int r = 0; r < 16; ++r) w[r] = d.W2[r * 256 + n];
                    u32x4 o0, o1; o0.x = pk2(w[0], w[1]); o0.y = pk2(w[2], w[3]); o0.z = pk2(w[4], w[5]); o0.w = pk2(w[6], w[7]); o1.x = pk2(w[8], w[9]); o1.y = pk2(w[10], w[11]); o1.z = pk2(w[12], w[13]); o1.w = pk2(w[14], w[15]);
                    *(u32x4*)(T + n * 32) = o0; *(u32x4*)(T + n * 32 + 8) = o1; *(u32x4*)(T + n * 32 + 16) = (u32x4){0u, 0u, 0u, 0u}; *(u32x4*)(T + n * 32 + 24) = (u32x4){0u, 0u, 0u, 0u}; }
            }
            return; }
        else if (n0 == 1536) lim = 1552; }
    else if (d.kind == 3) { if (n0 >= 3104) return; }
    {
        const int kr = lane >> 3, c4 = (lane & 7) * 4, col = sc0 + c4;
        const bool ok = col + 3 < lim;
        f32x4 v[8]; float gg[8];
#pragma unroll
        for (int i = 0; i < 8; ++i) v[i] = ok ? __builtin_nontemporal_load((const f32x4*)(d.W + (size_t)(k0 + 8 * i + kr) * d.Nsrc + col)) : (f32x4){0.f, 0.f, 0.f, 0.f};
        if (d.g) {
#pragma unroll
            for (int i = 0; i < 8; ++i) gg[i] = d.g[k0 + 8 * i + kr];
        } else {
#pragma unroll
            for (int i = 0; i < 8; ++i) gg[i] = 1.0f;
        }
#pragma unroll
        for (int i = 0; i < 8; ++i) { LAS float* p = scr + (8 * i + kr) * 33 + c4; p[0] = v[i][0] * gg[i]; p[1] = v[i][1] * gg[i]; p[2] = v[i][2] * gg[i]; p[3] = v[i][3] * gg[i]; }
    }
    asm volatile("s_waitcnt lgkmcnt(0)" ::: "memory");
    const int c = lane & 7;
#pragma unroll
    for (int j = 0; j < 4; ++j) {
        const int n = (lane >> 3) + 8 * j; const LAS float* s = scr + (8 * c) * 33 + n;
        u32x4 o; o.x = pk2(s[0 * 33], s[1 * 33]); o.y = pk2(s[2 * 33], s[3 * 33]); o.z = pk2(s[4 * 33], s[5 * 33]); o.w = pk2(s[6 * 33], s[7 * 33]);
        *(u32x4*)(d.WT + (size_t)(n0 + n) * d.K + k0 + 8 * c) = o;
    }
    asm volatile("s_waitcnt lgkmcnt(0)" ::: "memory");
}
constexpr int I_GU = 16 * 176, I_DN = 44 * 32, I_IN = 16 * 104, I_OUT = 16 * 32;
constexpr int IT_GU = 0, IT_DN = 4 * I_GU, IT_IN = IT_DN + 4 * I_DN, IT_OUT = IT_IN + 2 * I_IN, IT_END = IT_OUT + 2 * I_OUT;
__device__ __forceinline__ void convert_items(const Args& a, LAS unsigned char* lds, int lo, int hi, int w, int nw, int wave, int lane) {
    LAS float* scr = (LAS float*)(lds + wave * 16384);
    unsigned char* ws = a.ws;
    const float* norm_g = a.in[8];
    for (int it = lo + w; it < hi; it += nw) {
        int r = it; WDesc d;
        if (r < 4 * I_GU) { const int i = r / I_GU; r -= i * I_GU;
            d = WDesc{a.in[9] + (size_t)i * DM * 2 * FF, norm_g + ((i >> 1) * 3 + (i & 1) * 2) * DM, nullptr, (bf16_t*)(ws + WS_WGU + i * SZ_WGU), DM, 2 * FF, 2 * FF, 1}; }
        else if ((r -= 4 * I_GU) < 4 * I_DN) { const int i = r / I_DN; r -= i * I_DN;
            d = WDesc{a.in[10] + (size_t)i * FF * DM, nullptr, nullptr, (bf16_t*)(ws + WS_WDN + i * SZ_WDN), FF, DM, DM, 0}; }
        else if ((r -= 4 * I_DN) < I_IN) d = WDesc{a.in[11], norm_g + 1 * DM, a.in[12], (bf16_t*)(ws + WS_WIN), DM, 3088, NIN, 2};
        else if ((r -= I_IN) < I_IN)     d = WDesc{a.in[17], norm_g + 4 * DM, nullptr, (bf16_t*)(ws + WS_WIN + SZ_WIN), DM, 3088, NIN, 3};
        else if ((r -= I_IN) < I_OUT)    d = WDesc{a.in[16], nullptr, nullptr, (bf16_t*)(ws + WS_WOUT), DM, DM, DM, 0};
        else { r -= I_OUT;               d = WDesc{a.in[19], nullptr, nullptr, (bf16_t*)(ws + WS_WOUT + SZ_WOUT), DM, DM, DM, 0}; }
        prep_item(d, r, scr, lane);
    }
}
__device__ __forceinline__ void convert_job(const Args& a, LAS unsigned char* lds, int job, int w, int nw, int wave, int lane) {
    switch (job) {
        case 0:  convert_items(a, lds, IT_GU, IT_GU + I_GU, w, nw, wave, lane); break;
        case 1:  convert_items(a, lds, IT_DN, IT_DN + I_DN, w, nw, wave, lane);
                 convert_items(a, lds, IT_IN, IT_IN + I_IN, w, nw, wave, lane);
                 convert_items(a, lds, IT_OUT, IT_OUT + I_OUT, w, nw, wave, lane);
                 convert_items(a, lds, IT_GU + I_GU, IT_GU + 2 * I_GU, w, nw, wave, lane); break;
        case 3:  convert_items(a, lds, IT_DN + I_DN, IT_DN + 2 * I_DN, w, nw, wave, lane);
                 convert_items(a, lds, IT_GU + 2 * I_GU, IT_GU + 3 * I_GU, w, nw, wave, lane); break;
        case 4:  convert_items(a, lds, IT_DN + 2 * I_DN, IT_DN + 3 * I_DN, w, nw, wave, lane);
                 convert_items(a, lds, IT_IN + I_IN, IT_IN + 2 * I_IN, w, nw, wave, lane);
                 convert_items(a, lds, IT_OUT + I_OUT, IT_OUT + 2 * I_OUT, w, nw, wave, lane);
                 convert_items(a, lds, IT_GU + 3 * I_GU, IT_GU + 4 * I_GU, w, nw, wave, lane); break;
        default: convert_items(a, lds, IT_DN + 3 * I_DN, IT_DN + 4 * I_DN, w, nw, wave, lane); break;
    }
}
__device__ __forceinline__ void p0_prologue(const Args& a, LAS unsigned char* lds, int gw, int NGW, int wave, int lane) {
    unsigned char* ws = a.ws;
    convert_job(a, lds, 0, gw, NGW, wave, lane);
    { int t9 = threadIdx.x; asm volatile("" : "+v"(t9)); lane = t9 & 63; }
    { float* pz = (float*)(ws + WS_PART + SZ_PART); for (int i = gw * 64 + lane; i < 6 * MT; i += NGW * 64) pz[i] = 0.f; }
    bf16_t* XB = (bf16_t*)(ws + WS_XB); float* part0 = (float*)(ws + WS_PART);
    for (int row = gw; row < MT; row += NGW) {
        const float* src = (row < MP) ? a.in[0] + (size_t)row * DM : a.in[1] + (size_t)(row - MP) * DM;
        float ss = 0.f;
        f32x4 xv[4];
#pragma unroll
        for (int j = 0; j < 4; ++j) xv[j] = __builtin_nontemporal_load((const f32x4*)src + lane + 64 * j);
#pragma unroll
        for (int j = 0; j < 4; ++j) {
            const f32x4 v = xv[j];
            ss += (v[0] * v[0] + v[1] * v[1]) + (v[2] * v[2] + v[3] * v[3]);
            u32x2 w; w.x = pk2(v[0], v[1]); w.y = pk2(v[2], v[3]);
            ((u32x2*)(XB + (size_t)row * DM))[lane + 64 * j] = w;
        }
        ss = wave_sum(ss, lane);
        if (lane == 0) part0[row] = ss;
    }
}
__device__ __forceinline__ void final_norm(const Args& a, int gw, int NGW, int lane) {
    const bf16_t* XB = (const bf16_t*)(a.ws + WS_XB); const float* part = (const float*)(a.ws + WS_PART + 6 * SZ_PART); const float* g = a.in[20];
    for (int row = gw; row < MT; row += NGW) {
        const float r = 1.0f / sqrtf(part[row] * (1.0f / 1024.0f) + EPS);
#pragma unroll
        for (int j = 0; j < 4; ++j) {
            const u32x2 w = ((const u32x2*)(XB + (size_t)row * DM))[lane + 64 * j]; const f32x4 gg = ((const f32x4*)g)[lane + 64 * j];
            const f32x4 v = {__builtin_bit_cast(float, w.x << 16), __builtin_bit_cast(float, w.x & 0xffff0000u), __builtin_bit_cast(float, w.y << 16), __builtin_bit_cast(float, w.y & 0xffff0000u)};
            ((f32x4*)(a.out + O_YP + (size_t)row * DM))[lane + 64 * j] = v * r * gg;
        }
    }
}
__device__ __forceinline__ float scan_incl(float v, int lane) {
#pragma unroll
    for (int o = 1; o < 64; o <<= 1) { const float t = shfl_idx(v, lane - o); if (lane >= o) v += t; }
    return v;
}
__device__ __forceinline__ float scan_incl_rev(float v, int lane) {
#pragma unroll
    for (int o = 1; o < 64; o <<= 1) { const float t = shfl_idx(v, lane + o); if (lane + o < 64) v += t; }
    return v;
}

typedef short bf16x8_t __attribute__((ext_vector_type(8)));
typedef float f32x16_t __attribute__((ext_vector_type(16)));
__device__ __forceinline__ int crow_(int r, int hi) { return (r & 3) + 8 * (r >> 2) + 4 * hi; }
template <int KS> __device__ __forceinline__ f32x16_t mma_tile(const LAS bf16_t* A, int lda, const LAS bf16_t* Bt, int ldb, f32x16_t acc, int r32, int hi, int aswz = 0, int bswz = 0) {
#pragma unroll
    for (int ks = 0; ks < KS; ++ks) {
        const bf16x8_t a = *(const LAS bf16x8_t*)(A + r32 * lda + 8 * ((2 * ks + hi) ^ aswz));
        const bf16x8_t b = *(const LAS bf16x8_t*)(Bt + r32 * ldb + 8 * ((2 * ks + hi) ^ bswz));
        acc = __builtin_amdgcn_mfma_f32_32x32x16_bf16(a, b, acc, 0, 0, 0);
    }
    return acc;
}
constexpr int G_BC = 0, G_QIN = 16384, G_KIN = 25600, G_ATT = 34816, G_VT = 44032, G_ST = 62464, G_SSQ = 80896, G_ATL = 81920, G_END = 90112;
__device__ __forceinline__ void unpack8(const u32x4 w, float (&k)[8]) {
    k[0] = __builtin_bit_cast(float, w.x << 16); k[1] = __builtin_bit_cast(float, w.x & 0xffff0000u); k[2] = __builtin_bit_cast(float, w.y << 16); k[3] = __builtin_bit_cast(float, w.y & 0xffff0000u);
    k[4] = __builtin_bit_cast(float, w.z << 16); k[5] = __builtin_bit_cast(float, w.z & 0xffff0000u); k[6] = __builtin_bit_cast(float, w.w << 16); k[7] = __builtin_bit_cast(float, w.w & 0xffff0000u);
}
template <int L> __device__ __forceinline__ void gla_bcum(LAS float* bc, const float* LOGA, size_t row0, int h, int lane) {
    float la[L];
#pragma unroll
    for (int j = 0; j < L; ++j) la[j] = LOGA[(row0 + j) * 256 + h * 64 + lane];
    float run = 0.f;
#pragma unroll
    for (int j = 0; j < L; ++j) { run += la[j]; bc[j * 64 + lane] = run; }
}
__device__ __forceinline__ void put_vt(LAS bf16_t* Vt, int ldj, int v0, int j, const u32x4 a, const u32x4 b) {
    const unsigned w[8] = {a.x, a.y, a.z, a.w, b.x, b.y, b.z, b.w};
#pragma unroll
    for (int e = 0; e < 8; ++e) { Vt[(v0 + 2 * e) * ldj + j] = (bf16_t)(w[e] & 0xffffu); Vt[(v0 + 2 * e + 1) * ldj + j] = (bf16_t)(w[e] >> 16); }
}
template <int L> __device__ __forceinline__ void gla_u_unit(LAS unsigned char* lds, const bf16_t* EB, const float* LOGA, size_t row0, int h, float* Uout, float* ATOT, const float* s0, float* sfin) {
    int tid_ = threadIdx.x; asm volatile("" : "+v"(tid_));
    const int tid = tid_, lane = tid & 63, wave = __builtin_amdgcn_readfirstlane(tid >> 6), r32 = lane & 31, hi = lane >> 5;
    constexpr int LDJ = L + 8;
    LAS float* bc = (LAS float*)(lds + G_BC); LAS bf16_t* KsT = (LAS bf16_t*)(lds + G_KIN); LAS bf16_t* Vt = (LAS bf16_t*)(lds + G_VT);
    if (wave == 0) gla_bcum<L>(bc, LOGA, row0, h, lane);
    __syncthreads();
    {
        const int j = tid >> 3, c8 = tid & 7;
        if (j < L) {
            const size_t row = row0 + j;
            float kf[8]; unpack8(*(const u32x4*)(EB + row * NIN + 256 + h * 64 + 8 * c8), kf);
            const f32x4 b0 = *(const LAS f32x4*)(bc + j * 64 + 8 * c8), b1 = *(const LAS f32x4*)(bc + j * 64 + 8 * c8 + 4);
            const f32x4 l0 = *(const LAS f32x4*)(bc + (L - 1) * 64 + 8 * c8), l1 = *(const LAS f32x4*)(bc + (L - 1) * 64 + 8 * c8 + 4);
#pragma unroll
            for (int e = 0; e < 4; ++e) {
                KsT[(8 * c8 + e) * LDJ + j] = (bf16_t)f2bf(kf[e] * __expf(l0[e] - b0[e]));
                KsT[(8 * c8 + 4 + e) * LDJ + j] = (bf16_t)f2bf(kf[4 + e] * __expf(l1[e] - b1[e]));
            }
            const u32x4 va = *(const u32x4*)(EB + row * NIN + 512 + h * 128 + 16 * c8), vb = *(const u32x4*)(EB + row * NIN + 512 + h * 128 + 16 * c8 + 8);
            put_vt(Vt, LDJ, 16 * c8, j, va, vb);
        }
    }
    __syncthreads();
    const int kt = wave >> 2, vt = wave & 3;
    f32x16_t acc = {};
    acc = mma_tile<L / 16>(KsT + 32 * kt * LDJ, LDJ, Vt + 32 * vt * LDJ, LDJ, acc, r32, hi);
#pragma unroll
    for (int r = 0; r < 16; ++r) {
        const int k = 32 * kt + crow_(r, hi), v = 32 * vt + r32;
        if (s0 == nullptr) Uout[k * 128 + v] = acc[r];
        else sfin[k * 128 + v] = __expf(bc[(L - 1) * 64 + k]) * s0[k * 128 + v] + acc[r];
    }
    if (s0 == nullptr && tid < 64) ATOT[tid] = __expf(bc[(L - 1) * 64 + tid]);
    __syncthreads();
}
template <int L> __device__ __forceinline__ void gla_o_unit(LAS unsigned char* lds, const bf16_t* EB, const float* LOGA, size_t row0, int h, int n, const float* Ub, const float* Ab, const float* s0,
                                                            const float* gnorm, bf16_t* OAB, float* pstate) {
    int tid_ = threadIdx.x; asm volatile("" : "+v"(tid_));
    const int tid = tid_, lane = tid & 63, wave = __builtin_amdgcn_readfirstlane(tid >> 6), r32 = lane & 31, hi = lane >> 5;
    constexpr int LDJ = L + 8, NIT = (L + 31) / 32, LDK = 72;
    LAS float* bc = (LAS float*)(lds + G_BC); LAS bf16_t* Qin = (LAS bf16_t*)(lds + G_QIN); LAS bf16_t* Kin = (LAS bf16_t*)(lds + G_KIN); LAS bf16_t* att = (LAS bf16_t*)(lds + G_ATT);
    LAS bf16_t* Vt = (LAS bf16_t*)(lds + G_VT); LAS bf16_t* St = (LAS bf16_t*)(lds + G_ST); LAS float* ssq = (LAS float*)(lds + G_SSQ); LAS float* atl = (LAS float*)(lds + G_ATL);
    if (wave == 0) gla_bcum<L>(bc, LOGA, row0, h, lane);
    const int nat = s0 ? 0 : (pstate ? n + 1 : n);
    for (int i = tid; i < nat * 64; i += 512) atl[i] = Ab[i];
    __syncthreads();
    {
        float S[16];
        const int k0 = tid >> 7, v = tid & 127;
        if (s0) {
#pragma unroll
            for (int i = 0; i < 16; ++i) S[i] = s0[tid + 512 * i];
        } else {
#pragma unroll
            for (int i = 0; i < 16; ++i) S[i] = 0.f;
            for (int m = 0; m < n; ++m) {
                const float* um = Ub + (size_t)m * 8192 + tid;
#pragma unroll
                for (int i = 0; i < 16; ++i) S[i] = atl[m * 64 + k0 + 4 * i] * S[i] + um[512 * i];
            }
            if (pstate) {
                const float* um = Ub + (size_t)n * 8192 + tid;
#pragma unroll
                for (int i = 0; i < 16; ++i) pstate[tid + 512 * i] = atl[n * 64 + k0 + 4 * i] * S[i] + um[512 * i];
            }
        }
#pragma unroll
        for (int i = 0; i < 16; ++i) St[v * LDK + k0 + 4 * i] = (bf16_t)f2bf(S[i]);
    }
    {
        const int j = tid >> 3, c8 = tid & 7;
        if (j < L) {
            const size_t row = row0 + j;
            float qf[8], kf[8]; unpack8(*(const u32x4*)(EB + row * NIN + h * 64 + 8 * c8), qf); unpack8(*(const u32x4*)(EB + row * NIN + 256 + h * 64 + 8 * c8), kf);
            const f32x4 b0 = *(const LAS f32x4*)(bc + j * 64 + 8 * c8), b1 = *(const LAS f32x4*)(bc + j * 64 + 8 * c8 + 4);
            float qi[8], ki[8];
#pragma unroll
            for (int e = 0; e < 4; ++e) { const float e0 = __expf(b0[e]), e1 = __expf(b1[e]); qi[e] = qf[e] * e0; qi[4 + e] = qf[4 + e] * e1; ki[e] = kf[e] * __builtin_amdgcn_rcpf(e0); ki[4 + e] = kf[4 + e] * __builtin_amdgcn_rcpf(e1); }
            u32x4 qw, kw; qw.x = pk2(qi[0], qi[1]); qw.y = pk2(qi[2], qi[3]); qw.z = pk2(qi[4], qi[5]); qw.w = pk2(qi[6], qi[7]);
            kw.x = pk2(ki[0], ki[1]); kw.y = pk2(ki[2], ki[3]); kw.z = pk2(ki[4], ki[5]); kw.w = pk2(ki[6], ki[7]);
            *(LAS u32x4*)(Qin + j * LDK + 8 * c8) = qw; *(LAS u32x4*)(Kin + j * LDK + 8 * c8) = kw;
            const u32x4 va = *(const u32x4*)(EB + row * NIN + 512 + h * 128 + 16 * c8), vb = *(const u32x4*)(EB + row * NIN + 512 + h * 128 + 16 * c8 + 8);
            put_vt(Vt, LDJ, 16 * c8, j, va, vb);
        } else if (j < 32 * NIT) {
            const u32x4 z = {0u, 0u, 0u, 0u};
            *(LAS u32x4*)(Qin + j * LDK + 8 * c8) = z; *(LAS u32x4*)(Kin + j * LDK + 8 * c8) = z;
        }
    }
    __syncthreads();
    const int vt = wave >> 1, it = wave & 1;
    f32x16_t acc = {};
    if (it < NIT) acc = mma_tile<4>(St + 32 * vt * LDK, LDK, Qin + 32 * it * LDK, LDK, acc, r32, hi);
    if (wave < NIT * NIT) {
        const int ti = wave / NIT, tj = wave % NIT;
        f32x16_t s = {};
        s = mma_tile<4>(Qin + 32 * ti * LDK, LDK, Kin + 32 * tj * LDK, LDK, s, r32, hi);
        const int j = 32 * tj + r32;
        if (j < L) {
#pragma unroll
            for (int r = 0; r < 16; ++r) { const int i = 32 * ti + crow_(r, hi); att[i * LDJ + j] = (bf16_t)f2bf(i >= j ? s[r] : 0.f); }
        }
    }
    __syncthreads();
    if (it < NIT) acc = mma_tile<L / 16>(Vt + 32 * vt * LDJ, LDJ, att + 32 * it * LDJ, LDJ, acc, r32, hi);
    {
        float ss = 0.f;
#pragma unroll
        for (int r = 0; r < 16; ++r) ss += acc[r] * acc[r];
        ss += shfl_idx(ss, lane ^ 32);
        if (it < NIT && hi == 0) ssq[vt * 64 + 32 * it + r32] = ss;
    }
    u32x2 gwv[4]; f32x4 gnv[4];
#pragma unroll
    for (int gq = 0; gq < 4; ++gq) { const int v0 = 32 * vt + 8 * gq + 4 * hi; const int ic = (32 * it + r32 < L) ? 32 * it + r32 : 0;
        gwv[gq] = *(const u32x2*)(EB + (row0 + ic) * NIN + 1024 + h * 128 + v0); gnv[gq] = *(const f32x4*)(gnorm + v0); }
    __syncthreads();
    if (it < NIT) {
        const int i = 32 * it + r32;
        if (i < L) {
            const float tot = (ssq[i] + ssq[64 + i]) + (ssq[128 + i] + ssq[192 + i]);
            const float rr = __builtin_amdgcn_rsqf(tot * (1.0f / 128.0f) + EPS);
            const size_t row = row0 + i;
#pragma unroll
            for (int g = 0; g < 4; ++g) {
                const int v0 = 32 * vt + 8 * g + 4 * hi;
                const u32x2 gw = gwv[g]; const f32x4 gn = gnv[g];
                const float o0 = acc[4 * g + 0] * rr * gn[0] * __builtin_bit_cast(float, gw.x << 16), o1 = acc[4 * g + 1] * rr * gn[1] * __builtin_bit_cast(float, gw.x & 0xffff0000u);
                const float o2 = acc[4 * g + 2] * rr * gn[2] * __builtin_bit_cast(float, gw.y << 16), o3 = acc[4 * g + 3] * rr * gn[3] * __builtin_bit_cast(float, gw.y & 0xffff0000u);
                u32x2 ow; ow.x = pk2(o0, o1); ow.y = pk2(o2, o3);
                *(u32x2*)(OAB + row * DM + h * 128 + v0) = ow;
            }
        }
    }
    __syncthreads();
}

__device__ __forceinline__ void gla_m1_group(LAS unsigned char* lds, const bf16_t* EB, const float* LOGA, int bh, int g4, bf16_t* QIN, bf16_t* KIN, float* GU, float* GA, float* GT, float* GAG) {
    int tid_ = threadIdx.x; asm volatile("" : "+v"(tid_));
    const int tid = tid_, lane = tid & 63, wave = __builtin_amdgcn_readfirstlane(tid >> 6), r32 = lane & 31, hi = lane >> 5;
    constexpr int LDJ = 72;
    LAS float* bc = (LAS float*)(lds + G_BC); LAS bf16_t* KsT = (LAS bf16_t*)(lds + G_KIN); LAS bf16_t* Vt = (LAS bf16_t*)(lds + G_VT); LAS float* tot = (LAS float*)(lds + G_ATL);
    const int b = bh >> 2, h = bh & 3, kt = wave >> 2, vt = wave & 3;
    const int j = tid >> 3, c8 = tid & 7;
    const int jsw = (((j >> 3) ^ c8) << 3) | (j & 7);
    f32x16_t T = {};
    float blsum = 0.f;
    struct In { float la[8]; u32x4 q, k, va, vb; };
    auto load_in = [&](In& s, int n) {
        const size_t row0 = (size_t)b * TSEQ + 64 * n, row = row0 + j;
#pragma unroll
        for (int i = 0; i < 8; ++i) s.la[i] = LOGA[(row0 + 8 * wave + i) * 256 + h * 64 + lane];
        s.q = *(const u32x4*)(EB + row * NIN + h * 64 + 8 * c8); s.k = *(const u32x4*)(EB + row * NIN + 256 + h * 64 + 8 * c8);
        s.va = *(const u32x4*)(EB + row * NIN + 512 + h * 128 + 16 * c8); s.vb = *(const u32x4*)(EB + row * NIN + 512 + h * 128 + 16 * c8 + 8);
    };
    In in[2];
    load_in(in[0], 4 * g4);
#pragma unroll
    for (int c = 0; c < 4; ++c) {
        In& s = in[c & 1];
        const int n = 4 * g4 + c; const size_t row0 = (size_t)b * TSEQ + 64 * n;
        {
            float run = 0.f;
#pragma unroll
            for (int i = 0; i < 8; ++i) { run += s.la[i]; s.la[i] = run; }
            tot[wave * 64 + lane] = run;
            __syncthreads();
            float off = 0.f;
            for (int w2 = 0; w2 < wave; ++w2) off += tot[w2 * 64 + lane];
#pragma unroll
            for (int i = 0; i < 8; ++i) bc[(8 * wave + i) * 64 + lane] = s.la[i] + off;
        }
        __syncthreads();
        {
            const size_t row = row0 + j;
            float qf[8], kf[8]; unpack8(s.q, qf); unpack8(s.k, kf);
            const f32x4 b0 = *(const LAS f32x4*)(bc + j * 64 + 8 * c8), b1 = *(const LAS f32x4*)(bc + j * 64 + 8 * c8 + 4);
            const f32x4 l0 = *(const LAS f32x4*)(bc + 63 * 64 + 8 * c8), l1 = *(const LAS f32x4*)(bc + 63 * 64 + 8 * c8 + 4);
            float qi[8], ki[8];
#pragma unroll
            for (int e = 0; e < 4; ++e) {
                const float e0 = __expf(b0[e]), e1 = __expf(b1[e]), r0 = __builtin_amdgcn_rcpf(e0), r1 = __builtin_amdgcn_rcpf(e1);
                qi[e] = qf[e] * e0; qi[4 + e] = qf[4 + e] * e1; ki[e] = kf[e] * r0; ki[4 + e] = kf[4 + e] * r1;
                KsT[(8 * c8 + e) * LDJ + jsw] = (bf16_t)f2bf(ki[e] * __expf(l0[e])); KsT[(8 * c8 + 4 + e) * LDJ + jsw] = (bf16_t)f2bf(ki[4 + e] * __expf(l1[e]));
            }
            u32x4 qw, kw; qw.x = pk2(qi[0], qi[1]); qw.y = pk2(qi[2], qi[3]); qw.z = pk2(qi[4], qi[5]); qw.w = pk2(qi[6], qi[7]);
            kw.x = pk2(ki[0], ki[1]); kw.y = pk2(ki[2], ki[3]); kw.z = pk2(ki[4], ki[5]); kw.w = pk2(ki[6], ki[7]);
            *(u32x4*)(QIN + row * 256 + h * 64 + 8 * c8) = qw; *(u32x4*)(KIN + row * 256 + h * 64 + 8 * c8) = kw;
            put_vt(Vt, LDJ, 16 * c8, jsw, s.va, s.vb);
        }
        if (c < 3) load_in(in[(c + 1) & 1], n + 1);
        __syncthreads();
        {
            f32x16_t acc = {};
            acc = mma_tile<4>(KsT + 32 * kt * LDJ, LDJ, Vt + 32 * vt * LDJ, LDJ, acc, r32, hi, (4 * kt + (r32 >> 3)) & 7, (2 * vt + (r32 >> 4)) & 7);
            float* Un = GU + (size_t)(bh * 32 + n) * 8192;
#pragma unroll
            for (int r = 0; r < 16; ++r) {
                const int k = 32 * kt + crow_(r, hi), v = 32 * vt + r32;
                Un[k * 128 + v] = acc[r];
                T[r] = __expf(bc[63 * 64 + k]) * T[r] + acc[r];
            }
            if (tid < 64) { const float bl = bc[63 * 64 + tid]; GA[(size_t)(bh * 32 + n) * 64 + tid] = __expf(bl); blsum += bl; }
        }
        __syncthreads();
    }
    {
        float* Tg = GT + (size_t)(bh * 8 + g4) * 8192;
#pragma unroll
        for (int r = 0; r < 16; ++r) __hip_atomic_store(Tg + (32 * kt + crow_(r, hi)) * 128 + 32 * vt + r32, T[r], __ATOMIC_RELAXED, __HIP_MEMORY_SCOPE_AGENT);
        if (tid < 64) __hip_atomic_store(GAG + (size_t)(bh * 8 + g4) * 64 + tid, __expf(blsum), __ATOMIC_RELAXED, __HIP_MEMORY_SCOPE_AGENT);
    }
}
__device__ __forceinline__ void gla_m2_group(LAS unsigned char* lds, const bf16_t* EB, int bh, int g4, const bf16_t* QIN, const bf16_t* KIN, const float* GU, const float* GA, const float* GT, const float* GAG,
                                             const float* gnorm, bf16_t* OAB, float* pstate) {
    int tid_ = threadIdx.x; asm volatile("" : "+v"(tid_));
    const int tid = tid_, lane = tid & 63, wave = __builtin_amdgcn_readfirstlane(tid >> 6), r32 = lane & 31, hi = lane >> 5;
    constexpr int LDJ = 72, LDK = 72;
    LAS bf16_t* Qin = (LAS bf16_t*)(lds + G_QIN); LAS bf16_t* Kin = (LAS bf16_t*)(lds + G_KIN); LAS bf16_t* att = (LAS bf16_t*)(lds + G_ATT);
    LAS bf16_t* Vt = (LAS bf16_t*)(lds + G_VT); LAS bf16_t* St = (LAS bf16_t*)(lds + G_ST); LAS float* ssq = (LAS float*)(lds + G_SSQ); LAS float* atl = (LAS float*)(lds + G_ATL);
    const int b = bh >> 2, h = bh & 3, k0 = 16 * (tid >> 7), v = tid & 127, vt = wave >> 1, it = wave & 1;
    const int j = tid >> 3, c8 = tid & 7, jsw = (((j >> 3) ^ c8) << 3) | (j & 7);
    struct In { float un[16]; u32x4 q, k, va, vb; u32x2 gw[4]; };
    auto load_in = [&](In& s, int n) {
        const size_t row0 = (size_t)b * TSEQ + 64 * n, row = row0 + j;
        s.q = *(const u32x4*)(QIN + row * 256 + h * 64 + 8 * c8); s.k = *(const u32x4*)(KIN + row * 256 + h * 64 + 8 * c8);
        s.va = *(const u32x4*)(EB + row * NIN + 512 + h * 128 + 16 * c8); s.vb = *(const u32x4*)(EB + row * NIN + 512 + h * 128 + 16 * c8 + 8);
#pragma unroll
        for (int g = 0; g < 4; ++g) s.gw[g] = *(const u32x2*)(EB + (row0 + 32 * it + r32) * NIN + 1024 + h * 128 + 32 * vt + 8 * g + 4 * hi);
        const float* up = GU + (size_t)(bh * 32 + n) * 8192 + k0 * 128 + v;
#pragma unroll
        for (int i = 0; i < 16; ++i) s.un[i] = up[128 * i];
    };
    In in[2];
    load_in(in[0], 4 * g4);
    f32x4 gnv[4];
#pragma unroll
    for (int g = 0; g < 4; ++g) gnv[g] = *(const f32x4*)(gnorm + 32 * vt + 8 * g + 4 * hi);
    for (int i = tid; i < g4 * 64; i += 512) atl[i] = GAG[(size_t)bh * 8 * 64 + i];
    for (int i = tid; i < 4 * 64; i += 512) atl[g4 * 64 + i] = GA[(size_t)(bh * 32 + 4 * g4) * 64 + i];
    __syncthreads();
    float S[16];
#pragma unroll
    for (int i = 0; i < 16; ++i) S[i] = 0.f;
    for (int g = 0; g < g4; ++g) {
        const float* tg = GT + (size_t)(bh * 8 + g) * 8192 + k0 * 128 + v;
        float tgv[16];
#pragma unroll
        for (int i = 0; i < 16; ++i) tgv[i] = tg[128 * i];
#pragma unroll
        for (int i = 0; i < 16; ++i) S[i] = atl[g * 64 + k0 + i] * S[i] + tgv[i];
    }
#pragma unroll
    for (int c = 0; c < 4; ++c) {
        In& s = in[c & 1];
        const int n = 4 * g4 + c; const size_t row0 = (size_t)b * TSEQ + 64 * n;
        { u32x4 w0, w1; w0.x = pk2(S[0], S[1]); w0.y = pk2(S[2], S[3]); w0.z = pk2(S[4], S[5]); w0.w = pk2(S[6], S[7]);
          w1.x = pk2(S[8], S[9]); w1.y = pk2(S[10], S[11]); w1.z = pk2(S[12], S[13]); w1.w = pk2(S[14], S[15]);
          *(LAS u32x4*)(St + v * LDK + k0) = w0; *(LAS u32x4*)(St + v * LDK + k0 + 8) = w1; }
        *(LAS u32x4*)(Qin + j * LDK + 8 * c8) = s.q; *(LAS u32x4*)(Kin + j * LDK + 8 * c8) = s.k;
        put_vt(Vt, LDJ, 16 * c8, jsw, s.va, s.vb);
        if (c < 3) load_in(in[(c + 1) & 1], n + 1);
        __syncthreads();
        f32x16_t acc = {};
        acc = mma_tile<4>(St + 32 * vt * LDK, LDK, Qin + 32 * it * LDK, LDK, acc, r32, hi);
        if (wave < 4) {
            const int ti = wave >> 1, tj = wave & 1;
            f32x16_t sc = {};
            sc = mma_tile<4>(Qin + 32 * ti * LDK, LDK, Kin + 32 * tj * LDK, LDK, sc, r32, hi);
            const int jj = 32 * tj + r32;
#pragma unroll
            for (int r = 0; r < 16; ++r) { const int i = 32 * ti + crow_(r, hi); att[i * LDJ + jj] = (bf16_t)f2bf(i >= jj ? sc[r] : 0.f); }
        }
        __syncthreads();
        acc = mma_tile<4>(Vt + 32 * vt * LDJ, LDJ, att + 32 * it * LDJ, LDJ, acc, r32, hi, (2 * vt + (r32 >> 4)) & 7, 0);
        {
            float ss = 0.f;
#pragma unroll
            for (int r = 0; r < 16; ++r) ss += acc[r] * acc[r];
            ss += shfl_idx(ss, lane ^ 32);
            if (hi == 0) ssq[vt * 64 + 32 * it + r32] = ss;
        }
        __syncthreads();
        {
            const int i = 32 * it + r32;
            const float tot = (ssq[i] + ssq[64 + i]) + (ssq[128 + i] + ssq[192 + i]);
            const float rr = __builtin_amdgcn_rsqf(tot * (1.0f / 128.0f) + EPS);
            const size_t row = row0 + i;
#pragma unroll
            for (int g = 0; g < 4; ++g) {
                const int v0 = 32 * vt + 8 * g + 4 * hi;
                const u32x2 gw = s.gw[g];
                const f32x4 gn = gnv[g];
                const float o0 = acc[4 * g + 0] * rr * gn[0] * __builtin_bit_cast(float, gw.x << 16), o1 = acc[4 * g + 1] * rr * gn[1] * __builtin_bit_cast(float, gw.x & 0xffff0000u);
                const float o2 = acc[4 * g + 2] * rr * gn[2] * __builtin_bit_cast(float, gw.y << 16), o3 = acc[4 * g + 3] * rr * gn[3] * __builtin_bit_cast(float, gw.y & 0xffff0000u);
                u32x2 ow; ow.x = pk2(o0, o1); ow.y = pk2(o2, o3);
                *(u32x2*)(OAB + row * DM + h * 128 + v0) = ow;
            }
        }
#pragma unroll
        for (int i = 0; i < 16; ++i) S[i] = atl[(g4 + c) * 64 + k0 + i] * S[i] + s.un[i];
    }
    if (pstate) {
#pragma unroll
        for (int i = 0; i < 16; ++i) pstate[(k0 + i) * 128 + v] = S[i];
    }
    __syncthreads();
}

constexpr int SA_CB = 0, SA_OW = 16384, SA_MW = 81920, SA_LW = 82944, SA_FQ = 83968, SA_TOT = 84096, SA_END = 84224;
constexpr float FOX_SKIP2 = 160.0f * LOG2E;
template <int MODE> __device__ __forceinline__ void sample_attn_unit(LAS unsigned char* lds, const bf16_t* EB, int qcol, int kcol, int vcol, const float* ck, const float* cv, int kstr, int Lc,
                                                                       int b, int h, const float* clf  , const float* LOGF, const float* relb, bf16_t* OAB, int ocol) {
    int tid_ = threadIdx.x; asm volatile("" : "+v"(tid_));
    const int tid = tid_, lane = tid & 63, wave = __builtin_amdgcn_readfirstlane(tid >> 6), r32 = lane & 31, hi = lane >> 5;
    const size_t row0 = (size_t)MP + b * SSEQ;
    LAS float* cb = (LAS float*)(lds + SA_CB); LAS float* ow = (LAS float*)(lds + SA_OW); LAS float* mw = (LAS float*)(lds + SA_MW); LAS float* lw = (LAS float*)(lds + SA_LW);
    LAS float* fqb = (LAS float*)(lds + SA_FQ); LAS float* tot = (LAS float*)(lds + SA_TOT);
    if (MODE == 0) {
        float carry = 0.f;
        float lfv[8];
#pragma unroll
        for (int c = 0; c < 8; ++c) lfv[c] = clf[(size_t)(512 * wave + 64 * c + lane) * 16 + h];
#pragma unroll
        for (int c = 7; c >= 0; --c) {
            const int key = 512 * wave + 64 * c + lane;
            const float lf = lfv[c];
            const float suf = scan_incl_rev(lf, lane);
            cb[key] = carry + suf - lf;
            carry += lane_bcast(suf, 0);
        }
        if (lane == 0) tot[wave] = carry;
        if (wave == 0) { const float lf = (lane < 16) ? LOGF[(row0 + lane) * 16 + h] : 0.f; const float fq = scan_incl(lf, lane); if (lane < 16) fqb[lane] = -fq * LOG2E; }
        __syncthreads();
        float off = 0.f;
        for (int w2 = wave + 1; w2 < 8; ++w2) off += tot[w2];
        for (int c = 0; c < 8; ++c) { const int key = 512 * wave + 64 * c + lane; cb[key] = (cb[key] + off) * LOG2E; }
    } else {
        for (int x = tid; x < 320; x += NWAVES * 64) cb[x] = relb[h * 257 + (x < 256 ? x : 256)] * LOG2E;
    }
    __syncthreads();
    int s_first = 0;
    if (MODE == 0) {
        LAS int* smin = (LAS int*)(lds + SA_TOT + 64);
        if (tid == 0) *smin = Lc / 32 - 1;
        __syncthreads();
        if (tid < Lc / 32 && cb[32 * tid + 31] >= -FOX_SKIP2) atomicMin((int*)smin, tid);
        __syncthreads();
        s_first = __builtin_amdgcn_readfirstlane(*smin);
    }
    bf16x8_t qf[4];
#pragma unroll
    for (int ds = 0; ds < 4; ++ds) qf[ds] = *(const bf16x8_t*)(EB + (row0 + (r32 & 15)) * NIN + qcol + h * 64 + 16 * ds + 8 * hi);
    float m = -INFINITY, l = 0.f; f32x16_t o0 = {}, o1 = {};
    const int q = r32;
    auto softmax_pv = [&](f32x16_t s, const bf16x8_t (&vf)[2][2]) {
        float mx = s[0];
#pragma unroll
        for (int r = 1; r < 16; ++r) mx = fmaxf(mx, s[r]);
        mx = fmaxf(mx, shfl_idx(mx, lane ^ 32));
        const float mn = fmaxf(m, mx), alpha = __builtin_amdgcn_exp2f(m - mn);
        float ps = 0.f; float p[16];
#pragma unroll
        for (int r = 0; r < 16; ++r) { p[r] = __builtin_amdgcn_exp2f(s[r] - mn); ps += p[r]; }
        l = l * alpha + ps; m = mn;
#pragma unroll
        for (int r = 0; r < 16; ++r) { o0[r] *= alpha; o1[r] *= alpha; }
        u32x4 w0, w1; w0.x = pk2(p[0], p[1]); w0.y = pk2(p[2], p[3]); w0.z = pk2(p[4], p[5]); w0.w = pk2(p[6], p[7]);
        w1.x = pk2(p[8], p[9]); w1.y = pk2(p[10], p[11]); w1.z = pk2(p[12], p[13]); w1.w = pk2(p[14], p[15]);
        const bf16x8_t pf0 = __builtin_bit_cast(bf16x8_t, w0), pf1 = __builtin_bit_cast(bf16x8_t, w1);
        o0 = __builtin_amdgcn_mfma_f32_32x32x16_bf16(vf[0][0], pf0, o0, 0, 0, 0); o0 = __builtin_amdgcn_mfma_f32_32x32x16_bf16(vf[0][1], pf1, o0, 0, 0, 0);
        o1 = __builtin_amdgcn_mfma_f32_32x32x16_bf16(vf[1][0], pf0, o1, 0, 0, 0); o1 = __builtin_amdgcn_mfma_f32_32x32x16_bf16(vf[1][1], pf1, o1, 0, 0, 0);
    };
    const int n_sub = Lc / 32 - s_first;
    const int NS = (((n_sub + 7) >> 3) + 1) & ~1;
    auto load_kv = [&](f32x4 (&ka)[4][2], float (&vv)[2][2][8], int key0) {
        const float* kp = ck + (size_t)(key0 + r32) * kstr + 8 * hi;
#pragma unroll
        for (int ds = 0; ds < 4; ++ds) { ka[ds][0] = *(const f32x4*)(kp + 16 * ds); ka[ds][1] = *(const f32x4*)(kp + 16 * ds + 4); }
#pragma unroll
        for (int db = 0; db < 2; ++db)
#pragma unroll
            for (int ks = 0; ks < 2; ++ks)
#pragma unroll
                for (int j = 0; j < 8; ++j) vv[db][ks][j] = cv[(size_t)(key0 + 16 * ks + 8 * (j >> 2) + 4 * hi + (j & 3)) * kstr + 32 * db + r32];
    };
    auto step = [&](const f32x4 (&ka)[4][2], const float (&vv)[2][2][8], int key0) {
        f32x16_t s = {};
#pragma unroll
        for (int ds = 0; ds < 4; ++ds) {
            u32x4 w; w.x = pk2(ka[ds][0][0], ka[ds][0][1]); w.y = pk2(ka[ds][0][2], ka[ds][0][3]); w.z = pk2(ka[ds][1][0], ka[ds][1][1]); w.w = pk2(ka[ds][1][2], ka[ds][1][3]);
            s = __builtin_amdgcn_mfma_f32_32x32x16_bf16(__builtin_bit_cast(bf16x8_t, w), qf[ds], s, 0, 0, 0);
        }
        bf16x8_t vf[2][2];
#pragma unroll
        for (int db = 0; db < 2; ++db)
#pragma unroll
            for (int ks = 0; ks < 2; ++ks) { u32x4 w; w.x = pk2(vv[db][ks][0], vv[db][ks][1]); w.y = pk2(vv[db][ks][2], vv[db][ks][3]); w.z = pk2(vv[db][ks][4], vv[db][ks][5]); w.w = pk2(vv[db][ks][6], vv[db][ks][7]);
                vf[db][ks] = __builtin_bit_cast(bf16x8_t, w); }
        if (MODE == 0) {
#pragma unroll
            for (int g = 0; g < 4; ++g) { const f32x4 bb = *(const LAS f32x4*)(cb + key0 + 8 * g + 4 * hi);
#pragma unroll
                for (int e = 0; e < 4; ++e) s[4 * g + e] += bb[e]; }
        } else {
#pragma unroll
            for (int r = 0; r < 16; ++r) { const int ix = (Lc - (key0 + crow_(r, hi))) + (q & 15) + 128; s[r] += cb[ix > 256 ? 256 : ix]; }
        }
        softmax_pv(s, vf);
    };
    {
        f32x4 kaA[4][2], kaB[4][2]; float vvA[2][2][8], vvB[2][2][8];
        const int kbase = 32 * (s_first + wave * NS);
        if (kbase < Lc) load_kv(kaA, vvA, kbase);
        for (int sub = 0; sub < NS; sub += 2) {
            const int kA = kbase + 32 * sub, kB = kA + 32, kC = kA + 64;
            if (kB < Lc) load_kv(kaB, vvB, kB);
            if (kA < Lc) step(kaA, vvA, kA);
            if (sub + 2 < NS && kC < Lc) load_kv(kaA, vvA, kC);
            if (kB < Lc) step(kaB, vvB, kB);
        }
    }
    if (wave == 0) {
        f32x16_t s = {};
#pragma unroll
        for (int ds = 0; ds < 4; ++ds) { const bf16x8_t kf = *(const bf16x8_t*)(EB + (row0 + (r32 & 15)) * NIN + kcol + h * 64 + 16 * ds + 8 * hi); s = __builtin_amdgcn_mfma_f32_32x32x16_bf16(kf, qf[ds], s, 0, 0, 0); }
        bf16x8_t vf[2][2];
#pragma unroll
        for (int db = 0; db < 2; ++db)
#pragma unroll
            for (int ks = 0; ks < 2; ++ks) { bf16x8_t t;
#pragma unroll
                for (int j = 0; j < 8; ++j) t[j] = (short)EB[(row0 + ((16 * ks + 8 * (j >> 2) + 4 * hi + (j & 3)) & 15)) * NIN + vcol + h * 64 + 32 * db + r32];
                vf[db][ks] = t; }
#pragma unroll
        for (int r = 0; r < 16; ++r) {
            const int kn = crow_(r, hi);
            float bias;
            if (MODE == 0) bias = (kn < 16 && kn <= (q & 15)) ? fqb[kn & 15] : -INFINITY;
            else bias = (kn < 16) ? cb[(q & 15) - (kn & 15) + 128] : -INFINITY;
            s[r] += bias;
        }
        softmax_pv(s, vf);
    }
    {
        const float lt = l + shfl_idx(l, lane ^ 32);
        if (hi == 0) { mw[wave * 32 + q] = m; lw[wave * 32 + q] = lt; }
#pragma unroll
        for (int r = 0; r < 16; ++r) { ow[(wave * 64 + crow_(r, hi)) * 32 + q] = o0[r]; ow[(wave * 64 + 32 + crow_(r, hi)) * 32 + q] = o1[r]; }
    }
    __syncthreads();
    {
        const int qq = tid & 15, d0 = tid >> 4;
        float mm = mw[qq];
#pragma unroll
        for (int w = 1; w < 8; ++w) mm = fmaxf(mm, mw[w * 32 + qq]);
        float lt = 0.f, a0 = 0.f, a1 = 0.f;
#pragma unroll
        for (int w = 0; w < 8; ++w) { const float sc = __builtin_amdgcn_exp2f(mw[w * 32 + qq] - mm); lt += sc * lw[w * 32 + qq]; a0 += sc * ow[(w * 64 + d0) * 32 + qq]; a1 += sc * ow[(w * 64 + 32 + d0) * 32 + qq]; }
        const float inv = 1.0f / lt;
        OAB[(row0 + qq) * DM + ocol + h * 64 + d0] = (bf16_t)f2bf(a0 * inv); OAB[(row0 + qq) * DM + ocol + h * 64 + 32 + d0] = (bf16_t)f2bf(a1 * inv);
    }
    __syncthreads();
}

__device__ __forceinline__ void mini_gemm_unit(LAS unsigned char* lds, const bf16_t* A, const bf16_t* Bt, int K, int rb, int cbk, const float* xold, unsigned char* ws, int pout, float coef, const float* fin_gain, float* fin_out) {
    int tid_ = threadIdx.x; asm volatile("" : "+v"(tid_));
    const int tid = tid_, lane = tid & 63, wave = __builtin_amdgcn_readfirstlane(tid >> 6), r32 = lane & 31, hi = lane >> 5;
    const int kw = K >> 3;
    const bf16_t* ap = A + (size_t)(32 * rb + r32) * K + wave * kw + 8 * hi;
    const bf16_t* bp = Bt + (size_t)(32 * cbk + r32) * K + wave * kw + 8 * hi;
    f32x16_t acc0 = {};
    const int nks = kw / 16;
    for (int k0 = 0; k0 < nks; k0 += 12) {
        bf16x8_t a[12], b[12];
#pragma unroll
        for (int s = 0; s < 12; ++s) if (k0 + s < nks) { a[s] = *(const bf16x8_t*)(ap + 16 * (k0 + s)); b[s] = *(const bf16x8_t*)(bp + 16 * (k0 + s)); }
#pragma unroll
        for (int s = 0; s < 12; ++s) if (k0 + s < nks) acc0 = __builtin_amdgcn_mfma_f32_32x32x16_bf16(a[s], b[s], acc0, 0, 0, 0);
    }
    LAS float* red = (LAS float*)lds;
#pragma unroll
    for (int r = 0; r < 16; ++r) red[(wave * 32 + crow_(r, hi)) * 32 + r32] = acc0[r];
    __syncthreads();
    {
        const int row = tid >> 4, c2 = (tid & 15) * 2;
        typedef float f32x2_m __attribute__((ext_vector_type(2)));
        f32x2_m s = *(const LAS f32x2_m*)(red + row * 32 + c2);
#pragma unroll
        for (int w = 1; w < 8; ++w) s += *(const LAS f32x2_m*)(red + (w * 32 + row) * 32 + c2);
        const int grow = 32 * rb + row, col = 32 * cbk + c2;
        bf16_t* XB = (bf16_t*)(ws + WS_XB) + (size_t)(MP + grow) * DM + col;
        f32x2_m xo;
        if (xold) xo = *(const f32x2_m*)(xold + (size_t)grow * DM + col);
        else { const unsigned w = *(const unsigned*)XB; xo = (f32x2_m){__builtin_bit_cast(float, w << 16), __builtin_bit_cast(float, w & 0xffff0000u)}; }
        const f32x2_m xn = xo + s * coef;
        if (!fin_gain) *(unsigned*)XB = pk2(xn[0], xn[1]);
        float ss = xn[0] * xn[0] + xn[1] * xn[1];
        ss += shfl_idx(ss, lane ^ 1); ss += shfl_idx(ss, lane ^ 2); ss += shfl_idx(ss, lane ^ 4); ss += shfl_idx(ss, lane ^ 8);
        float* prow = (float*)(ws + WS_PART + (size_t)pout * SZ_PART) + (MP + grow);
        if ((tid & 15) == 0) atomicAdd(prow, ss);
        if (fin_gain) {
            unsigned* cnt = (unsigned*)(ws + 40960) + 16 * rb;
            asm volatile("s_waitcnt vmcnt(0)" ::: "memory");
            __syncthreads();
            if (tid == 0) {
                __hip_atomic_fetch_add(cnt, 1u, __ATOMIC_RELAXED, __HIP_MEMORY_SCOPE_AGENT);
                for (unsigned spins = 0; spins < (1u << 22); ++spins) { if (__hip_atomic_load(cnt, __ATOMIC_RELAXED, __HIP_MEMORY_SCOPE_AGENT) >= 32u) break; __builtin_amdgcn_s_sleep(2); }
                __builtin_amdgcn_fence(__ATOMIC_ACQUIRE, "agent");
                asm volatile("s_waitcnt vmcnt(0)" ::: "memory");
            }
            __syncthreads();
            const float r = __builtin_amdgcn_rsqf(__hip_atomic_load(prow, __ATOMIC_RELAXED, __HIP_MEMORY_SCOPE_AGENT) * (1.0f / 1024.0f) + EPS);
            const f32x2_m g = *(const f32x2_m*)(fin_gain + col);
            *(f32x2_m*)(fin_out + (size_t)grow * DM + col) = xn * r * g;
        }
    }
    __syncthreads();
}

template <int ODD>
__device__ __forceinline__ void proj16_tiles(LAS unsigned char* lds, unsigned char* ws, float* out, const float* bias, int base  , int only_q0) {
    int tid_ = threadIdx.x; asm volatile("" : "+v"(tid_));
    const int tid = tid_, lane = tid & 63, wave = __builtin_amdgcn_readfirstlane(tid >> 6), r16 = lane & 15, kq = lane >> 4, q = wave & 3, kh = wave >> 2;
    const int tile = (only_q0 && q != 0) ? -1 : base + 256 * q;
    const bf16_t* XB = (const bf16_t*)(ws + WS_XB);
    const bf16_t* W16 = (const bf16_t*)(ws + WS_WIN + (ODD ? SZ_WIN : 0)) + (size_t)(ODD ? 3072 : 1536) * DM;
    const float* part = (const float*)(ws + WS_PART + (size_t)(ODD ? 4 : 1) * SZ_PART);
    LAS float* red = (LAS float*)lds;
    LAS float* art = red + 1024;
    LAS unsigned char* wsm = lds + 8192;
    LAS unsigned char* tsm = lds + 8192 + 16 * 2064;
    float pss = 0.f; bf16x8_t xa[16];
    if (tile >= 0) {
        pss = part[16 * tile + r16];
        const bf16_t* xp = XB + (size_t)(16 * tile + r16) * DM + 512 * kh + 8 * kq;
#pragma unroll
        for (int s = 0; s < 16; ++s) xa[s] = *(const bf16x8_t*)(xp + 32 * s);
    }
    {
        u32x4 wv[4], tv[2];
#pragma unroll
        for (int i = 0; i < 4; ++i) wv[i] = *(const u32x4*)(W16 + (size_t)(tid + 512 * i) * 8);
        if (!ODD) {
            const bf16_t* T = (const bf16_t*)(ws + WS_WIN) + (size_t)1600 * DM;
#pragma unroll
            for (int i = 0; i < 2; ++i) tv[i] = *(const u32x4*)(T + (size_t)(tid + 512 * i) * 8);
        }
#pragma unroll
        for (int i = 0; i < 4; ++i) { const int idx = tid + 512 * i; *(LAS u32x4*)(wsm + (idx >> 7) * 2064 + (idx & 127) * 16) = wv[i]; }
        if (!ODD) {
#pragma unroll
            for (int i = 0; i < 2; ++i) { const int idx = tid + 512 * i; *(LAS u32x4*)(tsm + (idx >> 2) * 80 + (idx & 3) * 16) = tv[i]; }
        }
    }
    __syncthreads();
    f32x4 acc = {0.f, 0.f, 0.f, 0.f};
    if (tile >= 0) {
        const LAS unsigned char* wl = wsm + r16 * 2064 + (512 * kh + 8 * kq) * 2;
#pragma unroll
        for (int s = 0; s < 16; ++s) acc = __builtin_amdgcn_mfma_f32_16x16x32_bf16(*(const LAS bf16x8_t*)(wl + 64 * s), xa[s], acc, 0, 0, 0);
        if (kh == 1) *(LAS f32x4*)(red + (q * 64 + lane) * 4) = acc;
    }
    __syncthreads();
    if (kh == 0 && tile >= 0) {
        acc += *(const LAS f32x4*)(red + (q * 64 + lane) * 4);
        const int row = 16 * tile + r16;
        const float rinv = __builtin_amdgcn_rsqf(pss * (1.0f / 1024.0f) + EPS);
        if (ODD) {
            const f32x4 bo = *(const f32x4*)(bias + 4 * kq);
            f32x4 o;
#pragma unroll
            for (int i = 0; i < 4; ++i) o[i] = pg8::logsigmoid_f(acc[i] * rinv + bo[i]);
            *(f32x4*)((float*)(ws + WS_LOGF) + (size_t)row * 16 + 4 * kq) = o;
            float* dst = (row < MP) ? out + O_PFL + (size_t)row * 16 + 4 * kq : out + O_SFL + (size_t)(row - MP) * 16 + 4 * kq;
            *(f32x4*)dst = o;
        } else {
            *(LAS f32x4*)(art + (q * 16 + r16) * 16 + 4 * kq) = acc * rinv;
        }
    }
    if (!ODD) {
        __syncthreads();
        if (tile >= 0) {
            f32x4 bv[8];
#pragma unroll
            for (int jj = 0; jj < 8; ++jj) bv[jj] = *(const f32x4*)(bias + 16 * (8 * kh + jj) + 4 * kq);
            u32x4 rw = {0u, 0u, 0u, 0u};
            if (kq < 2) { const LAS float* ar = art + (q * 16 + r16) * 16 + 8 * kq; const f32x4 a0 = *(const LAS f32x4*)ar, a1 = *(const LAS f32x4*)(ar + 4);
                          rw.x = pk2(a0[0], a0[1]); rw.y = pk2(a0[2], a0[3]); rw.z = pk2(a1[0], a1[1]); rw.w = pk2(a1[2], a1[3]); }
            const bf16x8_t rb = __builtin_bit_cast(bf16x8_t, rw);
            float* LG = (float*)(ws + WS_LOGA) + (size_t)(16 * tile + r16) * 256 + 4 * kq;
#pragma unroll
            for (int jj = 0; jj < 8; ++jj) {
                const bf16x8_t wf = *(const LAS bf16x8_t*)(tsm + (16 * (8 * kh + jj) + r16) * 80 + 16 * kq);
                const f32x4 d = __builtin_amdgcn_mfma_f32_16x16x32_bf16(wf, rb, (f32x4){0.f, 0.f, 0.f, 0.f}, 0, 0, 0);
                f32x4 o;
#pragma unroll
                for (int i = 0; i < 4; ++i) o[i] = pg8::logsigmoid_f(d[i] + bv[jj][i]) * (1.0f / 16.0f);
                *(f32x4*)(LG + 16 * (8 * kh + jj)) = o;
            }
        }
    }
    __syncthreads();
}
template <int ODD>
__device__ __forceinline__ void sample_in_unit(LAS unsigned char* lds, unsigned char* ws, float* out, int u) {
    int tid_ = threadIdx.x; asm volatile("" : "+v"(tid_));
    const int tid = tid_, lane = tid & 63, wave = __builtin_amdgcn_readfirstlane(tid >> 6), r32 = lane & 31, hi = lane >> 5;
    const int rb = u / 24, cb = u - 24 * rb;
    const int col0 = 128 * cb + ((!ODD && cb >= 12) ? 256 : 0);
    const bf16_t* ap = (const bf16_t*)(ws + WS_XB) + (size_t)(MP + 32 * rb + r32) * DM + wave * 128 + 8 * hi;
    const bf16_t* bp = (const bf16_t*)(ws + WS_WIN + (ODD ? SZ_WIN : 0)) + (size_t)(col0 + r32) * DM + wave * 128 + 8 * hi;
    f32x16_t acc[4] = {};
#pragma unroll 2
    for (int ks = 0; ks < 8; ++ks) {
        const bf16x8_t a = *(const bf16x8_t*)(ap + 16 * ks);
        bf16x8_t b[4];
#pragma unroll
        for (int j = 0; j < 4; ++j) b[j] = *(const bf16x8_t*)(bp + (size_t)32 * j * DM + 16 * ks);
#pragma unroll
        for (int j = 0; j < 4; ++j) acc[j] = __builtin_amdgcn_mfma_f32_32x32x16_bf16(a, b[j], acc[j], 0, 0, 0);
    }
    LAS float* red = (LAS float*)lds;
#pragma unroll
    for (int j = 0; j < 4; ++j)
#pragma unroll
        for (int r = 0; r < 16; ++r) red[(wave * 32 + crow_(r, hi)) * 128 + 32 * j + r32] = acc[j][r];
    __syncthreads();
    {
        const int row = tid >> 4, c8 = (tid & 15) * 8;
        f32x4 s0 = *(const LAS f32x4*)(red + row * 128 + c8), s1 = *(const LAS f32x4*)(red + row * 128 + c8 + 4);
#pragma unroll
        for (int w = 1; w < 8; ++w) { s0 += *(const LAS f32x4*)(red + (w * 32 + row) * 128 + c8); s1 += *(const LAS f32x4*)(red + (w * 32 + row) * 128 + c8 + 4); }
        const int srow = 32 * rb + row;
        const float* part = (const float*)(ws + WS_PART + (size_t)(ODD ? 4 : 1) * SZ_PART);
        float sc = 1.0f; bool silu = false; float* fo = nullptr; int fpitch = 0, fcol = 0;
        if (ODD) {
            if (col0 < 1024) sc = QSCALE2;
            else if (col0 < 2048) { fo = out + O_SFK; fpitch = 1024; fcol = col0 - 1024; }
            else { fo = out + O_SFV; fpitch = 1024; fcol = col0 - 2048; }
        } else {
            if (col0 < 256) sc = 0.125f;
            else if (col0 >= 1024 && col0 < 1536) silu = true;
            else if (col0 >= 1792 && col0 < 2304) sc = QSCALE2;
            else if (col0 >= 2304 && col0 < 2816) { fo = out + O_SBK; fpitch = 512; fcol = col0 - 2304; }
            else if (col0 >= 2816) { fo = out + O_SBV; fpitch = 512; fcol = col0 - 2816; }
        }
        const float r = __builtin_amdgcn_rsqf(part[MP + srow] * (1.0f / 1024.0f) + EPS) * sc;
        float v[8];
#pragma unroll
        for (int i = 0; i < 4; ++i) { v[i] = s0[i] * r; v[4 + i] = s1[i] * r; }
        if (silu) {
#pragma unroll
            for (int e = 0; e < 8; ++e) v[e] = pg8::silu_f(v[e]);
        }
        u32x4 w; w.x = pk2(v[0], v[1]); w.y = pk2(v[2], v[3]); w.z = pk2(v[4], v[5]); w.w = pk2(v[6], v[7]);
        *(u32x4*)((bf16_t*)(ws + WS_EB) + (size_t)(MP + srow) * NIN + col0 + c8) = w;
        if (fo) { float* dst = fo + (size_t)srow * fpitch + fcol + c8; *(f32x4*)dst = (f32x4){v[0], v[1], v[2], v[3]}; *(f32x4*)(dst + 4) = (f32x4){v[4], v[5], v[6], v[7]}; }
    }
    __syncthreads();
}

__device__ __forceinline__ void fox_f2(LAS float* F2, LAS float* tot, const float* LOGF, int b, int h, int tid) {
    const int lane = tid & 63, w = tid >> 6;
    float carry = 0.f;
    float lfv[4];
#pragma unroll
    for (int c = 0; c < 4; ++c) lfv[c] = LOGF[((size_t)b * TSEQ + 256 * w + 64 * c + lane) * 16 + h];
#pragma unroll
    for (int c = 0; c < 4; ++c) {
        const int t = 256 * w + 64 * c + lane;
        const float F = carry + scan_incl(lfv[c], lane);
        F2[t] = F; carry = lane_bcast(F, 63);
    }
    if (lane == 0) tot[w] = carry;
    __syncthreads();
    float off = 0.f;
    for (int w2 = 0; w2 < w; ++w2) off += tot[w2];
#pragma unroll
    for (int c = 0; c < 4; ++c) { const int t = 256 * w + 64 * c + lane; F2[t] = (F2[t] + off) * LOG2E; }
    __syncthreads();
}

#define XB_TMO      128
#define XB_XCNT(j)  (256  + 64 * (j))
#define XB_XSUB(j)  (1280 + 64 * (j))
#define XB_XGEN(j)  (2304 + 64 * (j))
#define XB_TOP      3328
#define XB_TOPGEN   3392
#define XCD_BAR_WORDS 3456
#define XB_SPIN_CAP (1u << 18)

__device__ __forceinline__ unsigned xb_ld(unsigned* p)              { return __hip_atomic_load(p, __ATOMIC_RELAXED, __HIP_MEMORY_SCOPE_AGENT); }
__device__ __forceinline__ unsigned xb_add(unsigned* p, unsigned v) { return __hip_atomic_fetch_add(p, v, __ATOMIC_RELAXED, __HIP_MEMORY_SCOPE_AGENT); }
__device__ __forceinline__ unsigned xb_xcc_id() { return (unsigned)__builtin_amdgcn_s_getreg((3 << 11) | 20) & 0xFu; }
#define XB_SPIN(cond, bar) do { unsigned _sp = 0; while (cond) { __builtin_amdgcn_s_sleep(1); \
    if ((++_sp & 255u) == 0u) { if (xb_ld(&(bar)[XB_TMO])) break; if (_sp > XB_SPIN_CAP) { atomicAdd(&(bar)[XB_TMO], 1u); break; } } } } while (0)

struct XcdBarrier {
    unsigned* bar; unsigned x;
    volatile LAS unsigned* st;
};

__device__ __forceinline__ XcdBarrier xcd_barrier_post(unsigned* bar, volatile LAS unsigned* st) {
    XcdBarrier b; b.bar = bar; b.x = xb_xcc_id(); b.st = st;
    if (threadIdx.x == 0) (void)xb_add(&bar[XB_XCNT(b.x)], 1u);
    return b;
}
__device__ __forceinline__ void xcd_barrier_complete(unsigned* bar, unsigned x, unsigned& nloc, unsigned& nx) {
    const unsigned G = gridDim.x * gridDim.y * gridDim.z;
    unsigned sum, cnt, mine, sp = 0u;
    for (;;) {
        sum = 0u; cnt = 0u; mine = 0u;
#pragma unroll
        for (unsigned j = 0; j < 16; ++j) { const unsigned c = xb_ld(&bar[XB_XCNT(j)]); sum += c; cnt += (c > 0u) ? 1u : 0u; mine = (j == x) ? c : mine; }
        if (sum == G) break;
        __builtin_amdgcn_s_sleep(1);
        if ((++sp & 255u) == 0u) { if (xb_ld(&bar[XB_TMO])) break; if (sp > XB_SPIN_CAP) { atomicAdd(&bar[XB_TMO], 1u); break; } }
    }
    nloc = mine > 0u ? mine : 1u; nx = cnt > 0u ? cnt : 1u;
}

__device__ __forceinline__ void xcd_barrier(const XcdBarrier& b) {
    asm volatile("s_waitcnt vmcnt(0)" ::: "memory");
    __syncthreads();
    if (threadIdx.x == 0) {
        unsigned* bar = b.bar;
        __builtin_amdgcn_s_waitcnt(0);
        unsigned nloc = b.st[0], nx = b.st[1];
        if (nloc == 0u) { xcd_barrier_complete(bar, b.x, nloc, nx); b.st[0] = nloc; b.st[1] = nx; }
        const unsigned old = xb_add(&bar[XB_XSUB(b.x)], 1u);
        const unsigned gen = old / nloc;
        if (old + 1u == (gen + 1u) * nloc) {
            __builtin_amdgcn_fence(__ATOMIC_RELEASE, "agent");
            asm volatile("s_waitcnt vmcnt(0)" ::: "memory");
            const unsigned og = xb_add(&bar[XB_TOP], 1u);
            const unsigned tg = og / nx;
            if (og + 1u == (tg + 1u) * nx) xb_add(&bar[XB_TOPGEN], 1u);
            else XB_SPIN(xb_ld(&bar[XB_TOPGEN]) == tg, bar);
            __builtin_amdgcn_fence(__ATOMIC_ACQUIRE, "agent");
            xb_add(&bar[XB_XGEN(b.x)], 1u);
            asm volatile("s_waitcnt vmcnt(0)" ::: "memory");
        } else {
            asm volatile("buffer_inv sc1" ::: "memory");
            XB_SPIN(xb_ld(&bar[XB_TOPGEN]) == gen, bar);
            asm volatile("s_waitcnt vmcnt(0)" ::: "memory");
        }
    }
    __syncthreads();
}

constexpr int LDS_MISC = 131072 + 512;
__device__ __forceinline__ void grid_bar(unsigned char* ws, LAS unsigned char* lds) {
    XcdBarrier b; b.bar = (unsigned*)ws; b.x = xb_xcc_id(); b.st = (volatile LAS unsigned*)(lds + LDS_MISC);
    xcd_barrier(b);
}

#ifndef EN_MASK
#define EN_MASK 255
#endif

__global__ void __launch_bounds__(NWAVES * 64, 2) mega_fwd(Args args) {
    extern __shared__ __attribute__((aligned(16))) unsigned char lds_raw[];
    LAS unsigned char* lds = (LAS unsigned char*)lds_raw;
    cg::grid_group grid = cg::this_grid();
    const int ph_hi = ((const Args*)__builtin_amdgcn_kernarg_segment_ptr())->ph_hi;
    if (threadIdx.x < 32) ((LAS unsigned*)(lds + 131072))[threadIdx.x + 128] = 0u;
    __syncthreads();
    (void)xcd_barrier_post((unsigned*)((const Args*)__builtin_amdgcn_kernarg_segment_ptr())->ws, (volatile LAS unsigned*)(lds + LDS_MISC));
    for (int ph = ((const Args*)__builtin_amdgcn_kernarg_segment_ptr())->ph_lo; ph < ph_hi; ++ph) {
        unsigned zero; asm volatile("s_mov_b32 %0, 0" : "=s"(zero));
        const Args& A = *(const Args*)((const char*)__builtin_amdgcn_kernarg_segment_ptr() + zero);
        int tid = threadIdx.x; asm volatile("" : "+v"(tid));
        const int lane = tid & 63, wave = __builtin_amdgcn_readfirstlane(tid >> 6);
        int G = gridDim.x, bx = blockIdx.x; asm volatile("" : "+s"(G), "+s"(bx));
        const int gw = bx * NWAVES + wave, NGW = G * NWAVES;
        unsigned char* ws = A.ws; float* out = A.out;
        int kind, idx = 0;
        switch (ph) {
            case 0: kind = 0; break;
            case 1: kind = 1; idx = 0; break;  case 6: kind = 1; idx = 1; break;  case 8: kind = 1; idx = 2; break;  case 13: kind = 1; idx = 3; break;
            case 2: kind = 2; idx = 0; break;  case 7: kind = 2; idx = 1; break;  case 9: kind = 2; idx = 2; break;  case 14: kind = 2; idx = 3; break;
            case 3: kind = 3; break;  case 4: kind = 4; break;  case 5: kind = 5; idx = 0; break;
            case 10: kind = 6; break; case 11: kind = 7; break; case 12: kind = 5; idx = 1; break;
            default: kind = 8; break;
        }
        if (kind == 0 && (EN_MASK & 1)) {
            p0_prologue(A, lds, gw, NGW, wave, lane);
        } else if (kind == 1 && (EN_MASK & 2)) {
            const int pin = (idx == 0) ? 0 : (idx == 1) ? 2 : (idx == 2) ? 3 : 5;
            pg8::Gemm g{(const bf16_t*)(ws + WS_XB), (const bf16_t*)(ws + WS_WGU + idx * SZ_WGU), MT, 2 * FF, DM}; pg8::StaticOrder S; S.init(MT, 2 * FF, G, bx);
            pg8::EpiGU E{ws, pin, lds};
            pg8::gemm_phase<pg8::EpiGU, pg8::StaticOrder, true, true>(lds, g, S, E);
            { constexpr int NU = (MT / 256) * (2 * FF / 256); const int first_idle = NU % G;
              const int job = (idx == 0) ? 1 : (idx == 1) ? 3 : (idx == 2) ? 4 : 5;
              if (job >= 0 && bx >= first_idle) { int t5 = threadIdx.x; asm volatile("" : "+v"(t5)); convert_job(A, lds, job, (bx - first_idle) * NWAVES + __builtin_amdgcn_readfirstlane(t5 >> 6), (G - first_idle) * NWAVES, __builtin_amdgcn_readfirstlane(t5 >> 6), t5 & 63); } }
        } else if ((kind == 2 || kind == 5) && (EN_MASK & 4)) {
            const bool dn = kind == 2;
            const int pout = dn ? ((idx == 0) ? 1 : (idx == 1) ? 3 : (idx == 2) ? 4 : 6) : ((idx == 0) ? 2 : 5);
            const bool first = dn && idx == 0;
            const bf16_t* Ap = (const bf16_t*)(dn ? ws + WS_H : ws + WS_OAB); const bf16_t* Btp = (const bf16_t*)(dn ? ws + WS_WDN + idx * SZ_WDN : ws + WS_WOUT + idx * SZ_WOUT);
            const int Kd = dn ? FF : DM;
            { const int vcu = (G % 8 == 0) ? (bx % 8) * (G / 8) + bx / 8 : bx;
              const bool fin = dn && idx == 3 && G == 256;
              for (int u = vcu; u < 256; u += G) mini_gemm_unit(lds, Ap + (size_t)MP * Kd, Btp, Kd, u >> 5, u & 31, nullptr, ws, pout, dn ? 0.5f : 1.0f, fin ? A.in[20] : nullptr, out + O_YS); }
            pg8::Gemm g{Ap, Btp, MP, DM, Kd}; pg8::StaticOrder S; S.init(MP, DM, G, bx);
            if (dn && idx == 3 && G == 256) {
                pg8::EpiFinal E{ws, out + O_YP, A.in[20], 0.5f};
                pg8::gemm_phase<pg8::EpiFinal, pg8::StaticOrder, true, true>(lds, g, S, E);
            } else {
                pg8::EpiRes E{ws, pout, dn ? 0.5f : 1.0f};
                pg8::gemm_phase<pg8::EpiRes, pg8::StaticOrder, true, true>(lds, g, S, E);
            }
        } else if ((kind == 3 || kind == 6) && (EN_MASK & 8)) {
            const bool odd = kind == 6;
            for (int base = bx; base < 256; base += G) { if (odd) proj16_tiles<1>(lds, ws, out, A.in[18], base, 0); else proj16_tiles<0>(lds, ws, out, A.in[13], base, 0); }
            for (int u = bx; u < 208; u += G) {
                if (u < 192) { if (odd) sample_in_unit<1>(lds, ws, out, u); else sample_in_unit<0>(lds, ws, out, u); }
                else { if (odd) proj16_tiles<1>(lds, ws, out, A.in[18], 1024 + (u - 192), 1); else proj16_tiles<0>(lds, ws, out, A.in[13], 1024 + (u - 192), 1); }
            }
            pg8::Gemm g{(const bf16_t*)(ws + WS_XB), (const bf16_t*)(ws + WS_WIN + (odd ? SZ_WIN : 0)), MP, 3072, DM}; pg8::StaticOrder S; S.init(MP, 3072, G, bx, odd ? 1 : 2);
            if (odd) { pg8::EpiInOdd E{ws, out, lds}; pg8::gemm_phase<pg8::EpiInOdd, pg8::StaticOrder, true, true>(lds, g, S, E); }
            else     { pg8::EpiInEven E{ws, out, lds}; pg8::gemm_phase<pg8::EpiInEven, pg8::StaticOrder, true, true>(lds, g, S, E); }
        } else if (kind == 4 && (EN_MASK & 32)) {
            const bf16_t* EB = (const bf16_t*)(ws + WS_EB); bf16_t* OAB = (bf16_t*)(ws + WS_OAB); const float* LOGA = (const float*)(ws + WS_LOGA);
            float* GU = (float*)(ws + WS_GU); float* GA = (float*)(ws + WS_GA);
            const int vcu = (G % 8 == 0) ? (bx % 8) * (G / 8) + bx / 8 : bx;
            unsigned* gflag = (unsigned*)(ws + 49152);
            for (int id = vcu; id < 256; id += G) {
                gla_m1_group(lds, EB, LOGA, id >> 3, id & 7, (bf16_t*)(ws + WS_QIN), (bf16_t*)(ws + WS_KIN), GU, GA, (float*)(ws + WS_GT), (float*)(ws + WS_GAG));
                asm volatile("s_waitcnt vmcnt(0)" ::: "memory");
                __syncthreads();
                { int t7 = threadIdx.x; asm volatile("" : "+v"(t7));
                  if (t7 == 0) __hip_atomic_store(gflag + id, 1u, __ATOMIC_RELAXED, __HIP_MEMORY_SCOPE_AGENT); }
            }
            if (G == 256 && (vcu & 3) < 2) { const int w = vcu >> 2, b = w >> 2, h = w & 3;
                if ((vcu & 3) == 0) gla_u_unit<16>(lds, EB, LOGA, (size_t)MP + b * SSEQ, h, nullptr, nullptr, A.in[2] + (size_t)w * 8192, out + O_SSG + (size_t)w * 8192);
                else gla_o_unit<16>(lds, EB, LOGA, (size_t)MP + b * SSEQ, h, 0, nullptr, nullptr, A.in[2] + (size_t)w * 8192, A.in[14], OAB, nullptr);
            } else if (G != 256) {
                for (int w = vcu; w < 64; w += G) { const int b = w >> 2, h = w & 3;
                    gla_u_unit<16>(lds, EB, LOGA, (size_t)MP + b * SSEQ, h, nullptr, nullptr, A.in[2] + (size_t)w * 8192, out + O_SSG + (size_t)w * 8192);
                    gla_o_unit<16>(lds, EB, LOGA, (size_t)MP + b * SSEQ, h, 0, nullptr, nullptr, A.in[2] + (size_t)w * 8192, A.in[14], OAB, nullptr); }
            }
            {
                LAS float* tab = (LAS float*)(lds + 86016);
                const attn_body::bf16* Qp = (const attn_body::bf16*)EB;
                for (int pr = vcu; pr < 4 * NBATCH * 8; pr += G) {
                    const int bh = pr >> 2, pidx = pr & 3, b = bh >> 3, h = bh & 7;
                    { int tid4 = threadIdx.x; asm volatile("" : "+v"(tid4));
                      for (int x = tid4; x < 320; x += NWAVES * 64) tab[x] = A.in[15][h * 257 + (x < 256 ? x : 256)] * LOG2E;
                      __syncthreads(); }
                    for (int i = 0; i < 2; ++i) {
                        const int qb = (pidx == 0) ? (i == 0 ? 2 : 0) : (pidx == 1) ? (i == 0 ? 3 : 1) : (pidx == 2) ? 4 + i : 6 + i;
                        attn_body::attn_unit<8, 1>(b, h, qb, Qp + 1792, Qp + 2304, Qp + 2816, (attn_body::bf16*)OAB + 512, (char*)lds_raw, tab);
                    }
                }
            }
            for (int u = vcu; u < SBATCH * 8; u += G) { const int b = u >> 3, h = u & 7;
                sample_attn_unit<1>(lds, EB, 1792, 2304, 2816, A.in[3] + ((size_t)b * 512 * 8 + h) * 64, A.in[4] + ((size_t)b * 512 * 8 + h) * 64, 512, 512, b, h, nullptr, nullptr, A.in[15], OAB, 512); }
            for (int id = vcu; id < 256; id += G) { const int bh = id >> 3, g4 = id & 7;
                { int t8 = threadIdx.x; asm volatile("" : "+v"(t8));
                  if (t8 == 0) {
                      for (int g = 0; g < g4; ++g)
                          for (unsigned spins = 0; spins < (1u << 22); ++spins) { if (__hip_atomic_load(gflag + bh * 8 + g, __ATOMIC_RELAXED, __HIP_MEMORY_SCOPE_AGENT) != 0u) break; __builtin_amdgcn_s_sleep(2); }
                      __builtin_amdgcn_fence(__ATOMIC_ACQUIRE, "agent"); asm volatile("s_waitcnt vmcnt(0)" ::: "memory");
                  } }
                __syncthreads();
                gla_m2_group(lds, EB, bh, g4, (const bf16_t*)(ws + WS_QIN), (const bf16_t*)(ws + WS_KIN), GU, GA, (const float*)(ws + WS_GT), (const float*)(ws + WS_GAG), A.in[14], OAB, (g4 == 7) ? out + O_PSG + (size_t)bh * 8192 : nullptr); }
        } else if (kind == 7 && (EN_MASK & 64)) {
            const bf16_t* EB = (const bf16_t*)(ws + WS_EB); bf16_t* OAB = (bf16_t*)(ws + WS_OAB); const float* LOGF = (const float*)(ws + WS_LOGF);
            const int vcu = (G % 8 == 0) ? (bx % 8) * (G / 8) + bx / 8 : bx;
            LAS float* F2 = (LAS float*)(lds + 86016); LAS float* tot = (LAS float*)(lds + 86016 + 8192);
            const attn_body::bf16* Qp = (const attn_body::bf16*)EB;
            for (int pr = vcu; pr < 2 * NBATCH * 16; pr += G) {
                const int p = pr >> 1, e = pr & 1;
                if (e == 0) {
                    for (int u = 2 * p; u < 2 * p + 2; ++u) { const int b = u >> 4, h = u & 15;
                        sample_attn_unit<0>(lds, EB, 0, 1024, 2048, A.in[5] + ((size_t)b * PAST * 16 + h) * 64, A.in[6] + ((size_t)b * PAST * 16 + h) * 64, 1024, PAST, b, h, A.in[7] + (size_t)b * PAST * 16, LOGF, nullptr, OAB, 0); }
                }
                const int b = p >> 4, h = p & 15;
                { int tid3 = threadIdx.x; asm volatile("" : "+v"(tid3)); fox_f2(F2, tot, LOGF, b, h, tid3); }
                unsigned* cnt = (unsigned*)(ws + 16384) + 16 * p; LAS unsigned* slot = (LAS unsigned*)(lds + 86016 + 8192 + 64);
                for (;;) {
                    { int t6 = threadIdx.x; asm volatile("" : "+v"(t6)); if (t6 == 0) *slot = atomicAdd(cnt, 1u); }
                    __syncthreads();
                    const unsigned idxq = (unsigned)__builtin_amdgcn_readfirstlane((int)*slot);
                    __syncthreads();
                    if (idxq >= 8u) break;
                    attn_body::attn_unit<8, 0>(b, h, 7 - (int)idxq, Qp, Qp + 1024, Qp + 2048, (attn_body::bf16*)OAB, (char*)lds_raw, F2);
                }
            }
        } else if (kind == 8 && (EN_MASK & 128)) {
            if (G != 256) final_norm(A, gw, NGW, lane);
        }
        if (ph + 1 < ph_hi) { if (ph_hi > 4096) grid.sync(); else grid_bar(ws, lds); }
    }
}

#ifndef N_LAUNCHES
#define N_LAUNCHES 1
#endif
constexpr int NPHASES = 16;
extern "C" void kernel_launch(void* const* d_in, const int* in_sizes, int n_in, void* d_out, int out_size, void* d_ws, size_t ws_size, hipStream_t stream) {
    static int grid = 0;
    if (grid == 0) {
        if (n_in != 21 || (size_t)out_size != O_END || ws_size < WS_END) { fprintf(stderr, "kernel_launch: unexpected problem: n_in %d out %d (want %zu) ws %zu (want >= %zu)\n", n_in, out_size, (size_t)O_END, ws_size, (size_t)WS_END); grid = -1; return; }
        int dev = 0, cus = 0, per_cu = 0;
        if (hipGetDevice(&dev) != hipSuccess || hipDeviceGetAttribute(&cus, hipDeviceAttributeMultiprocessorCount, dev) != hipSuccess) { grid = -1; return; }
        if (hipFuncSetAttribute((const void*)mega_fwd, hipFuncAttributeMaxDynamicSharedMemorySize, LDS_BYTES) != hipSuccess) { fprintf(stderr, "kernel_launch: hipFuncSetAttribute failed\n"); grid = -1; return; }
        if (hipOccupancyMaxActiveBlocksPerMultiprocessor(&per_cu, (const void*)mega_fwd, NWAVES * 64, LDS_BYTES) != hipSuccess || per_cu < 1) { fprintf(stderr, "kernel_launch: occupancy query says %d\n", per_cu); per_cu = 1; }
        (void)hipGetLastError();
        if (per_cu > 1) per_cu = 1;
        grid = cus * per_cu;
        fprintf(stderr, "kernel_launch: grid %d\n", grid);
    }
    if (grid < 0) return;
    if (hipMemsetAsync(d_ws, 0, 65536, stream) != hipSuccess) { fprintf(stderr, "kernel_launch: hipMemsetAsync failed\n"); return; }
    Args a{};
    for (int i = 0; i < 21; ++i) a.in[i] = (const float*)d_in[i];
    a.out = (float*)d_out; a.ws = (unsigned char*)d_ws;
    if (N_LAUNCHES == 1) {
        a.ph_lo = 0; a.ph_hi = (grid == 256) ? NPHASES - 1 : NPHASES;
        void* kargs[] = {&a};
        hipError_t e = hipLaunchCooperativeKernel((const void*)mega_fwd, dim3(grid), dim3(NWAVES * 64), kargs, LDS_BYTES, stream);
        if (e != hipSuccess) fprintf(stderr, "kernel_launch: cooperative launch failed: %s (grid %d)\n", hipGetErrorString(e), grid);
    } else {
        for (int p = 0; p < NPHASES; ++p) { a.ph_lo = p; a.ph_hi = p + 1; hipLaunchKernelGGL(mega_fwd, dim3(grid), dim3(NWAVES * 64), LDS_BYTES, stream, a); }
    }
}
```

```cpp
#include <hip/hip_runtime.h>
#include <hip/hip_cooperative_groups.h>
#include <cstdio>
#include <cstdint>
namespace cg = cooperative_groups;

constexpr int DM = 1024, TSEQ = 2048, NBATCH = 8, SBATCH = 16, SSEQ = 16, PAST = 4096, FF = 2816;
constexpr int MP = NBATCH * TSEQ;
constexpr int MS = SBATCH * SSEQ;
constexpr int MT = MP + MS;
constexpr int NIN = 3328;
constexpr float LOG2E = 1.4426950408889634f;
constexpr float QSCALE2 = 0.125f * LOG2E;
constexpr float EPS = 1e-6f;

constexpr size_t O_YP = 0, O_YS = O_YP + (size_t)MP * DM, O_PSG = O_YS + (size_t)MS * DM, O_PBK = O_PSG + 8 * 4 * 64 * 128, O_PBV = O_PBK + 8 * 512 * 512,
                 O_PFK = O_PBV + 8 * 512 * 512, O_PFV = O_PFK + (size_t)MP * 1024, O_PFL = O_PFV + (size_t)MP * 1024, O_SSG = O_PFL + (size_t)MP * 16,
                 O_SBK = O_SSG + 16 * 4 * 64 * 128, O_SBV = O_SBK + (size_t)MS * 512, O_SFK = O_SBV + (size_t)MS * 512, O_SFV = O_SFK + (size_t)MS * 1024,
                 O_SFL = O_SFV + (size_t)MS * 1024, O_END = O_SFL + (size_t)MS * 16;
constexpr size_t MiB = 1u << 20;
constexpr size_t WS_WGU = 2 * MiB, SZ_WGU = (size_t)2 * FF * DM * 2;
constexpr size_t WS_WDN = 46 * MiB, SZ_WDN = (size_t)DM * FF * 2;
constexpr size_t WS_WIN = 68 * MiB, SZ_WIN = (size_t)NIN * DM * 2;
constexpr size_t WS_WOUT = 81 * MiB, SZ_WOUT = (size_t)DM * DM * 2;
constexpr size_t WS_X = 96 * MiB;
constexpr size_t WS_XB = 161 * MiB;
constexpr size_t WS_H = 194 * MiB;
constexpr size_t WS_EB = 284 * MiB;
constexpr size_t WS_OAB = 390 * MiB;
constexpr size_t WS_LOGA = 423 * MiB;
constexpr size_t WS_LOGF = 440 * MiB;
constexpr size_t WS_PART = 442 * MiB, SZ_PART = (size_t)MT * 4;
constexpr size_t WS_GU = 450 * MiB;
constexpr size_t WS_GA = 482 * MiB;
constexpr size_t WS_QIN = 484 * MiB, WS_KIN = 492 * MiB;
constexpr size_t WS_GT = 500 * MiB;
constexpr size_t WS_GAG = 508 * MiB;
constexpr size_t WS_END = 510 * MiB;
static_assert(WS_WGU + 4 * SZ_WGU <= WS_WDN && WS_WDN + 4 * SZ_WDN <= WS_WIN && WS_WIN + 2 * SZ_WIN <= WS_WOUT && WS_WOUT + 2 * SZ_WOUT <= WS_X, "ws map 1");
static_assert(WS_X + (size_t)MT * DM * 4 <= WS_XB && WS_XB + (size_t)MT * DM * 2 <= WS_H && WS_H + (size_t)MT * FF * 2 <= WS_EB && WS_EB + (size_t)MT * NIN * 2 <= WS_OAB, "ws map 2");
static_assert(WS_OAB + (size_t)MT * DM * 2 <= WS_LOGA && WS_LOGA + (size_t)MT * 256 * 4 <= WS_LOGF && WS_LOGF + (size_t)MT * 16 * 4 <= WS_PART && WS_PART + 7 * SZ_PART <= WS_END, "ws map 3");

namespace pg8 {
#define PG8_LAS __attribute__((address_space(3)))
typedef unsigned short bf16_t;
typedef short bf16x8 __attribute__((ext_vector_type(8)));
typedef float f32x4 __attribute__((ext_vector_type(4)));
typedef unsigned u32x4 __attribute__((ext_vector_type(4)));
constexpr int BM = 256, BK = 64, HALF = 128, HTB = HALF * BK * 2  , STAGE_BYTES = 8 * HTB, NXCD = 8, WGM = 4;

__host__ __device__ __forceinline__ int lds_byte(int r, int c) { const int st = (r >> 4) * 2 + (c >> 5), rr = r & 15, cc = c & 31, ob = rr * 64 + cc * 2; return st * 1024 + (ob ^ (((ob >> 9) & 1) << 5)); }
__host__ __device__ __forceinline__ void stage_rc(int b, int& R, int& C) { const int st = b / 1024, sb = b % 1024, swz = sb ^ (((sb >> 9) & 1) << 5); R = (st >> 1) * 16 + swz / 64; C = (st & 1) * 32 + (swz % 64) / 2; }
__host__ __device__ __forceinline__ int perm32(int rho) { const int n = rho >> 4, i = rho & 15; return 8 * (i >> 2) + 4 * n + (i & 3); }

struct Unit { int pm, pn; };
struct Gemm { const bf16_t* A; const bf16_t* Bt; int M, N, K; };

struct StaticOrder {
    int nM, nN, nwg, G, c, mix;
    __host__ __device__ void init(int M, int N, int G_, int c_, int mix_ = 0) { nM = M / BM; nN = N / BM; nwg = nM * nN; G = G_; c = c_; mix = mix_; }
    __host__ __device__ bool next(int i, Unit& u) const {
        const long L = (long)i * G + c; if (L >= nwg) return false;
        int wgid = (int)L; { const int q = nwg / NXCD, r = nwg % NXCD, xcd = wgid % NXCD, off = wgid / NXCD; wgid = (xcd < r ? xcd * (q + 1) : r * (q + 1) + (xcd - r) * q) + off; }
        const int nig = WGM * nN, gid = wgid / nig, fm = gid * WGM, gsz = (nM - fm) < WGM ? (nM - fm) : WGM;
        u.pm = fm + ((wgid % nig) % gsz); u.pn = (wgid % nig) / gsz;
        if (mix == 1 && u.pn < 12) u.pn = (u.pn % 3) * 4 + u.pn / 3;
        if (mix == 2 && u.pn >= 6) ++u.pn;
        return true;
    }
    __device__ __forceinline__ void a_ready(const Unit&) const {}
    __device__ __forceinline__ void done(const Unit&) const {}
};

__device__ __forceinline__ unsigned cvt_pk_bf16(float lo, float hi) { unsigned r; asm volatile("v_cvt_pk_bf16_f32 %0, %1, %2" : "=v"(r) : "v"(lo), "v"(hi)); return r; }
typedef float f32x2 __attribute__((ext_vector_type(2)));
typedef float f32x2 __attribute__((ext_vector_type(2)));
typedef unsigned u32x2 __attribute__((ext_vector_type(2)));
__device__ __forceinline__ float row_rinv(const float* part, int row) { return __builtin_amdgcn_rsqf(part[row] * (1.0f / 1024.0f) + EPS); }
constexpr int PRE_LDS = 131072 + 2048;
struct PreRows { const PG8_LAS float* b; };
__device__ __forceinline__ void pre_rows_load(PreRows& p, const float* part, const Unit& u, int wr, int lane, PG8_LAS unsigned char* lds) {
    PG8_LAS unsigned char* dst = lds + PRE_LDS + wr * 512;
    __builtin_amdgcn_global_load_lds((const unsigned*)(part + u.pm * BM + wr * 64 + lane), (PG8_LAS unsigned*)dst, 4, 0, 0);
    __builtin_amdgcn_global_load_lds((const unsigned*)(part + u.pm * BM + HALF + wr * 64 + lane), (PG8_LAS unsigned*)(dst + 256), 4, 0, 0);
    p.b = (const PG8_LAS float*)dst;
}
__device__ __forceinline__ float pre_rinv(const PreRows& p, int ai, int m, int fr) {
    return __builtin_amdgcn_rsqf(p.b[ai * 64 + m * 16 + fr] * (1.0f / 1024.0f) + EPS);
}
struct PreNone {};
__device__ __forceinline__ float silu_f(float x) { return x * __builtin_amdgcn_rcpf(1.0f + __builtin_amdgcn_exp2f(-x * LOG2E)); }
__device__ __forceinline__ float logsigmoid_f(float x) { return fminf(x, 0.f) - __logf(1.0f + __expf(-fabsf(x))); }

__device__ __forceinline__ void st_wt16(void* p, const u32x4 v) { asm volatile("global_store_dwordx4 %0, %1, off sc0 sc1\n\ts_nop 1" :: "v"(p), "v"(v) : "memory"); }
__device__ __forceinline__ void st_wt16(void* p, const f32x4 v) { asm volatile("global_store_dwordx4 %0, %1, off sc0 sc1\n\ts_nop 1" :: "v"(p), "v"(v) : "memory"); }
__device__ __forceinline__ void st_wt8(void* p, const u32x2 v)  { asm volatile("global_store_dwordx2 %0, %1, off sc0 sc1" :: "v"(p), "v"(v) : "memory"); }
struct EpiGU {
    static constexpr bool PERM = true, AFTER_DRAIN = false;
    unsigned char* ws; int pin; PG8_LAS unsigned char* lds;
    typedef PreRows Pre;
    __device__ __forceinline__ void pre_load(Pre& p, const Unit& u, int wr, int lane) const { pre_rows_load(p, (const float*)(ws + WS_PART + (size_t)pin * SZ_PART), u, wr, lane, lds); }
    __device__ __forceinline__ void operator()(const f32x4 (&acc)[2][2][4][2], const Unit& u, int wr, int wc, int fr, int fq, const Pre& pre) const {
        bf16_t* H = (bf16_t*)(ws + WS_H); const float* part = (const float*)(ws + WS_PART + (size_t)pin * SZ_PART);
        const int col0 = u.pn * 128 + wc * 32 + 8 * fq;
        float rr[2][4];
#pragma unroll
        for (int ai = 0; ai < 2; ++ai)
#pragma unroll
            for (int m = 0; m < 4; ++m) rr[ai][m] = pre_rinv(pre, ai, m, fr);
#pragma unroll
        for (int ai = 0; ai < 2; ++ai)
#pragma unroll
            for (int m = 0; m < 4; ++m) {
                const int row = u.pm * BM + ai * HALF + wr * 64 + m * 16 + fr;
                const float r = rr[ai][m];
                u32x4 w;
#pragma unroll
                for (int n = 0; n < 2; ++n) {
                    const f32x4 g4 = acc[ai][0][m][n], u4 = acc[ai][1][m][n];
                    const float rl = -r * LOG2E;
                    f32x4 t4 = g4 * rl;
#pragma unroll
                    for (int i = 0; i < 4; ++i) t4[i] = __builtin_amdgcn_exp2f(t4[i]);
                    t4 = t4 + 1.0f;
#pragma unroll
                    for (int i = 0; i < 4; ++i) t4[i] = __builtin_amdgcn_rcpf(t4[i]);
                    const f32x4 h4 = (g4 * u4) * (t4 * (r * r));
                    if (n == 0) { w.x = cvt_pk_bf16(h4[0], h4[1]); w.y = cvt_pk_bf16(h4[2], h4[3]); } else { w.z = cvt_pk_bf16(h4[0], h4[1]); w.w = cvt_pk_bf16(h4[2], h4[3]); }
                }
                st_wt16(H + (size_t)row * FF + col0, w);
            }
    }
};
__device__ __forceinline__ f32x4 bf4_to_f32(const u32x2 w) {
    return (f32x4){__builtin_bit_cast(float, w.x << 16), __builtin_bit_cast(float, w.x & 0xffff0000u), __builtin_bit_cast(float, w.y << 16), __builtin_bit_cast(float, w.y & 0xffff0000u)};
}
struct EpiRes {
    static constexpr bool PERM = true, AFTER_DRAIN = false;
    unsigned char* ws; int pout; float coef;
    typedef PreNone Pre;
    __device__ __forceinline__ void pre_load(Pre&, const Unit&, int, int) const {}
    __device__ __forceinline__ void operator()(const f32x4 (&acc)[2][2][4][2], const Unit& u, int wr, int wc, int fr, int fq, const Pre&) const {
        bf16_t* XB = (bf16_t*)(ws + WS_XB); float* part_out = (float*)(ws + WS_PART + (size_t)pout * SZ_PART);
        const int ln = fq * 16 + fr;
#pragma unroll
        for (int ai = 0; ai < 2; ++ai) {
            u32x4 xo[4][2];
#pragma unroll
            for (int m = 0; m < 4; ++m)
#pragma unroll
                for (int bj = 0; bj < 2; ++bj)
                    xo[m][bj] = *(const u32x4*)(XB + (size_t)(u.pm * BM + ai * HALF + wr * 64 + m * 16 + fr) * DM + u.pn * BM + bj * HALF + wc * 32 + 8 * fq);
#pragma unroll
            for (int m = 0; m < 4; ++m) {
                const int row = u.pm * BM + ai * HALF + wr * 64 + m * 16 + fr;
                float ss = 0.f;
#pragma unroll
                for (int bj = 0; bj < 2; ++bj) {
                    const int c = u.pn * BM + bj * HALF + wc * 32 + 8 * fq;
                    const f32x4 x0 = bf4_to_f32((u32x2){xo[m][bj].x, xo[m][bj].y}) + acc[ai][bj][m][0] * coef;
                    const f32x4 x1 = bf4_to_f32((u32x2){xo[m][bj].z, xo[m][bj].w}) + acc[ai][bj][m][1] * coef;
                    u32x4 w; w.x = cvt_pk_bf16(x0[0], x0[1]); w.y = cvt_pk_bf16(x0[2], x0[3]); w.z = cvt_pk_bf16(x1[0], x1[1]); w.w = cvt_pk_bf16(x1[2], x1[3]);
                    st_wt16(XB + (size_t)row * DM + c, w);
                    ss += ((x0[0] * x0[0] + x0[1] * x0[1]) + (x0[2] * x0[2] + x0[3] * x0[3])) + ((x1[0] * x1[0] + x1[1] * x1[1]) + (x1[2] * x1[2] + x1[3] * x1[3]));
                }
                ss += __builtin_bit_cast(float, __builtin_amdgcn_ds_bpermute((ln ^ 16) << 2, __builtin_bit_cast(int, ss)));
                ss += __builtin_bit_cast(float, __builtin_amdgcn_ds_bpermute((ln ^ 32) << 2, __builtin_bit_cast(int, ss)));
                if (fq == 0) atomicAdd(part_out + row, ss);
            }
        }
    }
};
struct EpiFinal {
    static constexpr bool PERM = false, AFTER_DRAIN = true;
    unsigned char* ws; float* out; const float* gain; float coef;
    typedef PreNone Pre;
    __device__ __forceinline__ void pre_load(Pre&, const Unit&, int, int) const {}
    __device__ __forceinline__ void fused(f32x4 (&acc)[2][2][4][2], const Unit& u, int wr, int wc, int fr, int fq, PG8_LAS unsigned char*, int, int) const {
        const bf16_t* XB = (const bf16_t*)(ws + WS_XB); float* part = (float*)(ws + WS_PART + 6 * SZ_PART);
        unsigned* cnt = (unsigned*)(ws + 32768) + 16 * u.pm;
        const int ln = fq * 16 + fr;
#pragma unroll
        for (int ai = 0; ai < 2; ++ai) {
            u32x2 xo[4][2][2];
#pragma unroll
            for (int m = 0; m < 4; ++m)
#pragma unroll
                for (int bj = 0; bj < 2; ++bj)
#pragma unroll
                    for (int n = 0; n < 2; ++n)
                        xo[m][bj][n] = *(const u32x2*)(XB + (size_t)(u.pm * BM + ai * HALF + wr * 64 + m * 16 + fr) * DM + u.pn * BM + bj * HALF + wc * 32 + n * 16 + 4 * fq);
#pragma unroll
            for (int m = 0; m < 4; ++m) {
                const int row = u.pm * BM + ai * HALF + wr * 64 + m * 16 + fr;
                float ss = 0.f;
#pragma unroll
                for (int bj = 0; bj < 2; ++bj)
#pragma unroll
                    for (int n = 0; n < 2; ++n) {
                        const f32x4 xn = bf4_to_f32(xo[m][bj][n]) + acc[ai][bj][m][n] * coef;
                        acc[ai][bj][m][n] = xn;
                        ss += (xn[0] * xn[0] + xn[1] * xn[1]) + (xn[2] * xn[2] + xn[3] * xn[3]);
                    }
                ss += __builtin_bit_cast(float, __builtin_amdgcn_ds_bpermute((ln ^ 16) << 2, __builtin_bit_cast(int, ss)));
                ss += __builtin_bit_cast(float, __builtin_amdgcn_ds_bpermute((ln ^ 32) << 2, __builtin_bit_cast(int, ss)));
                if (fq == 0) atomicAdd(part + row, ss);
            }
        }
        asm volatile("s_waitcnt vmcnt(0)" ::: "memory");
        if (ln == 0) __hip_atomic_fetch_add(cnt, 1u, __ATOMIC_RELAXED, __HIP_MEMORY_SCOPE_AGENT);
        if (wr == 0 && wc == 0) {
            for (unsigned spins = 0; spins < (1u << 22); ++spins) {
                if ((unsigned)__builtin_amdgcn_readfirstlane((int)__hip_atomic_load(cnt, __ATOMIC_RELAXED, __HIP_MEMORY_SCOPE_AGENT)) >= 32u) break;
                __builtin_amdgcn_s_sleep(2);
            }
            __builtin_amdgcn_fence(__ATOMIC_ACQUIRE, "agent");
        }
        asm volatile("s_waitcnt vmcnt(0) lgkmcnt(0)" ::: "memory"); __builtin_amdgcn_s_barrier(); asm volatile("" ::: "memory");
        float ssr[2][4]; f32x4 gv[2][2];
#pragma unroll
        for (int ai = 0; ai < 2; ++ai)
#pragma unroll
            for (int m = 0; m < 4; ++m) ssr[ai][m] = part[u.pm * BM + ai * HALF + wr * 64 + m * 16 + fr];
#pragma unroll
        for (int bj = 0; bj < 2; ++bj)
#pragma unroll
            for (int n = 0; n < 2; ++n) gv[bj][n] = *(const f32x4*)(gain + u.pn * BM + bj * HALF + wc * 32 + n * 16 + 4 * fq);
#pragma unroll
        for (int ai = 0; ai < 2; ++ai)
#pragma unroll
            for (int m = 0; m < 4; ++m) {
                const int row = u.pm * BM + ai * HALF + wr * 64 + m * 16 + fr;
                const float r = __builtin_amdgcn_rsqf(ssr[ai][m] * (1.0f / 1024.0f) + EPS);
#pragma unroll
                for (int bj = 0; bj < 2; ++bj)
#pragma unroll
                    for (int n = 0; n < 2; ++n) {
                        const int c = u.pn * BM + bj * HALF + wc * 32 + n * 16 + 4 * fq;
                        *(f32x4*)(out + (size_t)row * DM + c) = acc[ai][bj][m][n] * r * gv[bj][n];
                    }
            }
    }
};
template <int KIND>
__device__ __forceinline__ void in_tile(const f32x4 (&acc)[2][2][4][2], const Unit& u, int wr, int wc, int fr, int fq, const PreRows& pre, bf16_t* EB, int dcol0  ,
                                        float sc, float* o_p, float* o_s, int ocol0  , int opitch, const float* bias, float* LG) {
    float rr[2][4];
#pragma unroll
    for (int ai = 0; ai < 2; ++ai)
#pragma unroll
        for (int m = 0; m < 4; ++m) rr[ai][m] = pre_rinv(pre, ai, m, fr);
    f32x4 bia[2][2] = {};
    if (KIND == 4 || KIND == 5) {
#pragma unroll
        for (int bj = 0; bj < 2; ++bj) { const int cl = bj * HALF + wc * 32 + 8 * fq;
            if (KIND == 4 || cl < 16) { bia[bj][0] = *(const f32x4*)(bias + cl); bia[bj][1] = *(const f32x4*)(bias + cl + 4); } }
    }
#pragma unroll
    for (int ai = 0; ai < 2; ++ai)
#pragma unroll
        for (int m = 0; m < 4; ++m) {
            const int row = u.pm * BM + ai * HALF + wr * 64 + m * 16 + fr;
            const float r = rr[ai][m] * sc;
#pragma unroll
            for (int bj = 0; bj < 2; ++bj) {
                const int cl = bj * HALF + wc * 32 + 8 * fq;
                float v[8];
#pragma unroll
                for (int n = 0; n < 2; ++n)
#pragma unroll
                    for (int i = 0; i < 4; ++i) v[4 * n + i] = acc[ai][bj][m][n][i] * r;
                if (KIND == 4) {
                    const f32x4 b0 = bia[bj][0], b1 = bia[bj][1];
                    f32x4 o0, o1;
#pragma unroll
                    for (int i = 0; i < 4; ++i) { o0[i] = logsigmoid_f(v[i] + b0[i]) * (1.0f / 16.0f); o1[i] = logsigmoid_f(v[4 + i] + b1[i]) * (1.0f / 16.0f); }
                    *(f32x4*)(LG + (size_t)row * 256 + cl) = o0; *(f32x4*)(LG + (size_t)row * 256 + cl + 4) = o1;
                } else if (KIND == 5) {
                    if (cl < 16) {
                        const f32x4 b0 = bia[bj][0], b1 = bia[bj][1];
                        f32x4 o0, o1;
#pragma unroll
                        for (int i = 0; i < 4; ++i) { o0[i] = logsigmoid_f(v[i] + b0[i]); o1[i] = logsigmoid_f(v[4 + i] + b1[i]); }
                        *(f32x4*)(LG + (size_t)row * 16 + cl) = o0; *(f32x4*)(LG + (size_t)row * 16 + cl + 4) = o1;
                        float* dst = (row < MP) ? o_p + (size_t)row * 16 + cl : o_s + (size_t)(row - MP) * 16 + cl;
                        *(f32x4*)dst = o0; *(f32x4*)(dst + 4) = o1;
                    }
                } else {
                    if (KIND == 1) {
                        float t[8];
#pragma unroll
                        for (int e = 0; e < 8; ++e) t[e] = __builtin_amdgcn_exp2f(v[e] * -LOG2E);
#pragma unroll
                        for (int e = 0; e < 8; ++e) t[e] = __builtin_amdgcn_rcpf(t[e] + 1.0f);
#pragma unroll
                        for (int e = 0; e < 8; ++e) v[e] *= t[e];
                    }
                    u32x4 w; w.x = cvt_pk_bf16(v[0], v[1]); w.y = cvt_pk_bf16(v[2], v[3]); w.z = cvt_pk_bf16(v[4], v[5]); w.w = cvt_pk_bf16(v[6], v[7]);
                    st_wt16(EB + (size_t)row * NIN + dcol0 + cl, w);
                    if (KIND == 2) {
                        float* dst = (row < MP) ? o_p + (size_t)row * opitch + ocol0 + cl : o_s + (size_t)(row - MP) * opitch + ocol0 + cl;
                        *(f32x4*)dst = (f32x4){v[0], v[1], v[2], v[3]}; *(f32x4*)(dst + 4) = (f32x4){v[4], v[5], v[6], v[7]};
                    }
                    if (KIND == 3) {
                        float* dst = nullptr;
                        if (row >= MP) dst = o_s + (size_t)(row - MP) * 512 + ocol0 + cl;
                        else { const int t = row & (TSEQ - 1), b = row >> 11; if (t >= TSEQ - 512) dst = o_p + ((size_t)(b * 512 + (t - (TSEQ - 512))) * 512 + ocol0 + cl); }
                        if (dst) { *(f32x4*)dst = (f32x4){v[0], v[1], v[2], v[3]}; *(f32x4*)(dst + 4) = (f32x4){v[4], v[5], v[6], v[7]}; }
                    }
                }
            }
        }
}
struct EpiInEven {
    static constexpr bool PERM = true, AFTER_DRAIN = false;
    unsigned char* ws; float* out; PG8_LAS unsigned char* lds;
    typedef PreRows Pre;
    __device__ __forceinline__ void pre_load(Pre& p, const Unit& u, int wr, int lane) const { pre_rows_load(p, (const float*)(ws + WS_PART + 1 * SZ_PART), u, wr, lane, lds); }
    __device__ __forceinline__ void operator()(const f32x4 (&acc)[2][2][4][2], const Unit& u, int wr, int wc, int fr, int fq, const Pre& part) const {
        const int pn = u.pn;
        bf16_t* EB = (bf16_t*)(ws + WS_EB);
        if (pn == 4 || pn == 5) in_tile<1>(acc, u, wr, wc, fr, fq, part, EB, pn * BM, 1.0f, nullptr, nullptr, 0, 0, nullptr, nullptr);
        else if (pn >= 9) { const bool isv = pn >= 11; in_tile<3>(acc, u, wr, wc, fr, fq, part, EB, pn * BM, 1.0f, out + (isv ? O_PBV : O_PBK), out + (isv ? O_SBV : O_SBK), pn * BM - (isv ? 2816 : 2304), 512, nullptr, nullptr); }
        else in_tile<0>(acc, u, wr, wc, fr, fq, part, EB, pn * BM, (pn == 0) ? 0.125f : ((pn >= 7) ? QSCALE2 : 1.0f), nullptr, nullptr, 0, 0, nullptr, nullptr);
    }
};
struct EpiInOdd {
    static constexpr bool PERM = true, AFTER_DRAIN = false;
    unsigned char* ws; float* out; PG8_LAS unsigned char* lds;
    typedef PreRows Pre;
    __device__ __forceinline__ void pre_load(Pre& p, const Unit& u, int wr, int lane) const { pre_rows_load(p, (const float*)(ws + WS_PART + 4 * SZ_PART), u, wr, lane, lds); }
    __device__ __forceinline__ void operator()(const f32x4 (&acc)[2][2][4][2], const Unit& u, int wr, int wc, int fr, int fq, const Pre& part) const {
        const int pn = u.pn;
        bf16_t* EB = (bf16_t*)(ws + WS_EB);
        if (pn >= 4) { const bool isv = pn >= 8; in_tile<2>(acc, u, wr, wc, fr, fq, part, EB, pn * BM, 1.0f, out + (isv ? O_PFV : O_PFK), out + (isv ? O_SFV : O_SFK), pn * BM - (isv ? 2048 : 1024), 1024, nullptr, nullptr); }
        else in_tile<0>(acc, u, wr, wc, fr, fq, part, EB, pn * BM, QSCALE2, nullptr, nullptr, 0, 0, nullptr, nullptr);
    }
};
template <class Epi, class Sched, bool ALIGN_EPI = false, bool SP2 = false>
__device__ __forceinline__ void gemm_phase(PG8_LAS unsigned char* lds, const Gemm g, const Sched& S, const Epi& E) {
    int tid_ = threadIdx.x; asm volatile("" : "+v"(tid_));
    const int tid = tid_, wid = __builtin_amdgcn_readfirstlane(tid >> 6), lane = tid & 63, wr = wid >> 2, wc = wid & 3, fr = lane & 15, fq = lane >> 4;
    const int K = g.K, nt = K / BK;
    unsigned voffA[2], voffB[2];
#pragma unroll
    for (int i = 0; i < 2; ++i) { int R, C; stage_rc(tid * 16 + i * 8192, R, C); const int Rb = Epi::PERM ? ((R & ~31) + perm32(R & 31)) : R;
        voffA[i] = (unsigned)(R * K + C) * 2u; voffB[i] = (unsigned)(Rb * K + C) * 2u; }
    const size_t kstep = (size_t)(BK * 2);
    const size_t hstep = (size_t)HALF * K * 2;
    const size_t tstep = 2 * hstep;
    const unsigned ldsw = (unsigned)wid * 1024u;
    const int aoff = lds_byte(wr * 64 + fr, fq * 8), boff = lds_byte(wc * 32 + fr, fq * 8);
#define PG8_SA(b, h) (((b) * 2 + (h)) * HTB)
#define PG8_SB(b, h) ((4 + (b) * 2 + (h)) * HTB)
#define PG8_STAGE(bufoff, gbase, voff) do { _Pragma("unroll") for (int _i = 0; _i < 2; ++_i) \
        __builtin_amdgcn_global_load_lds((const unsigned*)((const char*)(gbase) + (voff)[_i]), (PG8_LAS unsigned*)(lds + (bufoff) + ldsw + _i * 8192), 16, 0, 0); } while (0)
#define PG8_LDA(dst, b, h) do { _Pragma("unroll") for (int m = 0; m < 4; ++m) _Pragma("unroll") for (int k = 0; k < 2; ++k) dst[m][k] = *(const PG8_LAS bf16x8*)(lds + PG8_SA(b, h) + aoff + m * 2048 + k * 1024); } while (0)
#define PG8_LDB(dst, b, h) do { _Pragma("unroll") for (int n = 0; n < 2; ++n) _Pragma("unroll") for (int k = 0; k < 2; ++k) dst[n][k] = *(const PG8_LAS bf16x8*)(lds + PG8_SB(b, h) + boff + n * 2048 + k * 1024); } while (0)
#define PG8_MMA(ai, bj, At, Bt) do { __builtin_amdgcn_s_setprio(1); _Pragma("unroll") for (int m = 0; m < 4; ++m) _Pragma("unroll") for (int n = 0; n < 2; ++n) _Pragma("unroll") for (int k = 0; k < 2; ++k) \
        acc[ai][bj][m][n] = __builtin_amdgcn_mfma_f32_16x16x32_bf16(Bt[n][k], At[m][k], acc[ai][bj][m][n], 0, 0, 0); __builtin_amdgcn_s_setprio(0); } while (0)
#define PG8_WAIT_V(n) asm volatile("s_waitcnt vmcnt(" #n ")" ::: "memory")
#define PG8_WAIT_L(n) asm volatile("s_waitcnt lgkmcnt(" #n ")" ::: "memory")
#define PG8_BAR __builtin_amdgcn_s_barrier()
#define PG8_SCHED __builtin_amdgcn_sched_barrier(0)
    Unit cur, nxt; int ui = 0;
    typename Epi::Pre pre{};
    if (!S.next(0, cur)) return;
    f32x4 acc[2][2][4][2];
#pragma unroll
    for (int a = 0; a < 2; ++a)
#pragma unroll
        for (int b = 0; b < 2; ++b)
#pragma unroll
            for (int m = 0; m < 4; ++m)
#pragma unroll
                for (int n = 0; n < 2; ++n) acc[a][b][m][n] = (f32x4){0.f, 0.f, 0.f, 0.f};
    bf16x8 At[4][2], B0[2][2], B1[2][2];
    const char* cA = (const char*)g.A + (size_t)cur.pm * tstep; const char* cB = (const char*)g.Bt + (size_t)cur.pn * tstep;
    S.a_ready(cur);
    if constexpr (SP2) {
        PG8_STAGE(PG8_SB(0, 0), cB, voffB); PG8_STAGE(PG8_SB(0, 1), cB + hstep, voffB); PG8_STAGE(PG8_SA(0, 0), cA, voffA); PG8_STAGE(PG8_SA(0, 1), cA + hstep, voffA);
        if (wr == 1) PG8_BAR;
        PG8_WAIT_V(2); PG8_BAR;
        PG8_STAGE(PG8_SB(1, 0), cB + kstep, voffB); PG8_STAGE(PG8_SA(1, 0), cA + kstep, voffA); PG8_STAGE(PG8_SB(1, 1), cB + hstep + kstep, voffB);
        PG8_WAIT_V(6); PG8_BAR;
    } else {
        PG8_STAGE(PG8_SB(0, 0), cB, voffB); PG8_STAGE(PG8_SA(0, 0), cA, voffA); PG8_STAGE(PG8_SB(0, 1), cB + hstep, voffB); PG8_STAGE(PG8_SA(0, 1), cA + hstep, voffA);
        if (wr == 1) PG8_BAR;
        PG8_WAIT_V(4); PG8_BAR;
        PG8_STAGE(PG8_SB(1, 0), cB + kstep, voffB); PG8_STAGE(PG8_SA(1, 0), cA + kstep, voffA); PG8_STAGE(PG8_SB(1, 1), cB + hstep + kstep, voffB);
        PG8_WAIT_V(6); PG8_BAR;
    }
    for (;;) {
        const bool has_next = S.next(ui + 1, nxt);
        const char* nA = has_next ? (const char*)g.A + (size_t)nxt.pm * tstep : cA; const char* nB = has_next ? (const char*)g.Bt + (size_t)nxt.pn * tstep : cB;
        for (int t = 0; t < nt; t += 2) {
            const bool last = (t == nt - 2);
            const char* a1 = cA + (size_t)(t + 1) * kstep;
            const char* a2 = last ? nA : cA + (size_t)(t + 2) * kstep; const char* b2 = last ? nB : cB + (size_t)(t + 2) * kstep;
            const char* a3 = a2 + kstep; const char* b3 = b2 + kstep;
            if (last && has_next) S.a_ready(nxt);
            if (last) E.pre_load(pre, cur, wr, lane);
            if constexpr (SP2) {
            PG8_LDB(B0, 0, 0); PG8_LDB(B1, 0, 1); PG8_SCHED; PG8_LDA(At, 0, 0); PG8_STAGE(PG8_SA(1, 1), a1 + hstep, voffA);
            PG8_WAIT_V(8); PG8_WAIT_L(0); PG8_BAR; PG8_MMA(0, 0, At, B0); PG8_MMA(0, 1, At, B1); PG8_BAR; PG8_SCHED;
            PG8_LDA(At, 0, 1); PG8_STAGE(PG8_SB(0, 0), b2, voffB); PG8_STAGE(PG8_SB(0, 1), b2 + hstep, voffB); PG8_STAGE(PG8_SA(0, 0), a2, voffA);
            PG8_WAIT_V(8); PG8_WAIT_L(0); PG8_BAR; PG8_MMA(1, 0, At, B0); PG8_MMA(1, 1, At, B1); PG8_BAR; PG8_SCHED;
            PG8_LDB(B0, 1, 0); PG8_LDB(B1, 1, 1); PG8_SCHED; PG8_LDA(At, 1, 0); PG8_STAGE(PG8_SA(0, 1), a2 + hstep, voffA);
            PG8_WAIT_V(8); PG8_WAIT_L(0); PG8_BAR; PG8_MMA(0, 0, At, B0); PG8_MMA(0, 1, At, B1); PG8_BAR; PG8_SCHED;
            PG8_LDA(At, 1, 1); PG8_STAGE(PG8_SB(1, 0), b3, voffB); PG8_STAGE(PG8_SB(1, 1), b3 + hstep, voffB); PG8_STAGE(PG8_SA(1, 0), a3, voffA);
            PG8_WAIT_V(8); PG8_WAIT_L(0); PG8_BAR; PG8_MMA(1, 0, At, B0); PG8_MMA(1, 1, At, B1); PG8_BAR; PG8_SCHED;
            } else {
            PG8_LDB(B0, 0, 0); PG8_SCHED; PG8_LDA(At, 0, 0); PG8_STAGE(PG8_SA(1, 1), a1 + hstep, voffA);
            PG8_WAIT_L(8); PG8_BAR; PG8_WAIT_L(0); PG8_MMA(0, 0, At, B0); PG8_BAR; PG8_SCHED;
            PG8_LDB(B1, 0, 1); PG8_STAGE(PG8_SB(0, 0), b2, voffB);
            PG8_BAR; PG8_WAIT_L(0); PG8_MMA(0, 1, At, B1); PG8_BAR;
            PG8_LDA(At, 0, 1); PG8_STAGE(PG8_SA(0, 0), a2, voffA);
            PG8_BAR; PG8_WAIT_L(0); PG8_MMA(1, 0, At, B0); PG8_BAR; PG8_SCHED;
            PG8_STAGE(PG8_SB(0, 1), b2 + hstep, voffB);
            PG8_WAIT_V(6); PG8_BAR; PG8_MMA(1, 1, At, B1); PG8_BAR;
            PG8_LDB(B0, 1, 0); PG8_SCHED; PG8_LDA(At, 1, 0); PG8_STAGE(PG8_SA(0, 1), a2 + hstep, voffA);
            PG8_WAIT_L(8); PG8_BAR; PG8_WAIT_L(0); PG8_MMA(0, 0, At, B0); PG8_BAR; PG8_SCHED;
            PG8_LDB(B1, 1, 1); PG8_STAGE(PG8_SB(1, 0), b3, voffB);
            PG8_BAR; PG8_WAIT_L(0); PG8_MMA(0, 1, At, B1); PG8_BAR;
            PG8_LDA(At, 1, 1); PG8_STAGE(PG8_SA(1, 0), a3, voffA);
            PG8_BAR; PG8_WAIT_L(0); PG8_MMA(1, 0, At, B0); PG8_BAR; PG8_SCHED;
            PG8_STAGE(PG8_SB(1, 1), b3 + hstep, voffB);
            PG8_WAIT_V(6); PG8_BAR; PG8_MMA(1, 1, At, B1); PG8_BAR;
            }
        }
        if constexpr (ALIGN_EPI) { if (wr == 0) PG8_BAR; }
        if constexpr (!Epi::AFTER_DRAIN) { E(acc, cur, wr, wc, fr, fq, pre); S.done(cur); }
        if (!has_next) break;
#pragma unroll
        for (int a = 0; a < 2; ++a)
#pragma unroll
            for (int b = 0; b < 2; ++b)
#pragma unroll
                for (int m = 0; m < 4; ++m)
#pragma unroll
                    for (int n = 0; n < 2; ++n) acc[a][b][m][n] = (f32x4){0.f, 0.f, 0.f, 0.f};
        cur = nxt; cA = nA; cB = nB; ++ui;
        if constexpr (ALIGN_EPI) { if (wr == 1) PG8_BAR; }
    }
    PG8_WAIT_V(0);
    if constexpr (!ALIGN_EPI) { if (wr == 0) PG8_BAR; }
    PG8_BAR;
    if constexpr (Epi::AFTER_DRAIN) { E.fused(acc, cur, wr, wc, fr, fq, lds, wid, lane); S.done(cur); }
#undef PG8_SA
#undef PG8_SB
#undef PG8_STAGE
#undef PG8_LDA
#undef PG8_LDB
#undef PG8_MMA
#undef PG8_WAIT_V
#undef PG8_WAIT_L
#undef PG8_BAR
#undef PG8_SCHED
}
}
#include <hip/hip_bf16.h>
#include <cmath>
namespace attn_body {
using bf16=__hip_bfloat16;
using bf16x8=__attribute__((ext_vector_type(8)))short;
using s16x4=__attribute__((ext_vector_type(4)))short;
using f32x16=__attribute__((ext_vector_type(16)))float;
using u32x4=__attribute__((ext_vector_type(4)))unsigned;
typedef float f32x4_t __attribute__((ext_vector_type(4)));
constexpr int BATCH=8,NHEAD=16,SEQ=2048,D=64,DM=NHEAD*D,PQ=3328;
constexpr int NW=8,QBLK=32,QB=QBLK*NW,KVBLK=64,NQB=SEQ/QB;
constexpr int ATTN_UNIT_ROWS=QB;
__device__ __forceinline__ int crow(int r,int hi){return (r&3)+8*(r>>2)+4*hi;}
#define SBAR() __builtin_amdgcn_sched_barrier(0)
__device__ __forceinline__ void cmask(f32x16&p0,f32x16&p1,int jb,int qrel,int hi){
  const float NEG=-INFINITY; int kb=64*jb+4*hi;
  #pragma unroll
  for(int r=0;r<16;++r){int kv=kb+(r&3)+8*(r>>2); if(kv>qrel)p0[r]=NEG; if(kv+32>qrel)p1[r]=NEG;}
}

constexpr int NSLOT=3, SLOTB=8192;
constexpr float FOX_SKIP2_=160.0f*1.4426950408889634f;
constexpr int LDS_K=0, LDS_V=NSLOT*SLOTB, LDS_WS=2*NSLOT*SLOTB, LDS_OST=LDS_WS+NW*64*4, LDS_BYTES=LDS_OST+NW*4096;
constexpr float C2=0.125f*1.4426950408889634f;
__device__ __forceinline__ void glds16(const void*gsrc,unsigned lds_dst){unsigned keep;
  asm volatile("s_mov_b32 %0, m0\n\ts_mov_b32 m0, %2\n\ts_nop 0\n\tglobal_load_lds_dwordx4 %1, off\n\ts_mov_b32 m0, %0":"=&s"(keep):"v"(gsrc),"s"(lds_dst):"memory");}
__device__ __forceinline__ float max3f(float a,float b,float c){float r;asm("v_max3_f32 %0, %1, %2, %3":"=v"(r):"v"(a),"v"(b),"v"(c));return r;}
__device__ __forceinline__ float max2f(float a,float b){float r;asm("v_max_f32_e32 %0, %1, %2":"=v"(r):"v"(a),"v"(b));return r;}
__device__ __forceinline__ float fadd_s(float a,float b){float r;asm("v_add_f32_e32 %0, %1, %2":"=v"(r):"v"(a),"v"(b));return r;}
__device__ __forceinline__ float fsub_s(float a,float b){float r;asm("v_sub_f32_e32 %0, %1, %2":"=v"(r):"v"(a),"v"(b));return r;}
typedef float f32x2_t __attribute__((ext_vector_type(2))); typedef __bf16 bf16x2_t __attribute__((ext_vector_type(2)));
__device__ __forceinline__ unsigned cvtpk_s(float lo,float hi){f32x2_t v={lo,hi};bf16x2_t b=__builtin_convertvector(v,bf16x2_t);return __builtin_bit_cast(unsigned,b);}
#define WAIT_BAR(N) asm volatile("s_waitcnt vmcnt(" #N ") lgkmcnt(0)\n\ts_barrier":::"memory")

__device__ __forceinline__ void qkt(f32x16&p0,f32x16&p1,const char*Kslot,const bf16x8*qr,int r32,int hi){
  const char*kb=Kslot+hi*1024+r32*16;
  #pragma unroll
  for(int d0=0;d0<4;++d0){
    const bf16x8 b0=*reinterpret_cast<const bf16x8*>(kb+d0*2048);
    const bf16x8 b1=*reinterpret_cast<const bf16x8*>(kb+d0*2048+512);
    {p0=__builtin_amdgcn_mfma_f32_32x32x16_bf16(b0,qr[d0],p0,0,0,0);p1=__builtin_amdgcn_mfma_f32_32x32x16_bf16(b1,qr[d0],p1,0,0,0);}}
}
typedef __attribute__((address_space(3))) const char* lds_cptr;
typedef short v4i16_t __attribute__((ext_vector_type(4)));
__device__ __forceinline__ void kload8(bf16x8*kf,lds_cptr kp){
  kf[0]=*(const __attribute__((address_space(3))) bf16x8*)(kp);      kf[1]=*(const __attribute__((address_space(3))) bf16x8*)(kp+512);
  kf[2]=*(const __attribute__((address_space(3))) bf16x8*)(kp+2048); kf[3]=*(const __attribute__((address_space(3))) bf16x8*)(kp+2560);
  kf[4]=*(const __attribute__((address_space(3))) bf16x8*)(kp+4096); kf[5]=*(const __attribute__((address_space(3))) bf16x8*)(kp+4608);
  kf[6]=*(const __attribute__((address_space(3))) bf16x8*)(kp+6144); kf[7]=*(const __attribute__((address_space(3))) bf16x8*)(kp+6656);
}
__device__ __forceinline__ void kload2(bf16x8*kf,lds_cptr kp,int j){ kf[2*j]=*(const __attribute__((address_space(3))) bf16x8*)(kp+j*2048); kf[2*j+1]=*(const __attribute__((address_space(3))) bf16x8*)(kp+j*2048+512); }
__device__ __forceinline__ s16x4 vtr(lds_cptr p){ return __builtin_bit_cast(s16x4,__builtin_amdgcn_ds_read_tr16_b64_v4i16((__attribute__((address_space(3))) v4i16_t*)p)); }
__device__ __forceinline__ float rowmax(const f32x16&p0,const f32x16&p1){
  float a=max3f(p0[0],p0[1],p1[0]),b=max3f(p0[2],p0[3],p1[1]);a=max3f(a,p1[2],p1[3]);
  #pragma unroll
  for(int r=4;r<16;r+=4){a=max3f(a,p0[r],p0[r+1]);b=max3f(b,p0[r+2],p0[r+3]);a=max3f(a,p1[r],p1[r+1]);b=max3f(b,p1[r+2],p1[r+3]);}
  const float m=max2f(a,b);
  auto rr=__builtin_amdgcn_permlane32_swap(__float_as_uint(m),__float_as_uint(m),false,false);
  return max2f(__uint_as_float(rr[0]),__uint_as_float(rr[1]));
}
__device__ __forceinline__ void pv(f32x16*o,int vb,bf16x8 pa0,bf16x8 pa1,bf16x8 pa2,bf16x8 pa3){
  #pragma unroll
  for(int d0=0;d0<2;++d0){s16x4 lo[4],hi[4];
    #pragma unroll
    for(int ks=0;ks<4;++ks){
      asm volatile("ds_read_b64_tr_b16 %0,%1 offset:%c2":"=&v"(lo[ks]):"v"(vb),"i"(d0*4096+ks*1024):"memory");
      asm volatile("ds_read_b64_tr_b16 %0,%1 offset:%c2":"=&v"(hi[ks]):"v"(vb),"i"(d0*4096+ks*1024+512):"memory");}
    asm volatile("s_waitcnt lgkmcnt(0)":::"memory");SBAR();
    #define PK(k) (bf16x8){lo[k][0],lo[k][1],lo[k][2],lo[k][3],hi[k][0],hi[k][1],hi[k][2],hi[k][3]}
    o[d0]=__builtin_amdgcn_mfma_f32_32x32x16_bf16(pa0,PK(0),o[d0],0,0,0);
    o[d0]=__builtin_amdgcn_mfma_f32_32x32x16_bf16(pa1,PK(1),o[d0],0,0,0);
    o[d0]=__builtin_amdgcn_mfma_f32_32x32x16_bf16(pa2,PK(2),o[d0],0,0,0);
    o[d0]=__builtin_amdgcn_mfma_f32_32x32x16_bf16(pa3,PK(3),o[d0],0,0,0);
    #undef PK
  }
}

#ifndef ATTN_STORE16
#define ATTN_STORE16(p,v) (*(u32x4*)(p)=(v))
#endif
template<int THRL,int MODE> __device__ __forceinline__ void attn_unit(int b,int h,int qb,const bf16*Q,const bf16*K,const bf16*V,bf16*O,char*shm,const __attribute__((address_space(3))) float*F2){
  int tid_=threadIdx.x; asm volatile("":"+v"(tid_));
  const int tid=tid_,lane=tid&63,r32=lane&31,hi=lane>>5; const int wid=__builtin_amdgcn_readfirstlane(tid>>6);
  const long rowbase=(long)b*SEQ; const int q0=qb*QB;
  int t_lo=(MODE==1&&qb>=2)?4*qb-8:0;
  if(MODE==0){
    const float lim=F2[qb*QB]+FOX_SKIP2_;
    while(t_lo+2<=4*qb && __builtin_amdgcn_readfirstlane(F2[64*(t_lo+2)-1]>lim)) t_lo+=2; }
  const bf16*Qw=Q+(rowbase+q0+wid*QBLK)*PQ+h*D;
  const bf16*Kh=K+(rowbase+64*t_lo)*PQ+h*D,*Vh=V+(rowbase+64*t_lo)*PQ+h*D;
  const unsigned lds0=(unsigned)(uintptr_t)shm;
  float*wsf=(float*)(shm+LDS_WS)+wid*64;
  const bf16*ksrc=Kh+(long)lane*PQ+wid*8;
  const bf16*vsrc=Vh+(long)(16*(wid&3)+(lane>>2))*PQ+(wid>>2)*32+(lane&3)*8;
  const unsigned kdst=lds0+LDS_K+wid*1024, vdst=lds0+LDS_V+wid*1024;
  #define DMA_K(t,slot) glds16(ksrc+(long)(t)*KVBLK*PQ,(unsigned)__builtin_amdgcn_readfirstlane(kdst+(slot)))
  #define DMA_V(t,slot) glds16(vsrc+(long)(t)*KVBLK*PQ,(unsigned)__builtin_amdgcn_readfirstlane(vdst+(slot)))
  const int vb0=(int)(lds0+LDS_V)+((lane>>4)&1)*32+(lane&3)*8+(4*hi+((lane&15)>>2))*64;
  const char*Kbase=shm+LDS_K; bf16x8 kf[8];
  const lds_cptr shm3=(lds_cptr)shm; const lds_cptr kp0=shm3+LDS_K+hi*1024+r32*16; const lds_cptr vp0=shm3+LDS_V+((lane>>4)&1)*32+(lane&3)*8+(4*hi+((lane&15)>>2))*64;
  const int NT=(q0+QB)/KVBLK-t_lo;
  DMA_K(0,0);DMA_V(0,0);DMA_K(1,SLOTB);
  bf16x8 qr[4];
  #pragma unroll
  for(int d0=0;d0<4;++d0)qr[d0]=*reinterpret_cast<const bf16x8*>(&Qw[(long)r32*PQ+d0*16+hi*8]);
  float mhat=0.f,l_reg=0.f;f32x16 o[2];o[0]=f32x16{};o[1]=f32x16{};
  #define BIAS(C0,C1,t) do{ const float nm_=f2q-mhat;          \
    if(MODE==0){ const __attribute__((address_space(3))) float*fp_=F2+64*(t_lo+(t))+4*hi; \
      _Pragma("unroll") for(int g_=0;g_<4;++g_){ const f32x4_t a_=*(const __attribute__((address_space(3))) f32x4_t*)(fp_+8*g_), b_=*(const __attribute__((address_space(3))) f32x4_t*)(fp_+32+8*g_); \
        _Pragma("unroll") for(int i_=0;i_<4;++i_){ C0[4*g_+i_]=nm_-a_[i_]; C1[4*g_+i_]=nm_-b_[i_]; } } } \
    else{ const int dl_=4*qb+(wid>>1)-(t_lo+(t));              \
      if(dl_<0||dl_>8){ const float c_=nm_-4096.f; _Pragma("unroll") for(int r=0;r<16;++r){C0[r]=c_;C1[r]=c_;} } \
      else if(dl_>=3){ const float c_=nm_+F2[256]; _Pragma("unroll") for(int r=0;r<16;++r){C0[r]=c_;C1[r]=c_;} } \
      else{ const __attribute__((address_space(3))) float*tp_=F2+64*dl_+128+32*(wid&1)+r32-4*hi;     \
        _Pragma("unroll") for(int r=0;r<16;++r){ const int j_=(r&3)+8*(r>>2); C0[r]=nm_+tp_[-j_]; C1[r]=nm_+tp_[-j_-32]; } } } }while(0)
  const int qrel=wid*QBLK+r32;
  const float f2q=(MODE==0)?F2[q0+qrel]:0.f;
  #define CMASK(P0,P1,t) do{ if(MODE==0){int jb_=(t)-(NT-4); if(jb_>=0)cmask(P0,P1,jb_,qrel,hi);} }while(0)
  bool resc=false;
  #define START(P0,P1) do{ const float rm=rowmax(P0,P1); resc=false; \
    { const float dl=__builtin_fmaxf(rm,0.f); mhat=fadd_s(mhat,dl); \
      _Pragma("unroll") for(int r=0;r<16;++r){P0[r]=fsub_s(P0[r],dl);P1[r]=fsub_s(P1[r],dl);} \
      } \
    _Pragma("unroll") for(int r=0;r<16;++r)P0[r]=__builtin_amdgcn_exp2f(P0[r]); }while(0)
  #define RESC() do{ if(resc){ asm volatile("s_waitcnt lgkmcnt(0)":::"memory"); \
      _Pragma("unroll") for(int d_=0;d_<2;++d_) _Pragma("unroll") for(int r=0;r<16;++r)o[d_][r]*=wsf[crow(r,hi)]; } }while(0)
  f32x16 pA0,pA1,pB0,pB1;
  int sl_prev=0,sl_cur=0,sl_next=SLOTB;
  #define ROT() do{sl_prev=sl_cur;sl_cur=sl_next;sl_next=(sl_next==(NSLOT-1)*SLOTB)?0:sl_next+SLOTB;}while(0)
  DMA_K(2,2*SLOTB);
  WAIT_BAR(3);
  BIAS(pA0,pA1,0); qkt(pA0,pA1,Kbase,qr,r32,hi);asm volatile("s_nop 15\n\ts_nop 7":"+v"(pA0),"+v"(pA1));CMASK(pA0,pA1,0);
  START(pA0,pA1);
  _Pragma("unroll") for(int r=0;r<16;++r)pA1[r]=__builtin_amdgcn_exp2f(pA1[r]);
  WAIT_BAR(0);
  DMA_K(3,0);DMA_V(1,SLOTB);
  ROT();
  kload8(kf,kp0+sl_cur);
  WAIT_BAR(2);
  s16x4 vlo[8],vhi[8]; u32x4 pw0,pw1,pw2,pw3;
  #define PKW(P,B) cvtpk_s(P[B],P[B+1])
  #define PAF(k) __builtin_bit_cast(bf16x8,pw##k)
  #define VFR(i) (bf16x8){vlo[i][0],vlo[i][1],vlo[i][2],vlo[i][3],vhi[i][0],vhi[i][1],vhi[i][2],vhi[i][3]}
  #define PIN(x) asm volatile("":"+v"(x))
  #define MX3(a,b,c) __builtin_fmaxf(__builtin_fmaxf((a),(b)),(c))
  #define GAPA(MF,A0,A1,A2,A3,W0,W1,PW) do{ MF; sacc+=A0; sacc+=A1; sacc+=A2; sacc+=A3; PIN(sacc); W0; W1; PIN(PW); SBAR(); }while(0)
  #define EX(v) __builtin_amdgcn_exp2f(v)
  #define GAPB(MF,X,B) do{ MF; X[B]=EX(X[B]); X[B+1]=EX(X[B+1]); X[B+2]=EX(X[B+2]); X[B+3]=EX(X[B+3]); PIN(X); SBAR(); }while(0)
  #define VRD(i) do{ vlo[i]=vtr(vp_+(((i)>>2)*4096+((i)&3)*1024)); vhi[i]=vtr(vp_+(((i)>>2)*4096+((i)&3)*1024+512)); }while(0)
  #define KRD(G,j) do{ if(G){ kload2(kf,kp0+sl_next,j); SBAR(); } }while(0)
  #define STEP(C0,C1,P0,P1,t,GK,GV,GL) do{ BIAS(C0,C1,t); SBAR(); \
    const lds_cptr vp_=vp0+sl_prev; \
    VRD(0); SBAR(); float sacc=(P0[0]+P0[1]); \
    GAPA(C0=__builtin_amdgcn_mfma_f32_32x32x16_bf16(kf[0],qr[0],C0,0,0,0), P0[2],P0[3],P0[4],P0[5],     pw0[0]=PKW(P0,0), pw0[1]=PKW(P0,2), pw0); \
    VRD(4); SBAR(); GAPA(C1=__builtin_amdgcn_mfma_f32_32x32x16_bf16(kf[1],qr[0],C1,0,0,0), P0[6],P0[7],P0[8],P0[9],     pw0[2]=PKW(P0,4), pw0[3]=PKW(P0,6), pw0); \
    VRD(1); SBAR(); GAPA(C0=__builtin_amdgcn_mfma_f32_32x32x16_bf16(kf[2],qr[1],C0,0,0,0),   P0[10],P0[11],P0[12],P0[13], pw1[0]=PKW(P0,8), pw1[1]=PKW(P0,10), pw1); \
    VRD(5); SBAR(); GAPA(C1=__builtin_amdgcn_mfma_f32_32x32x16_bf16(kf[3],qr[1],C1,0,0,0),   P0[14],P0[15],P1[0],P1[1],   pw1[2]=PKW(P0,12),pw1[3]=PKW(P0,14), pw1); \
    VRD(2); SBAR(); GAPA(C0=__builtin_amdgcn_mfma_f32_32x32x16_bf16(kf[4],qr[2],C0,0,0,0),   P1[2],P1[3],P1[4],P1[5],     pw2[0]=PKW(P1,0), pw2[1]=PKW(P1,2), pw2); \
    VRD(6); SBAR(); GAPA(C1=__builtin_amdgcn_mfma_f32_32x32x16_bf16(kf[5],qr[2],C1,0,0,0),   P1[6],P1[7],P1[8],P1[9],     pw2[2]=PKW(P1,4), pw2[3]=PKW(P1,6), pw2); \
    VRD(3); SBAR(); GAPA(C0=__builtin_amdgcn_mfma_f32_32x32x16_bf16(kf[6],qr[3],C0,0,0,0),   P1[10],P1[11],P1[12],P1[13], pw3[0]=PKW(P1,8), pw3[1]=PKW(P1,10), pw3); \
    VRD(7); SBAR(); GAPA(C1=__builtin_amdgcn_mfma_f32_32x32x16_bf16(kf[7],qr[3],C1,0,0,0),   P1[14],P1[15],0.f,0.f,       pw3[2]=PKW(P1,12),pw3[3]=PKW(P1,14), pw3); \
    l_reg+=sacc; \
    if(GK){DMA_K((t)+3,sl_cur);} if(GV){DMA_V((t)+1,sl_next);} \
    CMASK(C0,C1,t); \
    { float a=MX3(C0[0],C0[1],C1[0]),b=MX3(C0[2],C0[3],C1[1]); a=MX3(a,C1[2],C1[3]); \
      _Pragma("unroll") for(int r=4;r<16;r+=4){a=MX3(a,C0[r],C0[r+1]);b=MX3(b,C0[r+2],C0[r+3]);a=MX3(a,C1[r],C1[r+1]);b=MX3(b,C1[r+2],C1[r+3]);} \
      float rm=__builtin_fmaxf(a,b); { auto rr=__builtin_amdgcn_permlane32_swap(__float_as_uint(rm),__float_as_uint(rm),false,false); rm=__builtin_fmaxf(__uint_as_float(rr[0]),__uint_as_float(rr[1])); } \
      resc=false; \
      if(__builtin_expect(__any(rm>(float)THRL),0)){ const float dl=__builtin_fmaxf(rm,0.f); mhat+=dl; \
        _Pragma("unroll") for(int r=0;r<16;++r){C0[r]-=dl;C1[r]-=dl;} \
        const float f=__builtin_amdgcn_exp2f(-dl); l_reg*=f; if(hi==0)wsf[r32]=f; resc=true; } } \
    SBAR(); \
    GAPB(o[0]=__builtin_amdgcn_mfma_f32_32x32x16_bf16(PAF(0),VFR(0),o[0],0,0,0), C0,0); \
    GAPB(o[1]=__builtin_amdgcn_mfma_f32_32x32x16_bf16(PAF(0),VFR(4),o[1],0,0,0), C0,4); \
    KRD(GL,0); GAPB(o[0]=__builtin_amdgcn_mfma_f32_32x32x16_bf16(PAF(1),VFR(1),o[0],0,0,0), C0,8); \
    KRD(GL,1); GAPB(o[1]=__builtin_amdgcn_mfma_f32_32x32x16_bf16(PAF(1),VFR(5),o[1],0,0,0), C0,12); \
    KRD(GL,2); GAPB(o[0]=__builtin_amdgcn_mfma_f32_32x32x16_bf16(PAF(2),VFR(2),o[0],0,0,0), C1,0); \
    KRD(GL,3); GAPB(o[1]=__builtin_amdgcn_mfma_f32_32x32x16_bf16(PAF(2),VFR(6),o[1],0,0,0), C1,4); \
    GAPB(o[0]=__builtin_amdgcn_mfma_f32_32x32x16_bf16(PAF(3),VFR(3),o[0],0,0,0), C1,8); \
    GAPB(o[1]=__builtin_amdgcn_mfma_f32_32x32x16_bf16(PAF(3),VFR(7),o[1],0,0,0), C1,12); \
    }while(0)
  int t=1;
  #undef CMASK
  #define CMASK(P0,P1,t) do{}while(0)
  for(;t+5<NT;t+=2){
    STEP(pB0,pB1,pA0,pA1,t,true,true,true);     WAIT_BAR(2); RESC(); ROT();
    STEP(pA0,pA1,pB0,pB1,t+1,true,true,true);   WAIT_BAR(2); RESC(); ROT();
  }
  #undef CMASK
  #define CMASK(P0,P1,t) do{ if(MODE==0){int jb_=(t)-(NT-4); if(jb_>=0)cmask(P0,P1,jb_,qrel,hi);} }while(0)
  #define ENDW(tt) do{ if((tt)+3<NT){WAIT_BAR(2);} else if((tt)+2<NT){WAIT_BAR(1);} else {WAIT_BAR(0);} }while(0)
  for(;t+1<NT;t+=2){
    STEP(pB0,pB1,pA0,pA1,t,(t+3<NT),(t+1<NT),(t+1<NT));       ENDW(t);   RESC(); ROT();
    STEP(pA0,pA1,pB0,pB1,t+1,(t+4<NT),(t+2<NT),(t+2<NT));     ENDW(t+1); RESC(); ROT();
  }
  STEP(pB0,pB1,pA0,pA1,NT-1,false,false,false); RESC();
  { float sacc=pB0[0]+pB0[1]; _Pragma("unroll") for(int r=2;r<16;++r)sacc+=pB0[r]; _Pragma("unroll") for(int r=0;r<16;++r)sacc+=pB1[r]; l_reg+=sacc;
    pw0=(u32x4){PKW(pB0,0),PKW(pB0,2),PKW(pB0,4),PKW(pB0,6)};pw1=(u32x4){PKW(pB0,8),PKW(pB0,10),PKW(pB0,12),PKW(pB0,14)};pw2=(u32x4){PKW(pB1,0),PKW(pB1,2),PKW(pB1,4),PKW(pB1,6)};pw3=(u32x4){PKW(pB1,8),PKW(pB1,10),PKW(pB1,12),PKW(pB1,14)};
    SBAR(); pv(o,vb0+sl_cur,PAF(0),PAF(1),PAF(2),PAF(3)); }
  #undef PKW
  #undef PAF
  #undef VFR
  #undef PIN
  #undef MX3
  #undef GAPA
  #undef GAPB
  #undef EX
  #undef VRD
  #undef KRD
  #undef STEP
  #undef ENDW
  {auto rr=__builtin_amdgcn_permlane32_swap(__float_as_uint(l_reg),__float_as_uint(l_reg),false,false);l_reg=__uint_as_float(rr[0])+__uint_as_float(rr[1]);}
  if(hi==0)wsf[32+r32]=l_reg;asm volatile("s_waitcnt lgkmcnt(0)":::"memory");
  float rli[16];
  #pragma unroll
  for(int r=0;r<16;++r)rli[r]=__builtin_amdgcn_rcpf(wsf[32+crow(r,hi)]);
  bf16*Ow=O+(rowbase+q0+wid*QBLK)*DM+h*D;
  { bf16*stg=(bf16*)(shm+LDS_OST)+wid*2048;
    #pragma unroll
    for(int r=0;r<16;++r){const int orow=crow(r,hi);
      #pragma unroll
      for(int d0=0;d0<2;++d0)stg[orow*64+d0*32+r32]=__float2bfloat16(o[d0][r]*rli[r]);}
    asm volatile("s_waitcnt lgkmcnt(0)":::"memory");
    #pragma unroll
    for(int i=0;i<4;++i){const int row=i*8+(lane>>3),ch=lane&7; const u32x4 v=*(const u32x4*)(stg+row*64+ch*8); ATTN_STORE16(Ow+(long)row*DM+ch*8,v);} }
  asm volatile("s_waitcnt lgkmcnt(0)\n\ts_barrier":::"memory");
  #undef DMA_K
  #undef DMA_V
  #undef CMASK
  #undef START
  #undef RESC
  #undef ROT
  #undef BIAS
}
constexpr int ATTN_LDS_BYTES=LDS_BYTES;
#undef SBAR
#undef WAIT_BAR
}

typedef unsigned short bf16_t;
typedef float f32x4 __attribute__((ext_vector_type(4)));
typedef unsigned u32x4 __attribute__((ext_vector_type(4)));
typedef unsigned u32x2 __attribute__((ext_vector_type(2)));
#define LAS __attribute__((address_space(3)))

constexpr int LDS_BYTES = 147456;
constexpr int NWAVES = 8;

__device__ __forceinline__ unsigned f2bf(float f) { unsigned u = __builtin_bit_cast(unsigned, f); return (u + 0x7fffu + ((u >> 16) & 1u)) >> 16; }
typedef float f32x2_c __attribute__((ext_vector_type(2))); typedef __bf16 bf16x2_c __attribute__((ext_vector_type(2)));
__device__ __forceinline__ unsigned pk2(float lo, float hi) { const f32x2_c v = {lo, hi}; return __builtin_bit_cast(unsigned, __builtin_convertvector(v, bf16x2_c)); }
__device__ __forceinline__ float bf2f(unsigned short h) { return __builtin_bit_cast(float, (unsigned)h << 16); }
__device__ __forceinline__ float shfl_idx(float v, int src_lane) { return __builtin_bit_cast(float, __builtin_amdgcn_ds_bpermute(src_lane << 2, __builtin_bit_cast(int, v))); }
__device__ __forceinline__ float wave_sum(float v, int lane) {
#pragma unroll
    for (int o = 1; o < 64; o <<= 1) v += shfl_idx(v, lane ^ o);
    return v;
}
__device__ __forceinline__ float wave_max(float v, int lane) {
#pragma unroll
    for (int o = 1; o < 64; o <<= 1) v = fmaxf(v, shfl_idx(v, lane ^ o));
    return v;
}
__device__ __forceinline__ float lane_bcast(float v, int l) { return __builtin_bit_cast(float, __builtin_amdgcn_readlane(__builtin_bit_cast(int, v), l)); }

struct Args { const float* in[21]; float* out; unsigned char* ws; int ph_lo, ph_hi; };

struct WDesc { const float* W; const float* g; const float* W2; bf16_t* WT; int K, Nsrc, Ndst, kind; };
__device__ __forceinline__ void prep_item(const WDesc& d, int item, LAS float* scr, int lane) {
    const int nblk = d.Ndst / 32, kb = item / nblk, nb = item % nblk, k0 = 64 * kb, n0 = 32 * nb;
    int sc0 = n0, lim = d.Nsrc;
    if (d.kind == 1) { const int t = n0 >> 8, half = (n0 >> 7) & 1; sc0 = half * FF + t * 128 + (n0 & 127); }
    else if (d.kind == 2) { if (n0 >= 1792) sc0 = n0 - 240; else if (n0 > 1536) {
            if (n0 == 1568 && kb == 0) {
                bf16_t* T = d.WT + (size_t)1600 * d.K;
#pragma unroll
                for (int i = 0; i < 4; ++i) { const int n = 4 * lane + i; float w[16];
#pragma unroll
                    for (int r = 0; r < 16; ++r) w[r] = d.W2[r * 256 + n];
                    u32x4 o0, o1; o0.x = pk2(w[0], w[1]); o0.y = pk2(w[2], w[3]); o0.z = pk2(w[4], w[5]); o0.w = pk2(w[6], w[7]); o1.x = pk2(w[8], w[9]); o1.y = pk2(w[10], w[11]); o1.z = pk2(w[12], w[13]); o1.w = pk2(w[14], w[15]);
                    *(u32x4*)(T + n * 32) = o0; *(u32x4*)(T + n * 32 + 8) = o1; *(u32x4*)(T + n * 32 + 16) = (u32x4){0u, 0u, 0u, 0u}; *(u32x4*)(T + n * 32 + 24) = (u32x4){0u, 0u, 0u, 0u}; }
            }
            return; }
        else if (n0 == 1536) lim = 1552; }
    else if (d.kind == 3) { if (n0 >= 3104) return; }
    {
        const int kr = lane >> 3, c4 = (lane & 7) * 4, col = sc0 + c4;
        const bool ok = col + 3 < lim;
        f32x4 v[8]; float gg[8];
#pragma unroll
        for (int i = 0; i < 8; ++i) v[i] = ok ? __builtin_nontemporal_load((const f32x4*)(d.W + (size_t)(k0 + 8 * i + kr) * d.Nsrc + col)) : (f32x4){0.f, 0.f, 0.f, 0.f};
        if (d.g) {
#pragma unroll
            for (int i = 0; i < 8; ++i) gg[i] = d.g[k0 + 8 * i + kr];
        } else {
#pragma unroll
            for (int i = 0; i < 8; ++i) gg[i] = 1.0f;
        }
#pragma unroll
        for (int i = 0; i < 8; ++i) { LAS float* p = scr + (8 * i + kr) * 33 + c4; p[0] = v[i][0] * gg[i]; p[1] = v[i][1] * gg[i]; p[2] = v[i][2] * gg[i]; p[3] = v[i][3] * gg[i]; }
    }
    asm volatile("s_waitcnt lgkmcnt(0)" ::: "memory");
    const int c = lane & 7;
#pragma unroll
    for (int j = 0; j < 4; ++j) {
        const int n = (lane >> 3) + 8 * j; const LAS float* s = scr + (8 * c) * 33 + n;
        u32x4 o; o.x = pk2(s[0 * 33], s[1 * 33]); o.y = pk2(s[2 * 33], s[3 * 33]); o.z = pk2(s[4 * 33], s[5 * 33]); o.w = pk2(s[6 * 33], s[7 * 33]);
        *(u32x4*)(d.WT + (size_t)(n0 + n) * d.K + k0 + 8 * c) = o;
    }
    asm volatile("s_waitcnt lgkmcnt(0)" ::: "memory");
}
constexpr int I_GU = 16 * 176, I_DN = 44 * 32, I_IN = 16 * 104, I_OUT = 16 * 32;
constexpr int IT_GU = 0, IT_DN = 4 * I_GU, IT_IN = IT_DN + 4 * I_DN, IT_OUT = IT_IN + 2 * I_IN, IT_END = IT_OUT + 2 * I_OUT;
__device__ __forceinline__ void convert_items(const Args& a, LAS unsigned char* lds, int lo, int hi, int w, int nw, int wave, int lane) {
    LAS float* scr = (LAS float*)(lds + wave * 16384);
    unsigned char* ws = a.ws;
    const float* norm_g = a.in[8];
    for (int it = lo + w; it < hi; it += nw) {
        int r = it; WDesc d;
        if (r < 4 * I_GU) { const int i = r / I_GU; r -= i * I_GU;
            d = WDesc{a.in[9] + (size_t)i * DM * 2 * FF, norm_g + ((i >> 1) * 3 + (i & 1) * 2) * DM, nullptr, (bf16_t*)(ws + WS_WGU + i * SZ_WGU), DM, 2 * FF, 2 * FF, 1}; }
        else if ((r -= 4 * I_GU) < 4 * I_DN) { const int i = r / I_DN; r -= i * I_DN;
            d = WDesc{a.in[10] + (size_t)i * FF * DM, nullptr, nullptr, (bf16_t*)(ws + WS_WDN + i * SZ_WDN), FF, DM, DM, 0}; }
        else if ((r -= 4 * I_DN) < I_IN) d = WDesc{a.in[11], norm_g + 1 * DM, a.in[12], (bf16_t*)(ws + WS_WIN), DM, 3088, NIN, 2};
        else if ((r -= I_IN) < I_IN)     d = WDesc{a.in[17], norm_g + 4 * DM, nullptr, (bf16_t*)(ws + WS_WIN + SZ_WIN), DM, 3088, NIN, 3};
        else if ((r -= I_IN) < I_OUT)    d = WDesc{a.in[16], nullptr, nullptr, (bf16_t*)(ws + WS_WOUT), DM, DM, DM, 0};
        else { r -= I_OUT;               d = WDesc{a.in[19], nullptr, nullptr, (bf16_t*)(ws + WS_WOUT + SZ_WOUT), DM, DM, DM, 0}; }
        prep_item(d, r, scr, lane);
    }
}
__device__ __forceinline__ void convert_job(const Args& a, LAS unsigned char* lds, int job, int w, int nw, int wave, int lane) {
    switch (job) {
        case 0:  convert_items(a, lds, IT_GU, IT_GU + I_GU, w, nw, wave, lane); break;
        case 1:  convert_items(a, lds, IT_DN, IT_DN + I_DN, w, nw, wave, lane);
                 convert_items(a, lds, IT_IN, IT_IN + I_IN, w, nw, wave, lane);
                 convert_items(a, lds, IT_OUT, IT_OUT + I_OUT, w, nw, wave, lane);
                 convert_items(a, lds, IT_GU + I_GU, IT_GU + 2 * I_GU, w, nw, wave, lane); break;
        case 3:  convert_items(a, lds, IT_DN + I_DN, IT_DN + 2 * I_DN, w, nw, wave, lane);
                 convert_items(a, lds, IT_GU + 2 * I_GU, IT_GU + 3 * I_GU, w, nw, wave, lane); break;
        case 4:  convert_items(a, lds, IT_DN + 2 * I_DN, IT_DN + 3 * I_DN, w, nw, wave, lane);
                 convert_items(a, lds, IT_IN + I_IN, IT_IN + 2 * I_IN, w, nw, wave, lane);
                 convert_items(a, lds, IT_OUT + I_OUT, IT_OUT + 2 * I_OUT, w, nw, wave, lane);
                 convert_items(a, lds, IT_GU + 3 * I_GU, IT_GU + 4 * I_GU, w, nw, wave, lane); break;
        default: convert_items(a, lds, IT_DN + 3 * I_DN, IT_DN + 4 * I_DN, w, nw, wave, lane); break;
    }
}
__device__ __forceinline__ void p0_prologue(const Args& a, LAS unsigned char* lds, int gw, int NGW, int wave, int lane) {
    unsigned char* ws = a.ws;
    convert_job(a, lds, 0, gw, NGW, wave, lane);
    { int t9 = threadIdx.x; asm volatile("" : "+v"(t9)); lane = t9 & 63; }
    { float* pz = (float*)(ws + WS_PART + SZ_PART); for (int i = gw * 64 + lane; i < 6 * MT; i += NGW * 64) pz[i] = 0.f; }
    bf16_t* XB = (bf16_t*)(ws + WS_XB); float* part0 = (float*)(ws + WS_PART);
    for (int row = gw; row < MT; row += NGW) {
        const float* src = (row < MP) ? a.in[0] + (size_t)row * DM : a.in[1] + (size_t)(row - MP) * DM;
        float ss = 0.f;
        f32x4 xv[4];
#pragma unroll
        for (int j = 0; j < 4; ++j) xv[j] = __builtin_nontemporal_load((const f32x4*)src + lane + 64 * j);
#pragma unroll
        for (int j = 0; j < 4; ++j) {
            const f32x4 v = xv[j];
            ss += (v[0] * v[0] + v[1] * v[1]) + (v[2] * v[2] + v[3] * v[3]);
            u32x2 w; w.x = pk2(v[0], v[1]); w.y = pk2(v[2], v[3]);
            ((u32x2*)(XB + (size_t)row * DM))[lane + 64 * j] = w;
        }
        ss = wave_sum(ss, lane);
        if (lane == 0) part0[row] = ss;
    }
}
__device__ __forceinline__ void final_norm(const Args& a, int gw, int NGW, int lane) {
    const bf16_t* XB = (const bf16_t*)(a.ws + WS_XB); const float* part = (const float*)(a.ws + WS_PART + 6 * SZ_PART); const float* g = a.in[20];
    for (int row = gw; row < MT; row += NGW) {
        const float r = 1.0f / sqrtf(part[row] * (1.0f / 1024.0f) + EPS);
#pragma unroll
        for (int j = 0; j < 4; ++j) {
            const u32x2 w = ((const u32x2*)(XB + (size_t)row * DM))[lane + 64 * j]; const f32x4 gg = ((const f32x4*)g)[lane + 64 * j];
            const f32x4 v = {__builtin_bit_cast(float, w.x << 16), __builtin_bit_cast(float, w.x & 0xffff0000u), __builtin_bit_cast(float, w.y << 16), __builtin_bit_cast(float, w.y & 0xffff0000u)};
            ((f32x4*)(a.out + O_YP + (size_t)row * DM))[lane + 64 * j] = v * r * gg;
        }
    }
}
__device__ __forceinline__ float scan_incl(float v, int lane) {
#pragma unroll
    for (int o = 1; o < 64; o <<= 1) { const float t = shfl_idx(v, lane - o); if (lane >= o) v += t; }
    return v;
}
__device__ __forceinline__ float scan_incl_rev(float v, int lane) {
#pragma unroll
    for (int o = 1; o < 64; o <<= 1) { const float t = shfl_idx(v, lane + o); if (lane + o < 64) v += t; }
    return v;
}

typedef short bf16x8_t __attribute__((ext_vector_type(8)));
typedef float f32x16_t __attribute__((ext_vector_type(16)));
__device__ __forceinline__ int crow_(int r, int hi) { return (r & 3) + 8 * (r >> 2) + 4 * hi; }
template <int KS> __device__ __forceinline__ f32x16_t mma_tile(const LAS bf16_t* A, int lda, const LAS bf16_t* Bt, int ldb, f32x16_t acc, int r32, int hi, int aswz = 0, int bswz = 0) {
#pragma unroll
    for (int ks = 0; ks < KS; ++ks) {
        const bf16x8_t a = *(const LAS bf16x8_t*)(A + r32 * lda + 8 * ((2 * ks + hi) ^ aswz));
        const bf16x8_t b = *(const LAS bf16x8_t*)(Bt + r32 * ldb + 8 * ((2 * ks + hi) ^ bswz));
        acc = __builtin_amdgcn_mfma_f32_32x32x16_bf16(a, b, acc, 0, 0, 0);
    }
    return acc;
}
constexpr int G_BC = 0, G_QIN = 16384, G_KIN = 25600, G_ATT = 34816, G_VT = 44032, G_ST = 62464, G_SSQ = 80896, G_ATL = 81920, G_END = 90112;
__device__ __forceinline__ void unpack8(const u32x4 w, float (&k)[8]) {
    k[0] = __builtin_bit_cast(float, w.x << 16); k[1] = __builtin_bit_cast(float, w.x & 0xffff0000u); k[2] = __builtin_bit_cast(float, w.y << 16); k[3] = __builtin_bit_cast(float, w.y & 0xffff0000u);
    k[4] = __builtin_bit_cast(float, w.z << 16); k[5] = __builtin_bit_cast(float, w.z & 0xffff0000u); k[6] = __builtin_bit_cast(float, w.w << 16); k[7] = __builtin_bit_cast(float, w.w & 0xffff0000u);
}
template <int L> __device__ __forceinline__ void gla_bcum(LAS float* bc, const float* LOGA, size_t row0, int h, int lane) {
    float la[L];
#pragma unroll
    for (int j = 0; j < L; ++j) la[j] = LOGA[(row0 + j) * 256 + h * 64 + lane];
    float run = 0.f;
#pragma unroll
    for (int j = 0; j < L; ++j) { run += la[j]; bc[j * 64 + lane] = run; }
}
__device__ __forceinline__ void put_vt(LAS bf16_t* Vt, int ldj, int v0, int j, const u32x4 a, const u32x4 b) {
    const unsigned w[8] = {a.x, a.y, a.z, a.w, b.x, b.y, b.z, b.w};
#pragma unroll
    for (int e = 0; e < 8; ++e) { Vt[(v0 + 2 * e) * ldj + j] = (bf16_t)(w[e] & 0xffffu); Vt[(v0 + 2 * e + 1) * ldj + j] = (bf16_t)(w[e] >> 16); }
}
template <int L> __device__ __forceinline__ void gla_u_unit(LAS unsigned char* lds, const bf16_t* EB, const float* LOGA, size_t row0, int h, float* Uout, float* ATOT, const float* s0, float* sfin) {
    int tid_ = threadIdx.x; asm volatile("" : "+v"(tid_));
    const int tid = tid_, lane = tid & 63, wave = __builtin_amdgcn_readfirstlane(tid >> 6), r32 = lane & 31, hi = lane >> 5;
    constexpr int LDJ = L + 8;
    LAS float* bc = (LAS float*)(lds + G_BC); LAS bf16_t* KsT = (LAS bf16_t*)(lds + G_KIN); LAS bf16_t* Vt = (LAS bf16_t*)(lds + G_VT);
    if (wave == 0) gla_bcum<L>(bc, LOGA, row0, h, lane);
    __syncthreads();
    {
        const int j = tid >> 3, c8 = tid & 7;
        if (j < L) {
            const size_t row = row0 + j;
            float kf[8]; unpack8(*(const u32x4*)(EB + row * NIN + 256 + h * 64 + 8 * c8), kf);
            const f32x4 b0 = *(const LAS f32x4*)(bc + j * 64 + 8 * c8), b1 = *(const LAS f32x4*)(bc + j * 64 + 8 * c8 + 4);
            const f32x4 l0 = *(const LAS f32x4*)(bc + (L - 1) * 64 + 8 * c8), l1 = *(const LAS f32x4*)(bc + (L - 1) * 64 + 8 * c8 + 4);
#pragma unroll
            for (int e = 0; e < 4; ++e) {
                KsT[(8 * c8 + e) * LDJ + j] = (bf16_t)f2bf(kf[e] * __expf(l0[e] - b0[e]));
                KsT[(8 * c8 + 4 + e) * LDJ + j] = (bf16_t)f2bf(kf[4 + e] * __expf(l1[e] - b1[e]));
            }
            const u32x4 va = *(const u32x4*)(EB + row * NIN + 512 + h * 128 + 16 * c8), vb = *(const u32x4*)(EB + row * NIN + 512 + h * 128 + 16 * c8 + 8);
            put_vt(Vt, LDJ, 16 * c8, j, va, vb);
        }
    }
    __syncthreads();
    const int kt = wave >> 2, vt = wave & 3;
    f32x16_t acc = {};
    acc = mma_tile<L / 16>(KsT + 32 * kt * LDJ, LDJ, Vt + 32 * vt * LDJ, LDJ, acc, r32, hi);
#pragma unroll
    for (int r = 0; r < 16; ++r) {
        const int k = 32 * kt + crow_(r, hi), v = 32 * vt + r32;
        if (s0 == nullptr) Uout[k * 128 + v] = acc[r];
        else sfin[k * 128 + v] = __expf(bc[(L - 1) * 64 + k]) * s0[k * 128 + v] + acc[r];
    }
    if (s0 == nullptr && tid < 64) ATOT[tid] = __expf(bc[(L - 1) * 64 + tid]);
    __syncthreads();
}
template <int L> __device__ __forceinline__ void gla_o_unit(LAS unsigned char* lds, const bf16_t* EB, const float* LOGA, size_t row0, int h, int n, const float* Ub, const float* Ab, const float* s0,
                                                            const float* gnorm, bf16_t* OAB, float* pstate) {
    int tid_ = threadIdx.x; asm volatile("" : "+v"(tid_));
    const int tid = tid_, lane = tid & 63, wave = __builtin_amdgcn_readfirstlane(tid >> 6), r32 = lane & 31, hi = lane >> 5;
    constexpr int LDJ = L + 8, NIT = (L + 31) / 32, LDK = 72;
    LAS float* bc = (LAS float*)(lds + G_BC); LAS bf16_t* Qin = (LAS bf16_t*)(lds + G_QIN); LAS bf16_t* Kin = (LAS bf16_t*)(lds + G_KIN); LAS bf16_t* att = (LAS bf16_t*)(lds + G_ATT);
    LAS bf16_t* Vt = (LAS bf16_t*)(lds + G_VT); LAS bf16_t* St = (LAS bf16_t*)(lds + G_ST); LAS float* ssq = (LAS float*)(lds + G_SSQ); LAS float* atl = (LAS float*)(lds + G_ATL);
    if (wave == 0) gla_bcum<L>(bc, LOGA, row0, h, lane);
    const int nat = s0 ? 0 : (pstate ? n + 1 : n);
    for (int i = tid; i < nat * 64; i += 512) atl[i] = Ab[i];
    __syncthreads();
    {
        float S[16];
        const int k0 = tid >> 7, v = tid & 127;
        if (s0) {
#pragma unroll
            for (int i = 0; i < 16; ++i) S[i] = s0[tid + 512 * i];
        } else {
#pragma unroll
            for (int i = 0; i < 16; ++i) S[i] = 0.f;
            for (int m = 0; m < n; ++m) {
                const float* um = Ub + (size_t)m * 8192 + tid;
#pragma unroll
                for (int i = 0; i < 16; ++i) S[i] = atl[m * 64 + k0 + 4 * i] * S[i] + um[512 * i];
            }
            if (pstate) {
                const float* um = Ub + (size_t)n * 8192 + tid;
#pragma unroll
                for (int i = 0; i < 16; ++i) pstate[tid + 512 * i] = atl[n * 64 + k0 + 4 * i] * S[i] + um[512 * i];
            }
        }
#pragma unroll
        for (int i = 0; i < 16; ++i) St[v * LDK + k0 + 4 * i] = (bf16_t)f2bf(S[i]);
    }
    {
        const int j = tid >> 3, c8 = tid & 7;
        if (j < L) {
            const size_t row = row0 + j;
            float qf[8], kf[8]; unpack8(*(const u32x4*)(EB + row * NIN + h * 64 + 8 * c8), qf); unpack8(*(const u32x4*)(EB + row * NIN + 256 + h * 64 + 8 * c8), kf);
            const f32x4 b0 = *(const LAS f32x4*)(bc + j * 64 + 8 * c8), b1 = *(const LAS f32x4*)(bc + j * 64 + 8 * c8 + 4);
            float qi[8], ki[8];
#pragma unroll
            for (int e = 0; e < 4; ++e) { const float e0 = __expf(b0[e]), e1 = __expf(b1[e]); qi[e] = qf[e] * e0; qi[4 + e] = qf[4 + e] * e1; ki[e] = kf[e] * __builtin_amdgcn_rcpf(e0); ki[4 + e] = kf[4 + e] * __builtin_amdgcn_rcpf(e1); }
            u32x4 qw, kw; qw.x = pk2(qi[0], qi[1]); qw.y = pk2(qi[2], qi[3]); qw.z = pk2(qi[4], qi[5]); qw.w = pk2(qi[6], qi[7]);
            kw.x = pk2(ki[0], ki[1]); kw.y = pk2(ki[2], ki[3]); kw.z = pk2(ki[4], ki[5]); kw.w = pk2(ki[6], ki[7]);
            *(LAS u32x4*)(Qin + j * LDK + 8 * c8) = qw; *(LAS u32x4*)(Kin + j * LDK + 8 * c8) = kw;
            const u32x4 va = *(const u32x4*)(EB + row * NIN + 512 + h * 128 + 16 * c8), vb = *(const u32x4*)(EB + row * NIN + 512 + h * 128 + 16 * c8 + 8);
            put_vt(Vt, LDJ, 16 * c8, j, va, vb);
        } else if (j < 32 * NIT) {
            const u32x4 z = {0u, 0u, 0u, 0u};
            *(LAS u32x4*)(Qin + j * LDK + 8 * c8) = z; *(LAS u32x4*)(Kin + j * LDK + 8 * c8) = z;
        }
    }
    __syncthreads();
    const int vt = wave >> 1, it = wave & 1;
    f32x16_t acc = {};
    if (it < NIT) acc = mma_tile<4>(St + 32 * vt * LDK, LDK, Qin + 32 * it * LDK, LDK, acc, r32, hi);
    if (wave < NIT * NIT) {
        const int ti = wave / NIT, tj = wave % NIT;
        f32x16_t s = {};
        s = mma_tile<4>(Qin + 32 * ti * LDK, LDK, Kin + 32 * tj * LDK, LDK, s, r32, hi);
        const int j = 32 * tj + r32;
        if (j < L) {
#pragma unroll
            for (int r = 0; r < 16; ++r) { const int i = 32 * ti + crow_(r, hi); att[i * LDJ + j] = (bf16_t)f2bf(i >= j ? s[r] : 0.f); }
        }
    }
    __syncthreads();
    if (it < NIT) acc = mma_tile<L / 16>(Vt + 32 * vt * LDJ, LDJ, att + 32 * it * LDJ, LDJ, acc, r32, hi);
    {
        float ss = 0.f;
#pragma unroll
        for (int r = 0; r < 16; ++r) ss += acc[r] * acc[r];
        ss += shfl_idx(ss, lane ^ 32);
        if (it < NIT && hi == 0) ssq[vt * 64 + 32 * it + r32] = ss;
    }
    u32x2 gwv[4]; f32x4 gnv[4];
#pragma unroll
    for (int gq = 0; gq < 4; ++gq) { const int v0 = 32 * vt + 8 * gq + 4 * hi; const int ic = (32 * it + r32 < L) ? 32 * it + r32 : 0;
        gwv[gq] = *(const u32x2*)(EB + (row0 + ic) * NIN + 1024 + h * 128 + v0); gnv[gq] = *(const f32x4*)(gnorm + v0); }
    __syncthreads();
    if (it < NIT) {
        const int i = 32 * it + r32;
        if (i < L) {
            const float tot = (ssq[i] + ssq[64 + i]) + (ssq[128 + i] + ssq[192 + i]);
            const float rr = __builtin_amdgcn_rsqf(tot * (1.0f / 128.0f) + EPS);
            const size_t row = row0 + i;
#pragma unroll
            for (int g = 0; g < 4; ++g) {
                const int v0 = 32 * vt + 8 * g + 4 * hi;
                const u32x2 gw = gwv[g]; const f32x4 gn = gnv[g];
                const float o0 = acc[4 * g + 0] * rr * gn[0] * __builtin_bit_cast(float, gw.x << 16), o1 = acc[4 * g + 1] * rr * gn[1] * __builtin_bit_cast(float, gw.x & 0xffff0000u);
                const float o2 = acc[4 * g + 2] * rr * gn[2] * __builtin_bit_cast(float, gw.y << 16), o3 = acc[4 * g + 3] * rr * gn[3] * __builtin_bit_cast(float, gw.y & 0xffff0000u);
                u32x2 ow; ow.x = pk2(o0, o1); ow.y = pk2(o2, o3);
                *(u32x2*)(OAB + row * DM + h * 128 + v0) = ow;
            }
        }
    }
    __syncthreads();
}

__device__ __forceinline__ void gla_m1_group(LAS unsigned char* lds, const bf16_t* EB, const float* LOGA, int bh, int g4, bf16_t* QIN, bf16_t* KIN, float* GU, float* GA, float* GT, float* GAG) {
    int tid_ = threadIdx.x; asm volatile("" : "+v"(tid_));
    const int tid = tid_, lane = tid & 63, wave = __builtin_amdgcn_readfirstlane(tid >> 6), r32 = lane & 31, hi = lane >> 5;
    constexpr int LDJ = 72;
    LAS float* bc = (LAS float*)(lds + G_BC); LAS bf16_t* KsT = (LAS bf16_t*)(lds + G_KIN); LAS bf16_t* Vt = (LAS bf16_t*)(lds + G_VT); LAS float* tot = (LAS float*)(lds + G_ATL);
    const int b = bh >> 2, h = bh & 3, kt = wave >> 2, vt = wave & 3;
    const int j = tid >> 3, c8 = tid & 7;
    const int jsw = (((j >> 3) ^ c8) << 3) | (j & 7);
    f32x16_t T = {};
    float blsum = 0.f;
    struct In { float la[8]; u32x4 q, k, va, vb; };
    auto load_in = [&](In& s, int n) {
        const size_t row0 = (size_t)b * TSEQ + 64 * n, row = row0 + j;
#pragma unroll
        for (int i = 0; i < 8; ++i) s.la[i] = LOGA[(row0 + 8 * wave + i) * 256 + h * 64 + lane];
        s.q = *(const u32x4*)(EB + row * NIN + h * 64 + 8 * c8); s.k = *(const u32x4*)(EB + row * NIN + 256 + h * 64 + 8 * c8);
        s.va = *(const u32x4*)(EB + row * NIN + 512 + h * 128 + 16 * c8); s.vb = *(const u32x4*)(EB + row * NIN + 512 + h * 128 + 16 * c8 + 8);
    };
    In in[2];
    load_in(in[0], 4 * g4);
#pragma unroll
    for (int c = 0; c < 4; ++c) {
        In& s = in[c & 1];
        const int n = 4 * g4 + c; const size_t row0 = (size_t)b * TSEQ + 64 * n;
        {
            float run = 0.f;
#pragma unroll
            for (int i = 0; i < 8; ++i) { run += s.la[i]; s.la[i] = run; }
            tot[wave * 64 + lane] = run;
            __syncthreads();
            float off = 0.f;
            for (int w2 = 0; w2 < wave; ++w2) off += tot[w2 * 64 + lane];
#pragma unroll
            for (int i = 0; i < 8; ++i) bc[(8 * wave + i) * 64 + lane] = s.la[i] + off;
        }
        __syncthreads();
        {
            const size_t row = row0 + j;
            float qf[8], kf[8]; unpack8(s.q, qf); unpack8(s.k, kf);
            const f32x4 b0 = *(const LAS f32x4*)(bc + j * 64 + 8 * c8), b1 = *(const LAS f32x4*)(bc + j * 64 + 8 * c8 + 4);
            const f32x4 l0 = *(const LAS f32x4*)(bc + 63 * 64 + 8 * c8), l1 = *(const LAS f32x4*)(bc + 63 * 64 + 8 * c8 + 4);
            float qi[8], ki[8];
#pragma unroll
            for (int e = 0; e < 4; ++e) {
                const float e0 = __expf(b0[e]), e1 = __expf(b1[e]), r0 = __builtin_amdgcn_rcpf(e0), r1 = __builtin_amdgcn_rcpf(e1);
                qi[e] = qf[e] * e0; qi[4 + e] = qf[4 + e] * e1; ki[e] = kf[e] * r0; ki[4 + e] = kf[4 + e] * r1;
                KsT[(8 * c8 + e) * LDJ + jsw] = (bf16_t)f2bf(ki[e] * __expf(l0[e])); KsT[(8 * c8 + 4 + e) * LDJ + jsw] = (bf16_t)f2bf(ki[4 + e] * __expf(l1[e]));
            }
            u32x4 qw, kw; qw.x = pk2(qi[0], qi[1]); qw.y = pk2(qi[2], qi[3]); qw.z = pk2(qi[4], qi[5]); qw.w = pk2(qi[6], qi[7]);
            kw.x = pk2(ki[0], ki[1]); kw.y = pk2(ki[2], ki[3]); kw.z = pk2(ki[4], ki[5]); kw.w = pk2(ki[6], ki[7]);
            *(u32x4*)(QIN + row * 256 + h * 64 + 8 * c8) = qw; *(u32x4*)(KIN + row * 256 + h * 64 + 8 * c8) = kw;
            put_vt(Vt, LDJ, 16 * c8, jsw, s.va, s.vb);
        }
        if (c < 3) load_in(in[(c + 1) & 1], n + 1);
        __syncthreads();
        {
            f32x16_t acc = {};
            acc = mma_tile<4>(KsT + 32 * kt * LDJ, LDJ, Vt + 32 * vt * LDJ, LDJ, acc, r32, hi, (4 * kt + (r32 >> 3)) & 7, (2 * vt + (r32 >> 4)) & 7);
            float* Un = GU + (size_t)(bh * 32 + n) * 8192;
#pragma unroll
            for (int r = 0; r < 16; ++r) {
                const int k = 32 * kt + crow_(r, hi), v = 32 * vt + r32;
                Un[k * 128 + v] = acc[r];
                T[r] = __expf(bc[63 * 64 + k]) * T[r] + acc[r];
            }
            if (tid < 64) { const float bl = bc[63 * 64 + tid]; GA[(size_t)(bh * 32 + n) * 64 + tid] = __expf(bl); blsum += bl; }
        }
        __syncthreads();
    }
    {
        float* Tg = GT + (size_t)(bh * 8 + g4) * 8192;
#pragma unroll
        for (int r = 0; r < 16; ++r) __hip_atomic_store(Tg + (32 * kt + crow_(r, hi)) * 128 + 32 * vt + r32, T[r], __ATOMIC_RELAXED, __HIP_MEMORY_SCOPE_AGENT);
        if (tid < 64) __hip_atomic_store(GAG + (size_t)(bh * 8 + g4) * 64 + tid, __expf(blsum), __ATOMIC_RELAXED, __HIP_MEMORY_SCOPE_AGENT);
    }
}
__device__ __forceinline__ void gla_m2_group(LAS unsigned char* lds, const bf16_t* EB, int bh, int g4, const bf16_t* QIN, const bf16_t* KIN, const float* GU, const float* GA, const float* GT, const float* GAG,
                                             const float* gnorm, bf16_t* OAB, float* pstate) {
    int tid_ = threadIdx.x; asm volatile("" : "+v"(tid_));
    const int tid = tid_, lane = tid & 63, wave = __builtin_amdgcn_readfirstlane(tid >> 6), r32 = lane & 31, hi = lane >> 5;
    constexpr int LDJ = 72, LDK = 72;
    LAS bf16_t* Qin = (LAS bf16_t*)(lds + G_QIN); LAS bf16_t* Kin = (LAS bf16_t*)(lds + G_KIN); LAS bf16_t* att = (LAS bf16_t*)(lds + G_ATT);
    LAS bf16_t* Vt = (LAS bf16_t*)(lds + G_VT); LAS bf16_t* St = (LAS bf16_t*)(lds + G_ST); LAS float* ssq = (LAS float*)(lds + G_SSQ); LAS float* atl = (LAS float*)(lds + G_ATL);
    const int b = bh >> 2, h = bh & 3, k0 = 16 * (tid >> 7), v = tid & 127, vt = wave >> 1, it = wave & 1;
    const int j = tid >> 3, c8 = tid & 7, jsw = (((j >> 3) ^ c8) << 3) | (j & 7);
    struct In { float un[16]; u32x4 q, k, va, vb; u32x2 gw[4]; };
    auto load_in = [&](In& s, int n) {
        const size_t row0 = (size_t)b * TSEQ + 64 * n, row = row0 + j;
        s.q = *(const u32x4*)(QIN + row * 256 + h * 64 + 8 * c8); s.k = *(const u32x4*)(KIN + row * 256 + h * 64 + 8 * c8);
        s.va = *(const u32x4*)(EB + row * NIN + 512 + h * 128 + 16 * c8); s.vb = *(const u32x4*)(EB + row * NIN + 512 + h * 128 + 16 * c8 + 8);
#pragma unroll
        for (int g = 0; g < 4; ++g) s.gw[g] = *(const u32x2*)(EB + (row0 + 32 * it + r32) * NIN + 1024 + h * 128 + 32 * vt + 8 * g + 4 * hi);
        const float* up = GU + (size_t)(bh * 32 + n) * 8192 + k0 * 128 + v;
#pragma unroll
        for (int i = 0; i < 16; ++i) s.un[i] = up[128 * i];
    };
    In in[2];
    load_in(in[0], 4 * g4);
    f32x4 gnv[4];
#pragma unroll
    for (int g = 0; g < 4; ++g) gnv[g] = *(const f32x4*)(gnorm + 32 * vt + 8 * g + 4 * hi);
    for (int i = tid; i < g4 * 64; i += 512) atl[i] = GAG[(size_t)bh * 8 * 64 + i];
    for (int i = tid; i < 4 * 64; i += 512) atl[g4 * 64 + i] = GA[(size_t)(bh * 32 + 4 * g4) * 64 + i];
    __syncthreads();
    float S[16];
#pragma unroll
    for (int i = 0; i < 16; ++i) S[i] = 0.f;
    for (int g = 0; g < g4; ++g) {
        const float* tg = GT + (size_t)(bh * 8 + g) * 8192 + k0 * 128 + v;
        float tgv[16];
#pragma unroll
        for (int i = 0; i < 16; ++i) tgv[i] = tg[128 * i];
#pragma unroll
        for (int i = 0; i < 16; ++i) S[i] = atl[g * 64 + k0 + i] * S[i] + tgv[i];
    }
#pragma unroll
    for (int c = 0; c < 4; ++c) {
        In& s = in[c & 1];
        const int n = 4 * g4 + c; const size_t row0 = (size_t)b * TSEQ + 64 * n;
        { u32x4 w0, w1; w0.x = pk2(S[0], S[1]); w0.y = pk2(S[2], S[3]); w0.z = pk2(S[4], S[5]); w0.w = pk2(S[6], S[7]);
          w1.x = pk2(S[8], S[9]); w1.y = pk2(S[10], S[11]); w1.z = pk2(S[12], S[13]); w1.w = pk2(S[14], S[15]);
          *(LAS u32x4*)(St + v * LDK + k0) = w0; *(LAS u32x4*)(St + v * LDK + k0 + 8) = w1; }
        *(LAS u32x4*)(Qin + j * LDK + 8 * c8) = s.q; *(LAS u32x4*)(Kin + j * LDK + 8 * c8) = s.k;
        put_vt(Vt, LDJ, 16 * c8, jsw, s.va, s.vb);
        if (c < 3) load_in(in[(c + 1) & 1], n + 1);
        __syncthreads();
        f32x16_t acc = {};
        acc = mma_tile<4>(St + 32 * vt * LDK, LDK, Qin + 32 * it * LDK, LDK, acc, r32, hi);
        if (wave < 4) {
            const int ti = wave >> 1, tj = wave & 1;
            f32x16_t sc = {};
            sc = mma_tile<4>(Qin + 32 * ti * LDK, LDK, Kin + 32 * tj * LDK, LDK, sc, r32, hi);
            const int jj = 32 * tj + r32;
#pragma unroll
            for (int r = 0; r < 16; ++r) { const int i = 32 * ti + crow_(r, hi); att[i * LDJ + jj] = (bf16_t)f2bf(i >= jj ? sc[r] : 0.f); }
        }
        __syncthreads();
        acc = mma_tile<4>(Vt + 32 * vt * LDJ, LDJ, att + 32 * it * LDJ, LDJ, acc, r32, hi, (2 * vt + (r32 >> 4)) & 7, 0);
        {
            float ss = 0.f;
#pragma unroll
            for (int r = 0; r < 16; ++r) ss += acc[r] * acc[r];
            ss += shfl_idx(ss, lane ^ 32);
            if (hi == 0) ssq[vt * 64 + 32 * it + r32] = ss;
        }
        __syncthreads();
        {
            const int i = 32 * it + r32;
            const float tot = (ssq[i] + ssq[64 + i]) + (ssq[128 + i] + ssq[192 + i]);
            const float rr = __builtin_amdgcn_rsqf(tot * (1.0f / 128.0f) + EPS);
            const size_t row = row0 + i;
#pragma unroll
            for (int g = 0; g < 4; ++g) {
                const int v0 = 32 * vt + 8 * g + 4 * hi;
                const u32x2 gw = s.gw[g];
                const f32x4 gn = gnv[g];
                const float o0 = acc[4 * g + 0] * rr * gn[0] * __builtin_bit_cast(float, gw.x << 16), o1 = acc[4 * g + 1] * rr * gn[1] * __builtin_bit_cast(float, gw.x & 0xffff0000u);
                const float o2 = acc[4 * g + 2] * rr * gn[2] * __builtin_bit_cast(float, gw.y << 16), o3 = acc[4 * g + 3] * rr * gn[3] * __builtin_bit_cast(float, gw.y & 0xffff0000u);
                u32x2 ow; ow.x = pk2(o0, o1); ow.y = pk2(o2, o3);
                *(u32x2*)(OAB + row * DM + h * 128 + v0) = ow;
            }
        }
#pragma unroll
        for (int i = 0; i < 16; ++i) S[i] = atl[(g4 + c) * 64 + k0 + i] * S[i] + s.un[i];
    }
    if (pstate) {
#pragma unroll
        for (int i = 0; i < 16; ++i) pstate[(k0 + i) * 128 + v] = S[i];
    }
    __syncthreads();
}

constexpr int SA_CB = 0, SA_OW = 16384, SA_MW = 81920, SA_LW = 82944, SA_FQ = 83968, SA_TOT = 84096, SA_END = 84224;
constexpr float FOX_SKIP2 = 160.0f * LOG2E;
template <int MODE> __device__ __forceinline__ void sample_attn_unit(LAS unsigned char* lds, const bf16_t* EB, int qcol, int kcol, int vcol, const float* ck, const float* cv, int kstr, int Lc,
                                                                       int b, int h, const float* clf  , const float* LOGF, const float* relb, bf16_t* OAB, int ocol) {
    int tid_ = threadIdx.x; asm volatile("" : "+v"(tid_));
    const int tid = tid_, lane = tid & 63, wave = __builtin_amdgcn_readfirstlane(tid >> 6), r32 = lane & 31, hi = lane >> 5;
    const size_t row0 = (size_t)MP + b * SSEQ;
    LAS float* cb = (LAS float*)(lds + SA_CB); LAS float* ow = (LAS float*)(lds + SA_OW); LAS float* mw = (LAS float*)(lds + SA_MW); LAS float* lw = (LAS float*)(lds + SA_LW);
    LAS float* fqb = (LAS float*)(lds + SA_FQ); LAS float* tot = (LAS float*)(lds + SA_TOT);
    if (MODE == 0) {
        float carry = 0.f;
        float lfv[8];
#pragma unroll
        for (int c = 0; c < 8; ++c) lfv[c] = clf[(size_t)(512 * wave + 64 * c + lane) * 16 + h];
#pragma unroll
        for (int c = 7; c >= 0; --c) {
            const int key = 512 * wave + 64 * c + lane;
            const float lf = lfv[c];
            const float suf = scan_incl_rev(lf, lane);
            cb[key] = carry + suf - lf;
            carry += lane_bcast(suf, 0);
        }
        if (lane == 0) tot[wave] = carry;
        if (wave == 0) { const float lf = (lane < 16) ? LOGF[(row0 + lane) * 16 + h] : 0.f; const float fq = scan_incl(lf, lane); if (lane < 16) fqb[lane] = -fq * LOG2E; }
        __syncthreads();
        float off = 0.f;
        for (int w2 = wave + 1; w2 < 8; ++w2) off += tot[w2];
        for (int c = 0; c < 8; ++c) { const int key = 512 * wave + 64 * c + lane; cb[key] = (cb[key] + off) * LOG2E; }
    } else {
        for (int x = tid; x < 320; x += NWAVES * 64) cb[x] = relb[h * 257 + (x < 256 ? x : 256)] * LOG2E;
    }
    __syncthreads();
    int s_first = 0;
    if (MODE == 0) {
        LAS int* smin = (LAS int*)(lds + SA_TOT + 64);
        if (tid == 0) *smin = Lc / 32 - 1;
        __syncthreads();
        if (tid < Lc / 32 && cb[32 * tid + 31] >= -FOX_SKIP2) atomicMin((int*)smin, tid);
        __syncthreads();
        s_first = __builtin_amdgcn_readfirstlane(*smin);
    }
    bf16x8_t qf[4];
#pragma unroll
    for (int ds = 0; ds < 4; ++ds) qf[ds] = *(const bf16x8_t*)(EB + (row0 + (r32 & 15)) * NIN + qcol + h * 64 + 16 * ds + 8 * hi);
    float m = -INFINITY, l = 0.f; f32x16_t o0 = {}, o1 = {};
    const int q = r32;
    auto softmax_pv = [&](f32x16_t s, const bf16x8_t (&vf)[2][2]) {
        float mx = s[0];
#pragma unroll
        for (int r = 1; r < 16; ++r) mx = fmaxf(mx, s[r]);
        mx = fmaxf(mx, shfl_idx(mx, lane ^ 32));
        const float mn = fmaxf(m, mx), alpha = __builtin_amdgcn_exp2f(m - mn);
        float ps = 0.f; float p[16];
#pragma unroll
        for (int r = 0; r < 16; ++r) { p[r] = __builtin_amdgcn_exp2f(s[r] - mn); ps += p[r]; }
        l = l * alpha + ps; m = mn;
#pragma unroll
        for (int r = 0; r < 16; ++r) { o0[r] *= alpha; o1[r] *= alpha; }
        u32x4 w0, w1; w0.x = pk2(p[0], p[1]); w0.y = pk2(p[2], p[3]); w0.z = pk2(p[4], p[5]); w0.w = pk2(p[6], p[7]);
        w1.x = pk2(p[8], p[9]); w1.y = pk2(p[10], p[11]); w1.z = pk2(p[12], p[13]); w1.w = pk2(p[14], p[15]);
        const bf16x8_t pf0 = __builtin_bit_cast(bf16x8_t, w0), pf1 = __builtin_bit_cast(bf16x8_t, w1);
        o0 = __builtin_amdgcn_mfma_f32_32x32x16_bf16(vf[0][0], pf0, o0, 0, 0, 0); o0 = __builtin_amdgcn_mfma_f32_32x32x16_bf16(vf[0][1], pf1, o0, 0, 0, 0);
        o1 = __builtin_amdgcn_mfma_f32_32x32x16_bf16(vf[1][0], pf0, o1, 0, 0, 0); o1 = __builtin_amdgcn_mfma_f32_32x32x16_bf16(vf[1][1], pf1, o1, 0, 0, 0);
    };
    const int n_sub = Lc / 32 - s_first;
    const int NS = (((n_sub + 7) >> 3) + 1) & ~1;
    auto load_kv = [&](f32x4 (&ka)[4][2], float (&vv)[2][2][8], int key0) {
        const float* kp = ck + (size_t)(key0 + r32) * kstr + 8 * hi;
#pragma unroll
        for (int ds = 0; ds < 4; ++ds) { ka[ds][0] = *(const f32x4*)(kp + 16 * ds); ka[ds][1] = *(const f32x4*)(kp + 16 * ds + 4); }
#pragma unroll
        for (int db = 0; db < 2; ++db)
#pragma unroll
            for (int ks = 0; ks < 2; ++ks)
#pragma unroll
                for (int j = 0; j < 8; ++j) vv[db][ks][j] = cv[(size_t)(key0 + 16 * ks + 8 * (j >> 2) + 4 * hi + (j & 3)) * kstr + 32 * db + r32];
    };
    auto step = [&](const f32x4 (&ka)[4][2], const float (&vv)[2][2][8], int key0) {
        f32x16_t s = {};
#pragma unroll
        for (int ds = 0; ds < 4; ++ds) {
            u32x4 w; w.x = pk2(ka[ds][0][0], ka[ds][0][1]); w.y = pk2(ka[ds][0][2], ka[ds][0][3]); w.z = pk2(ka[ds][1][0], ka[ds][1][1]); w.w = pk2(ka[ds][1][2], ka[ds][1][3]);
            s = __builtin_amdgcn_mfma_f32_32x32x16_bf16(__builtin_bit_cast(bf16x8_t, w), qf[ds], s, 0, 0, 0);
        }
        bf16x8_t vf[2][2];
#pragma unroll
        for (int db = 0; db < 2; ++db)
#pragma unroll
            for (int ks = 0; ks < 2; ++ks) { u32x4 w; w.x = pk2(vv[db][ks][0], vv[db][ks][1]); w.y = pk2(vv[db][ks][2], vv[db][ks][3]); w.z = pk2(vv[db][ks][4], vv[db][ks][5]); w.w = pk2(vv[db][ks][6], vv[db][ks][7]);
                vf[db][ks] = __builtin_bit_cast(bf16x8_t, w); }
        if (MODE == 0) {
#pragma unroll
            for (int g = 0; g < 4; ++g) { const f32x4 bb = *(const LAS f32x4*)(cb + key0 + 8 * g + 4 * hi);
#pragma unroll
                for (int e = 0; e < 4; ++e) s[4 * g + e] += bb[e]; }
        } else {
#pragma unroll
            for (int r = 0; r < 16; ++r) { const int ix = (Lc - (key0 + crow_(r, hi))) + (q & 15) + 128; s[r] += cb[ix > 256 ? 256 : ix]; }
        }
        softmax_pv(s, vf);
    };
    {
        f32x4 kaA[4][2], kaB[4][2]; float vvA[2][2][8], vvB[2][2][8];
        const int kbase = 32 * (s_first + wave * NS);
        if (kbase < Lc) load_kv(kaA, vvA, kbase);
        for (int sub = 0; sub < NS; sub += 2) {
            const int kA = kbase + 32 * sub, kB = kA + 32, kC = kA + 64;
            if (kB < Lc) load_kv(kaB, vvB, kB);
            if (kA < Lc) step(kaA, vvA, kA);
            if (sub + 2 < NS && kC < Lc) load_kv(kaA, vvA, kC);
            if (kB < Lc) step(kaB, vvB, kB);
        }
    }
    if (wave == 0) {
        f32x16_t s = {};
#pragma unroll
        for (int ds = 0; ds < 4; ++ds) { const bf16x8_t kf = *(const bf16x8_t*)(EB + (row0 + (r32 & 15)) * NIN + kcol + h * 64 + 16 * ds + 8 * hi); s = __builtin_amdgcn_mfma_f32_32x32x16_bf16(kf, qf[ds], s, 0, 0, 0); }
        bf16x8_t vf[2][2];
#pragma unroll
        for (int db = 0; db < 2; ++db)
#pragma unroll
            for (int ks = 0; ks < 2; ++ks) { bf16x8_t t;
#pragma unroll
                for (int j = 0; j < 8; ++j) t[j] = (short)EB[(row0 + ((16 * ks + 8 * (j >> 2) + 4 * hi + (j & 3)) & 15)) * NIN + vcol + h * 64 + 32 * db + r32];
                vf[db][ks] = t; }
#pragma unroll
        for (int r = 0; r < 16; ++r) {
            const int kn = crow_(r, hi);
            float bias;
            if (MODE == 0) bias = (kn < 16 && kn <= (q & 15)) ? fqb[kn & 15] : -INFINITY;
            else bias = (kn < 16) ? cb[(q & 15) - (kn & 15) + 128] : -INFINITY;
            s[r] += bias;
        }
        softmax_pv(s, vf);
    }
    {
        const float lt = l + shfl_idx(l, lane ^ 32);
        if (hi == 0) { mw[wave * 32 + q] = m; lw[wave * 32 + q] = lt; }
#pragma unroll
        for (int r = 0; r < 16; ++r) { ow[(wave * 64 + crow_(r, hi)) * 32 + q] = o0[r]; ow[(wave * 64 + 32 + crow_(r, hi)) * 32 + q] = o1[r]; }
    }
    __syncthreads();
    {
        const int qq = tid & 15, d0 = tid >> 4;
        float mm = mw[qq];
#pragma unroll
        for (int w = 1; w < 8; ++w) mm = fmaxf(mm, mw[w * 32 + qq]);
        float lt = 0.f, a0 = 0.f, a1 = 0.f;
#pragma unroll
        for (int w = 0; w < 8; ++w) { const float sc = __builtin_amdgcn_exp2f(mw[w * 32 + qq] - mm); lt += sc * lw[w * 32 + qq]; a0 += sc * ow[(w * 64 + d0) * 32 + qq]; a1 += sc * ow[(w * 64 + 32 + d0) * 32 + qq]; }
        const float inv = 1.0f / lt;
        OAB[(row0 + qq) * DM + ocol + h * 64 + d0] = (bf16_t)f2bf(a0 * inv); OAB[(row0 + qq) * DM + ocol + h * 64 + 32 + d0] = (bf16_t)f2bf(a1 * inv);
    }
    __syncthreads();
}

__device__ __forceinline__ void mini_gemm_unit(LAS unsigned char* lds, const bf16_t* A, const bf16_t* Bt, int K, int rb, int cbk, const float* xold, unsigned char* ws, int pout, float coef, const float* fin_gain, float* fin_out) {
    int tid_ = threadIdx.x; asm volatile("" : "+v"(tid_));
    const int tid = tid_, lane = tid & 63, wave = __builtin_amdgcn_readfirstlane(tid >> 6), r32 = lane & 31, hi = lane >> 5;
    const int kw = K >> 3;
    const bf16_t* ap = A + (size_t)(32 * rb + r32) * K + wave * kw + 8 * hi;
    const bf16_t* bp = Bt + (size_t)(32 * cbk + r32) * K + wave * kw + 8 * hi;
    f32x16_t acc0 = {};
    const int nks = kw / 16;
    for (int k0 = 0; k0 < nks; k0 += 12) {
        bf16x8_t a[12], b[12];
#pragma unroll
        for (int s = 0; s < 12; ++s) if (k0 + s < nks) { a[s] = *(const bf16x8_t*)(ap + 16 * (k0 + s)); b[s] = *(const bf16x8_t*)(bp + 16 * (k0 + s)); }
#pragma unroll
        for (int s = 0; s < 12; ++s) if (k0 + s < nks) acc0 = __builtin_amdgcn_mfma_f32_32x32x16_bf16(a[s], b[s], acc0, 0, 0, 0);
    }
    LAS float* red = (LAS float*)lds;
#pragma unroll
    for (int r = 0; r < 16; ++r) red[(wave * 32 + crow_(r, hi)) * 32 + r32] = acc0[r];
    __syncthreads();
    {
        const int row = tid >> 4, c2 = (tid & 15) * 2;
        typedef float f32x2_m __attribute__((ext_vector_type(2)));
        f32x2_m s = *(const LAS f32x2_m*)(red + row * 32 + c2);
#pragma unroll
        for (int w = 1; w < 8; ++w) s += *(const LAS f32x2_m*)(red + (w * 32 + row) * 32 + c2);
        const int grow = 32 * rb + row, col = 32 * cbk + c2;
        bf16_t* XB = (bf16_t*)(ws + WS_XB) + (size_t)(MP + grow) * DM + col;
        f32x2_m xo;
        if (xold) xo = *(const f32x2_m*)(xold + (size_t)grow * DM + col);
        else { const unsigned w = *(const unsigned*)XB; xo = (f32x2_m){__builtin_bit_cast(float, w << 16), __builtin_bit_cast(float, w & 0xffff0000u)}; }
        const f32x2_m xn = xo + s * coef;
        if (!fin_gain) *(unsigned*)XB = pk2(xn[0], xn[1]);
        float ss = xn[0] * xn[0] + xn[1] * xn[1];
        ss += shfl_idx(ss, lane ^ 1); ss += shfl_idx(ss, lane ^ 2); ss += shfl_idx(ss, lane ^ 4); ss += shfl_idx(ss, lane ^ 8);
        float* prow = (float*)(ws + WS_PART + (size_t)pout * SZ_PART) + (MP + grow);
        if ((tid & 15) == 0) atomicAdd(prow, ss);
        if (fin_gain) {
            unsigned* cnt = (unsigned*)(ws + 40960) + 16 * rb;
            asm volatile("s_waitcnt vmcnt(0)" ::: "memory");
            __syncthreads();
            if (tid == 0) {
                __hip_atomic_fetch_add(cnt, 1u, __ATOMIC_RELAXED, __HIP_MEMORY_SCOPE_AGENT);
                for (unsigned spins = 0; spins < (1u << 22); ++spins) { if (__hip_atomic_load(cnt, __ATOMIC_RELAXED, __HIP_MEMORY_SCOPE_AGENT) >= 32u) break; __builtin_amdgcn_s_sleep(2); }
                __builtin_amdgcn_fence(__ATOMIC_ACQUIRE, "agent");
                asm volatile("s_waitcnt vmcnt(0)" ::: "memory");
            }
            __syncthreads();
            const float r = __builtin_amdgcn_rsqf(__hip_atomic_load(prow, __ATOMIC_RELAXED, __HIP_MEMORY_SCOPE_AGENT) * (1.0f / 1024.0f) + EPS);
            const f32x2_m g = *(const f32x2_m*)(fin_gain + col);
            *(f32x2_m*)(fin_out + (size_t)grow * DM + col) = xn * r * g;
        }
    }
    __syncthreads();
}

template <int ODD>
__device__ __forceinline__ void proj16_tiles(LAS unsigned char* lds, unsigned char* ws, float* out, const float* bias, int base  , int only_q0) {
    int tid_ = threadIdx.x; asm volatile("" : "+v"(tid_));
    const int tid = tid_, lane = tid & 63, wave = __builtin_amdgcn_readfirstlane(tid >> 6), r16 = lane & 15, kq = lane >> 4, q = wave & 3, kh = wave >> 2;
    const int tile = (only_q0 && q != 0) ? -1 : base + 256 * q;
    const bf16_t* XB = (const bf16_t*)(ws + WS_XB);
    const bf16_t* W16 = (const bf16_t*)(ws + WS_WIN + (ODD ? SZ_WIN : 0)) + (size_t)(ODD ? 3072 : 1536) * DM;
    const float* part = (const float*)(ws + WS_PART + (size_t)(ODD ? 4 : 1) * SZ_PART);
    LAS float* red = (LAS float*)lds;
    LAS float* art = red + 1024;
    LAS unsigned char* wsm = lds + 8192;
    LAS unsigned char* tsm = lds + 8192 + 16 * 2064;
    float pss = 0.f; bf16x8_t xa[16];
    if (tile >= 0) {
        pss = part[16 * tile + r16];
        const bf16_t* xp = XB + (size_t)(16 * tile + r16) * DM + 512 * kh + 8 * kq;
#pragma unroll
        for (int s = 0; s < 16; ++s) xa[s] = *(const bf16x8_t*)(xp + 32 * s);
    }
    {
        u32x4 wv[4], tv[2];
#pragma unroll
        for (int i = 0; i < 4; ++i) wv[i] = *(const u32x4*)(W16 + (size_t)(tid + 512 * i) * 8);
        if (!ODD) {
            const bf16_t* T = (const bf16_t*)(ws + WS_WIN) + (size_t)1600 * DM;
#pragma unroll
            for (int i = 0; i < 2; ++i) tv[i] = *(const u32x4*)(T + (size_t)(tid + 512 * i) * 8);
        }
#pragma unroll
        for (int i = 0; i < 4; ++i) { const int idx = tid + 512 * i; *(LAS u32x4*)(wsm + (idx >> 7) * 2064 + (idx & 127) * 16) = wv[i]; }
        if (!ODD) {
#pragma unroll
            for (int i = 0; i < 2; ++i) { const int idx = tid + 512 * i; *(LAS u32x4*)(tsm + (idx >> 2) * 80 + (idx & 3) * 16) = tv[i]; }
        }
    }
    __syncthreads();
    f32x4 acc = {0.f, 0.f, 0.f, 0.f};
    if (tile >= 0) {
        const LAS unsigned char* wl = wsm + r16 * 2064 + (512 * kh + 8 * kq) * 2;
#pragma unroll
        for (int s = 0; s < 16; ++s) acc = __builtin_amdgcn_mfma_f32_16x16x32_bf16(*(const LAS bf16x8_t*)(wl + 64 * s), xa[s], acc, 0, 0, 0);
        if (kh == 1) *(LAS f32x4*)(red + (q * 64 + lane) * 4) = acc;
    }
    __syncthreads();
    if (kh == 0 && tile >= 0) {
        acc += *(const LAS f32x4*)(red + (q * 64 + lane) * 4);
        const int row = 16 * tile + r16;
        const float rinv = __builtin_amdgcn_rsqf(pss * (1.0f / 1024.0f) + EPS);
        if (ODD) {
            const f32x4 bo = *(const f32x4*)(bias + 4 * kq);
            f32x4 o;
#pragma unroll
            for (int i = 0; i < 4; ++i) o[i] = pg8::logsigmoid_f(acc[i] * rinv + bo[i]);
            *(f32x4*)((float*)(ws + WS_LOGF) + (size_t)row * 16 + 4 * kq) = o;
            float* dst = (row < MP) ? out + O_PFL + (size_t)row * 16 + 4 * kq : out + O_SFL + (size_t)(row - MP) * 16 + 4 * kq;
            *(f32x4*)dst = o;
        } else {
            *(LAS f32x4*)(art + (q * 16 + r16) * 16 + 4 * kq) = acc * rinv;
        }
    }
    if (!ODD) {
        __syncthreads();
        if (tile >= 0) {
            f32x4 bv[8];
#pragma unroll
            for (int jj = 0; jj < 8; ++jj) bv[jj] = *(const f32x4*)(bias + 16 * (8 * kh + jj) + 4 * kq);
            u32x4 rw = {0u, 0u, 0u, 0u};
            if (kq < 2) { const LAS float* ar = art + (q * 16 + r16) * 16 + 8 * kq; const f32x4 a0 = *(const LAS f32x4*)ar, a1 = *(const LAS f32x4*)(ar + 4);
                          rw.x = pk2(a0[0], a0[1]); rw.y = pk2(a0[2], a0[3]); rw.z = pk2(a1[0], a1[1]); rw.w = pk2(a1[2], a1[3]); }
            const bf16x8_t rb = __builtin_bit_cast(bf16x8_t, rw);
            float* LG = (float*)(ws + WS_LOGA) + (size_t)(16 * tile + r16) * 256 + 4 * kq;
#pragma unroll
            for (int jj = 0; jj < 8; ++jj) {
                const bf16x8_t wf = *(const LAS bf16x8_t*)(tsm + (16 * (8 * kh + jj) + r16) * 80 + 16 * kq);
                const f32x4 d = __builtin_amdgcn_mfma_f32_16x16x32_bf16(wf, rb, (f32x4){0.f, 0.f, 0.f, 0.f}, 0, 0, 0);
                f32x4 o;
#pragma unroll
                for (int i = 0; i < 4; ++i) o[i] = pg8::logsigmoid_f(d[i] + bv[jj][i]) * (1.0f / 16.0f);
                *(f32x4*)(LG + 16 * (8 * kh + jj)) = o;
            }
        }
    }
    __syncthreads();
}
template <int ODD>
__device__ __forceinline__ void sample_in_unit(LAS unsigned char* lds, unsigned char* ws, float* out, int u) {
    int tid_ = threadIdx.x; asm volatile("" : "+v"(tid_));
    const int tid = tid_, lane = tid & 63, wave = __builtin_amdgcn_readfirstlane(tid >> 6), r32 = lane & 31, hi = lane >> 5;
    const int rb = u / 24, cb = u - 24 * rb;
    const int col0 = 128 * cb + ((!ODD && cb >= 12) ? 256 : 0);
    const bf16_t* ap = (const bf16_t*)(ws + WS_XB) + (size_t)(MP + 32 * rb + r32) * DM + wave * 128 + 8 * hi;
    const bf16_t* bp = (const bf16_t*)(ws + WS_WIN + (ODD ? SZ_WIN : 0)) + (size_t)(col0 + r32) * DM + wave * 128 + 8 * hi;
    f32x16_t acc[4] = {};
#pragma unroll 2
    for (int ks = 0; ks < 8; ++ks) {
        const bf16x8_t a = *(const bf16x8_t*)(ap + 16 * ks);
        bf16x8_t b[4];
#pragma unroll
        for (int j = 0; j < 4; ++j) b[j] = *(const bf16x8_t*)(bp + (size_t)32 * j * DM + 16 * ks);
#pragma unroll
        for (int j = 0; j < 4; ++j) acc[j] = __builtin_amdgcn_mfma_f32_32x32x16_bf16(a, b[j], acc[j], 0, 0, 0);
    }
    LAS float* red = (LAS float*)lds;
#pragma unroll
    for (int j = 0; j < 4; ++j)
#pragma unroll
        for (int r = 0; r < 16; ++r) red[(wave * 32 + crow_(r, hi)) * 128 + 32 * j + r32] = acc[j][r];
    __syncthreads();
    {
        const int row = tid >> 4, c8 = (tid & 15) * 8;
        f32x4 s0 = *(const LAS f32x4*)(red + row * 128 + c8), s1 = *(const LAS f32x4*)(red + row * 128 + c8 + 4);
#pragma unroll
        for (int w = 1; w < 8; ++w) { s0 += *(const LAS f32x4*)(red + (w * 32 + row) * 128 + c8); s1 += *(const LAS f32x4*)(red + (w * 32 + row) * 128 + c8 + 4); }
        const int srow = 32 * rb + row;
        const float* part = (const float*)(ws + WS_PART + (size_t)(ODD ? 4 : 1) * SZ_PART);
        float sc = 1.0f; bool silu = false; float* fo = nullptr; int fpitch = 0, fcol = 0;
        if (ODD) {
            if (col0 < 1024) sc = QSCALE2;
            else if (col0 < 2048) { fo = out + O_SFK; fpitch = 1024; fcol = col0 - 1024; }
            else { fo = out + O_SFV; fpitch = 1024; fcol = col0 - 2048; }
        } else {
            if (col0 < 256) sc = 0.125f;
            else if (col0 >= 1024 && col0 < 1536) silu = true;
            else if (col0 >= 1792 && col0 < 2304) sc = QSCALE2;
            else if (col0 >= 2304 && col0 < 2816) { fo = out + O_SBK; fpitch = 512; fcol = col0 - 2304; }
            else if (col0 >= 2816) { fo = out + O_SBV; fpitch = 512; fcol = col0 - 2816; }
        }
        const float r = __builtin_amdgcn_rsqf(part[MP + srow] * (1.0f / 1024.0f) + EPS) * sc;
        float v[8];
#pragma unroll
        for (int i = 0; i < 4; ++i) { v[i] = s0[i] * r; v[4 + i] = s1[i] * r; }
        if (silu) {
#pragma unroll
            for (int e = 0; e < 8; ++e) v[e] = pg8::silu_f(v[e]);
        }
        u32x4 w; w.x = pk2(v[0], v[1]); w.y = pk2(v[2], v[3]); w.z = pk2(v[4], v[5]); w.w = pk2(v[6], v[7]);
        *(u32x4*)((bf16_t*)(ws + WS_EB) + (size_t)(MP + srow) * NIN + col0 + c8) = w;
        if (fo) { float* dst = fo + (size_t)srow * fpitch + fcol + c8; *(f32x4*)dst = (f32x4){v[0], v[1], v[2], v[3]}; *(f32x4*)(dst + 4) = (f32x4){v[4], v[5], v[6], v[7]}; }
    }
    __syncthreads();
}

__device__ __forceinline__ void fox_f2(LAS float* F2, LAS float* tot, const float* LOGF, int b, int h, int tid) {
    const int lane = tid & 63, w = tid >> 6;
    float carry = 0.f;
    float lfv[4];
#pragma unroll
    for (int c = 0; c < 4; ++c) lfv[c] = LOGF[((size_t)b * TSEQ + 256 * w + 64 * c + lane) * 16 + h];
#pragma unroll
    for (int c = 0; c < 4; ++c) {
        const int t = 256 * w + 64 * c + lane;
        const float F = carry + scan_incl(lfv[c], lane);
        F2[t] = F; carry = lane_bcast(F, 63);
    }
    if (lane == 0) tot[w] = carry;
    __syncthreads();
    float off = 0.f;
    for (int w2 = 0; w2 < w; ++w2) off += tot[w2];
#pragma unroll
    for (int c = 0; c < 4; ++c) { const int t = 256 * w + 64 * c + lane; F2[t] = (F2[t] + off) * LOG2E; }
    __syncthreads();
}

#define XB_TMO      128
#define XB_XCNT(j)  (256  + 64 * (j))
#define XB_XSUB(j)  (1280 + 64 * (j))
#define XB_XGEN(j)  (2304 + 64 * (j))
#define XB_TOP      3328
#define XB_TOPGEN   3392
#define XCD_BAR_WORDS 3456
#define XB_SPIN_CAP (1u << 18)

__device__ __forceinline__ unsigned xb_ld(unsigned* p)              { return __hip_atomic_load(p, __ATOMIC_RELAXED, __HIP_MEMORY_SCOPE_AGENT); }
__device__ __forceinline__ unsigned xb_add(unsigned* p, unsigned v) { return __hip_atomic_fetch_add(p, v, __ATOMIC_RELAXED, __HIP_MEMORY_SCOPE_AGENT); }
__device__ __forceinline__ unsigned xb_xcc_id() { return (unsigned)__builtin_amdgcn_s_getreg((3 << 11) | 20) & 0xFu; }
#define XB_SPIN(cond, bar) do { unsigned _sp = 0; while (cond) { __builtin_amdgcn_s_sleep(1); \
    if ((++_sp & 255u) == 0u) { if (xb_ld(&(bar)[XB_TMO])) break; if (_sp > XB_SPIN_CAP) { atomicAdd(&(bar)[XB_TMO], 1u); break; } } } } while (0)

struct XcdBarrier {
    unsigned* bar; unsigned x;
    volatile LAS unsigned* st;
};

__device__ __forceinline__ XcdBarrier xcd_barrier_post(unsigned* bar, volatile LAS unsigned* st) {
    XcdBarrier b; b.bar = bar; b.x = xb_xcc_id(); b.st = st;
    if (threadIdx.x == 0) (void)xb_add(&bar[XB_XCNT(b.x)], 1u);
    return b;
}
__device__ __forceinline__ void xcd_barrier_complete(unsigned* bar, unsigned x, unsigned& nloc, unsigned& nx) {
    const unsigned G = gridDim.x * gridDim.y * gridDim.z;
    unsigned sum, cnt, mine, sp = 0u;
    for (;;) {
        sum = 0u; cnt = 0u; mine = 0u;
#pragma unroll
        for (unsigned j = 0; j < 16; ++j) { const unsigned c = xb_ld(&bar[XB_XCNT(j)]); sum += c; cnt += (c > 0u) ? 1u : 0u; mine = (j == x) ? c : mine; }
        if (sum == G) break;
        __builtin_amdgcn_s_sleep(1);
        if ((++sp & 255u) == 0u) { if (xb_ld(&bar[XB_TMO])) break; if (sp > XB_SPIN_CAP) { atomicAdd(&bar[XB_TMO], 1u); break; } }
    }
    nloc = mine > 0u ? mine : 1u; nx = cnt > 0u ? cnt : 1u;
}

__device__ __forceinline__ void xcd_barrier(const XcdBarrier& b) {
    asm volatile("s_waitcnt vmcnt(0)" ::: "memory");
    __syncthreads();
    if (threadIdx.x == 0) {
        unsigned* bar = b.bar;
        __builtin_amdgcn_s_waitcnt(0);
        unsigned nloc = b.st[0], nx = b.st[1];
        if (nloc == 0u) { xcd_barrier_complete(bar, b.x, nloc, nx); b.st[0] = nloc; b.st[1] = nx; }
        const unsigned old = xb_add(&bar[XB_XSUB(b.x)], 1u);
        const unsigned gen = old / nloc;
        if (old + 1u == (gen + 1u) * nloc) {
            __builtin_amdgcn_fence(__ATOMIC_RELEASE, "agent");
            asm volatile("s_waitcnt vmcnt(0)" ::: "memory");
            const unsigned og = xb_add(&bar[XB_TOP], 1u);
            const unsigned tg = og / nx;
            if (og + 1u == (tg + 1u) * nx) xb_add(&bar[XB_TOPGEN], 1u);
            else XB_SPIN(xb_ld(&bar[XB_TOPGEN]) == tg, bar);
            __builtin_amdgcn_fence(__ATOMIC_ACQUIRE, "agent");
            xb_add(&bar[XB_XGEN(b.x)], 1u);
            asm volatile("s_waitcnt vmcnt(0)" ::: "memory");
        } else {
            asm volatile("buffer_inv sc1" ::: "memory");
            XB_SPIN(xb_ld(&bar[XB_XGEN(b.x)]) == gen, bar);
            asm volatile("s_waitcnt vmcnt(0)" ::: "memory");
        }
    }
    __syncthreads();
}

constexpr int LDS_MISC = 131072 + 512;
__device__ __forceinline__ void grid_bar(unsigned char* ws, LAS unsigned char* lds) {
    XcdBarrier b; b.bar = (unsigned*)ws; b.x = xb_xcc_id(); b.st = (volatile LAS unsigned*)(lds + LDS_MISC);
    xcd_barrier(b);
}

#ifndef EN_MASK
#define EN_MASK 255
#endif

__global__ void __launch_bounds__(NWAVES * 64, 2) mega_fwd(Args args) {
    extern __shared__ __attribute__((aligned(16))) unsigned char lds_raw[];
    LAS unsigned char* lds = (LAS unsigned char*)lds_raw;
    cg::grid_group grid = cg::this_grid();
    const int ph_hi = ((const Args*)__builtin_amdgcn_kernarg_segment_ptr())->ph_hi;
    if (threadIdx.x < 32) ((LAS unsigned*)(lds + 131072))[threadIdx.x + 128] = 0u;
    __syncthreads();
    (void)xcd_barrier_post((unsigned*)((const Args*)__builtin_amdgcn_kernarg_segment_ptr())->ws, (volatile LAS unsigned*)(lds + LDS_MISC));
    for (int ph = ((const Args*)__builtin_amdgcn_kernarg_segment_ptr())->ph_lo; ph < ph_hi; ++ph) {
        unsigned zero; asm volatile("s_mov_b32 %0, 0" : "=s"(zero));
        const Args& A = *(const Args*)((const char*)__builtin_amdgcn_kernarg_segment_ptr() + zero);
        int tid = threadIdx.x; asm volatile("" : "+v"(tid));
        const int lane = tid & 63, wave = __builtin_amdgcn_readfirstlane(tid >> 6);
        int G = gridDim.x, bx = blockIdx.x; asm volatile("" : "+s"(G), "+s"(bx));
        const int gw = bx * NWAVES + wave, NGW = G * NWAVES;
        unsigned char* ws = A.ws; float* out = A.out;
        int kind, idx = 0;
        switch (ph) {
            case 0: kind = 0; break;
            case 1: kind = 1; idx = 0; break;  case 6: kind = 1; idx = 1; break;  case 8: kind = 1; idx = 2; break;  case 13: kind = 1; idx = 3; break;
            case 2: kind = 2; idx = 0; break;  case 7: kind = 2; idx = 1; break;  case 9: kind = 2; idx = 2; break;  case 14: kind = 2; idx = 3; break;
            case 3: kind = 3; break;  case 4: kind = 4; break;  case 5: kind = 5; idx = 0; break;
            case 10: kind = 6; break; case 11: kind = 7; break; case 12: kind = 5; idx = 1; break;
            default: kind = 8; break;
        }
        if (kind == 0 && (EN_MASK & 1)) {
            p0_prologue(A, lds, gw, NGW, wave, lane);
        } else if (kind == 1 && (EN_MASK & 2)) {
            const int pin = (idx == 0) ? 0 : (idx == 1) ? 2 : (idx == 2) ? 3 : 5;
            pg8::Gemm g{(const bf16_t*)(ws + WS_XB), (const bf16_t*)(ws + WS_WGU + idx * SZ_WGU), MT, 2 * FF, DM}; pg8::StaticOrder S; S.init(MT, 2 * FF, G, bx);
            pg8::EpiGU E{ws, pin, lds};
            pg8::gemm_phase<pg8::EpiGU, pg8::StaticOrder, true, true>(lds, g, S, E);
            { constexpr int NU = (MT / 256) * (2 * FF / 256); const int first_idle = NU % G;
              const int job = (idx == 0) ? 1 : (idx == 1) ? 3 : (idx == 2) ? 4 : 5;
              if (job >= 0 && bx >= first_idle) { int t5 = threadIdx.x; asm volatile("" : "+v"(t5)); convert_job(A, lds, job, (bx - first_idle) * NWAVES + __builtin_amdgcn_readfirstlane(t5 >> 6), (G - first_idle) * NWAVES, __builtin_amdgcn_readfirstlane(t5 >> 6), t5 & 63); } }
        } else if ((kind == 2 || kind == 5) && (EN_MASK & 4)) {
            const bool dn = kind == 2;
            const int pout = dn ? ((idx == 0) ? 1 : (idx == 1) ? 3 : (idx == 2) ? 4 : 6) : ((idx == 0) ? 2 : 5);
            const bool first = dn && idx == 0;
            const bf16_t* Ap = (const bf16_t*)(dn ? ws + WS_H : ws + WS_OAB); const bf16_t* Btp = (const bf16_t*)(dn ? ws + WS_WDN + idx * SZ_WDN : ws + WS_WOUT + idx * SZ_WOUT);
            const int Kd = dn ? FF : DM;
            { const int vcu = (G % 8 == 0) ? (bx % 8) * (G / 8) + bx / 8 : bx;
              const bool fin = dn && idx == 3 && G == 256;
              for (int u = vcu; u < 256; u += G) mini_gemm_unit(lds, Ap + (size_t)MP * Kd, Btp, Kd, u >> 5, u & 31, nullptr, ws, pout, dn ? 0.5f : 1.0f, fin ? A.in[20] : nullptr, out + O_YS); }
            pg8::Gemm g{Ap, Btp, MP, DM, Kd}; pg8::StaticOrder S; S.init(MP, DM, G, bx);
            if (dn && idx == 3 && G == 256) {
                pg8::EpiFinal E{ws, out + O_YP, A.in[20], 0.5f};
                pg8::gemm_phase<pg8::EpiFinal, pg8::StaticOrder, true, true>(lds, g, S, E);
            } else {
                pg8::EpiRes E{ws, pout, dn ? 0.5f : 1.0f};
                pg8::gemm_phase<pg8::EpiRes, pg8::StaticOrder, true, true>(lds, g, S, E);
            }
        } else if ((kind == 3 || kind == 6) && (EN_MASK & 8)) {
            const bool odd = kind == 6;
            for (int base = bx; base < 256; base += G) { if (odd) proj16_tiles<1>(lds, ws, out, A.in[18], base, 0); else proj16_tiles<0>(lds, ws, out, A.in[13], base, 0); }
            for (int u = bx; u < 208; u += G) {
                if (u < 192) { if (odd) sample_in_unit<1>(lds, ws, out, u); else sample_in_unit<0>(lds, ws, out, u); }
                else { if (odd) proj16_tiles<1>(lds, ws, out, A.in[18], 1024 + (u - 192), 1); else proj16_tiles<0>(lds, ws, out, A.in[13], 1024 + (u - 192), 1); }
            }
            pg8::Gemm g{(const bf16_t*)(ws + WS_XB), (const bf16_t*)(ws + WS_WIN + (odd ? SZ_WIN : 0)), MP, 3072, DM}; pg8::StaticOrder S; S.init(MP, 3072, G, bx, odd ? 1 : 2);
            if (odd) { pg8::EpiInOdd E{ws, out, lds}; pg8::gemm_phase<pg8::EpiInOdd, pg8::StaticOrder, true, true>(lds, g, S, E); }
            else     { pg8::EpiInEven E{ws, out, lds}; pg8::gemm_phase<pg8::EpiInEven, pg8::StaticOrder, true, true>(lds, g, S, E); }
        } else if (kind == 4 && (EN_MASK & 32)) {
            const bf16_t* EB = (const bf16_t*)(ws + WS_EB); bf16_t* OAB = (bf16_t*)(ws + WS_OAB); const float* LOGA = (const float*)(ws + WS_LOGA);
            float* GU = (float*)(ws + WS_GU); float* GA = (float*)(ws + WS_GA);
            const int vcu = (G % 8 == 0) ? (bx % 8) * (G / 8) + bx / 8 : bx;
            unsigned* gflag = (unsigned*)(ws + 49152);
            for (int id = vcu; id < 256; id += G) {
                gla_m1_group(lds, EB, LOGA, id >> 3, id & 7, (bf16_t*)(ws + WS_QIN), (bf16_t*)(ws + WS_KIN), GU, GA, (float*)(ws + WS_GT), (float*)(ws + WS_GAG));
                asm volatile("s_waitcnt vmcnt(0)" ::: "memory");
                __syncthreads();
                { int t7 = threadIdx.x; asm volatile("" : "+v"(t7));
                  if (t7 == 0) __hip_atomic_store(gflag + id, 1u, __ATOMIC_RELAXED, __HIP_MEMORY_SCOPE_AGENT); }
            }
            if (G == 256 && (vcu & 3) < 2) { const int w = vcu >> 2, b = w >> 2, h = w & 3;
                if ((vcu & 3) == 0) gla_u_unit<16>(lds, EB, LOGA, (size_t)MP + b * SSEQ, h, nullptr, nullptr, A.in[2] + (size_t)w * 8192, out + O_SSG + (size_t)w * 8192);
                else gla_o_unit<16>(lds, EB, LOGA, (size_t)MP + b * SSEQ, h, 0, nullptr, nullptr, A.in[2] + (size_t)w * 8192, A.in[14], OAB, nullptr);
            } else if (G != 256) {
                for (int w = vcu; w < 64; w += G) { const int b = w >> 2, h = w & 3;
                    gla_u_unit<16>(lds, EB, LOGA, (size_t)MP + b * SSEQ, h, nullptr, nullptr, A.in[2] + (size_t)w * 8192, out + O_SSG + (size_t)w * 8192);
                    gla_o_unit<16>(lds, EB, LOGA, (size_t)MP + b * SSEQ, h, 0, nullptr, nullptr, A.in[2] + (size_t)w * 8192, A.in[14], OAB, nullptr); }
            }
            {
                LAS float* tab = (LAS float*)(lds + 86016);
                const attn_body::bf16* Qp = (const attn_body::bf16*)EB;
                for (int pr = vcu; pr < 4 * NBATCH * 8; pr += G) {
                    const int bh = pr >> 2, pidx = pr & 3, b = bh >> 3, h = bh & 7;
                    { int tid4 = threadIdx.x; asm volatile("" : "+v"(tid4));
                      for (int x = tid4; x < 320; x += NWAVES * 64) tab[x] = A.in[15][h * 257 + (x < 256 ? x : 256)] * LOG2E;
                      __syncthreads(); }
                    for (int i = 0; i < 2; ++i) {
                        const int qb = (pidx == 0) ? (i == 0 ? 2 : 0) : (pidx == 1) ? (i == 0 ? 3 : 1) : (pidx == 2) ? 4 + i : 6 + i;
                        attn_body::attn_unit<8, 1>(b, h, qb, Qp + 1792, Qp + 2304, Qp + 2816, (attn_body::bf16*)OAB + 512, (char*)lds_raw, tab);
                    }
                }
            }
            for (int u = vcu; u < SBATCH * 8; u += G) { const int b = u >> 3, h = u & 7;
                sample_attn_unit<1>(lds, EB, 1792, 2304, 2816, A.in[3] + ((size_t)b * 512 * 8 + h) * 64, A.in[4] + ((size_t)b * 512 * 8 + h) * 64, 512, 512, b, h, nullptr, nullptr, A.in[15], OAB, 512); }
            for (int id = vcu; id < 256; id += G) { const int bh = id >> 3, g4 = id & 7;
                { int t8 = threadIdx.x; asm volatile("" : "+v"(t8));
                  if (t8 == 0) {
                      for (int g = 0; g < g4; ++g)
                          for (unsigned spins = 0; spins < (1u << 22); ++spins) { if (__hip_atomic_load(gflag + bh * 8 + g, __ATOMIC_RELAXED, __HIP_MEMORY_SCOPE_AGENT) != 0u) break; __builtin_amdgcn_s_sleep(2); }
                      __builtin_amdgcn_fence(__ATOMIC_ACQUIRE, "agent"); asm volatile("s_waitcnt vmcnt(0)" ::: "memory");
                  } }
                __syncthreads();
                gla_m2_group(lds, EB, bh, g4, (const bf16_t*)(ws + WS_QIN), (const bf16_t*)(ws + WS_KIN), GU, GA, (const float*)(ws + WS_GT), (const float*)(ws + WS_GAG), A.in[14], OAB, (g4 == 7) ? out + O_PSG + (size_t)bh * 8192 : nullptr); }
        } else if (kind == 7 && (EN_MASK & 64)) {
            const bf16_t* EB = (const bf16_t*)(ws + WS_EB); bf16_t* OAB = (bf16_t*)(ws + WS_OAB); const float* LOGF = (const float*)(ws + WS_LOGF);
            const int vcu = (G % 8 == 0) ? (bx % 8) * (G / 8) + bx / 8 : bx;
            LAS float* F2 = (LAS float*)(lds + 86016); LAS float* tot = (LAS float*)(lds + 86016 + 8192);
            const attn_body::bf16* Qp = (const attn_body::bf16*)EB;
            for (int pr = vcu; pr < 2 * NBATCH * 16; pr += G) {
                const int p = pr >> 1, e = pr & 1;
                if (e == 0) {
                    for (int u = 2 * p; u < 2 * p + 2; ++u) { const int b = u >> 4, h = u & 15;
                        sample_attn_unit<0>(lds, EB, 0, 1024, 2048, A.in[5] + ((size_t)b * PAST * 16 + h) * 64, A.in[6] + ((size_t)b * PAST * 16 + h) * 64, 1024, PAST, b, h, A.in[7] + (size_t)b * PAST * 16, LOGF, nullptr, OAB, 0); }
                }
                const int b = p >> 4, h = p & 15;
                { int tid3 = threadIdx.x; asm volatile("" : "+v"(tid3)); fox_f2(F2, tot, LOGF, b, h, tid3); }
                unsigned* cnt = (unsigned*)(ws + 16384) + 16 * p; LAS unsigned* slot = (LAS unsigned*)(lds + 86016 + 8192 + 64);
                for (;;) {
                    { int t6 = threadIdx.x; asm volatile("" : "+v"(t6)); if (t6 == 0) *slot = atomicAdd(cnt, 1u); }
                    __syncthreads();
                    const unsigned idxq = (unsigned)__builtin_amdgcn_readfirstlane((int)*slot);
                    __syncthreads();
                    if (idxq >= 8u) break;
                    attn_body::attn_unit<8, 0>(b, h, 7 - (int)idxq, Qp, Qp + 1024, Qp + 2048, (attn_body::bf16*)OAB, (char*)lds_raw, F2);
                }
            }
        } else if (kind == 8 && (EN_MASK & 128)) {
            if (G != 256) final_norm(A, gw, NGW, lane);
        }
        if (ph + 1 < ph_hi) { if (ph_hi > 4096) grid.sync(); else grid_bar(ws, lds); }
    }
}

#ifndef N_LAUNCHES
#define N_LAUNCHES 1
#endif
constexpr int NPHASES = 16;
extern "C" void kernel_launch(void* const* d_in, const int* in_sizes, int n_in, void* d_out, int out_size, void* d_ws, size_t ws_size, hipStream_t stream) {
    static int grid = 0;
    if (grid == 0) {
        if (n_in != 21 || (size_t)out_size != O_END || ws_size < WS_END) { fprintf(stderr, "kernel_launch: unexpected problem: n_in %d out %d (want %zu) ws %zu (want >= %zu)\n", n_in, out_size, (size_t)O_END, ws_size, (size_t)WS_END); grid = -1; return; }
        int dev = 0, cus = 0, per_cu = 0;
        if (hipGetDevice(&dev) != hipSuccess || hipDeviceGetAttribute(&cus, hipDeviceAttributeMultiprocessorCount, dev) != hipSuccess) { grid = -1; return; }
        if (hipFuncSetAttribute((const void*)mega_fwd, hipFuncAttributeMaxDynamicSharedMemorySize, LDS_BYTES) != hipSuccess) { fprintf(stderr, "kernel_launch: hipFuncSetAttribute failed\n"); grid = -1; return; }
        if (hipOccupancyMaxActiveBlocksPerMultiprocessor(&per_cu, (const void*)mega_fwd, NWAVES * 64, LDS_BYTES) != hipSuccess || per_cu < 1) { fprintf(stderr, "kernel_launch: occupancy query says %d\n", per_cu); per_cu = 1; }
        (void)hipGetLastError();
        if (per_cu > 1) per_cu = 1;
        grid = cus * per_cu;
        fprintf(stderr, "kernel_launch: grid %d\n", grid);
    }
    if (grid < 0) return;
    if (hipMemsetAsync(d_ws, 0, 65536, stream) != hipSuccess) { fprintf(stderr, "kernel_launch: hipMemsetAsync failed\n"); return; }
    Args a{};
    for (int i = 0; i < 21; ++i) a.in[i] = (const float*)d_in[i];
    a.out = (float*)d_out; a.ws = (unsigned char*)d_ws;
    if (N_LAUNCHES == 1) {
        a.ph_lo = 0; a.ph_hi = (grid == 256) ? NPHASES - 1 : NPHASES;
        void* kargs[] = {&a};
        hipError_t e = hipLaunchCooperativeKernel((const void*)mega_fwd, dim3(grid), dim3(NWAVES * 64), kargs, LDS_BYTES, stream);
        if (e != hipSuccess) fprintf(stderr, "kernel_launch: cooperative launch failed: %s (grid %d)\n", hipGetErrorString(e), grid);
    } else {
        for (int p = 0; p < NPHASES; ++p) { a.ph_lo = p; a.ph_hi = p + 1; hipLaunchKernelGGL(mega_fwd, dim3(grid), dim3(NWAVES * 64), LDS_BYTES, stream, a); }
    }
}
```

```cpp
#include <hip/hip_runtime.h>
#include <hip/hip_cooperative_groups.h>
#include <cstdio>
#include <cstdint>
namespace cg = cooperative_groups;

constexpr int DM = 1024, TSEQ = 2048, NBATCH = 8, SBATCH = 16, SSEQ = 16, PAST = 4096, FF = 2816;
constexpr int MP = NBATCH * TSEQ;
constexpr int MS = SBATCH * SSEQ;
constexpr int MT = MP + MS;
constexpr int NIN = 3328;
constexpr float LOG2E = 1.4426950408889634f;
constexpr float QSCALE2 = 0.125f * LOG2E;
constexpr float EPS = 1e-6f;

constexpr size_t O_YP = 0, O_YS = O_YP + (size_t)MP * DM, O_PSG = O_YS + (size_t)MS * DM, O_PBK = O_PSG + 8 * 4 * 64 * 128, O_PBV = O_PBK + 8 * 512 * 512,
                 O_PFK = O_PBV + 8 * 512 * 512, O_PFV = O_PFK + (size_t)MP * 1024, O_PFL = O_PFV + (size_t)MP * 1024, O_SSG = O_PFL + (size_t)MP * 16,
                 O_SBK = O_SSG + 16 * 4 * 64 * 128, O_SBV = O_SBK + (size_t)MS * 512, O_SFK = O_SBV + (size_t)MS * 512, O_SFV = O_SFK + (size_t)MS * 1024,
                 O_SFL = O_SFV + (size_t)MS * 1024, O_END = O_SFL + (size_t)MS * 16;
constexpr size_t MiB = 1u << 20;
constexpr size_t WS_WGU = 2 * MiB, SZ_WGU = (size_t)2 * FF * DM * 2;
constexpr size_t WS_WDN = 46 * MiB, SZ_WDN = (size_t)DM * FF * 2;
constexpr size_t WS_WIN = 68 * MiB, SZ_WIN = (size_t)NIN * DM * 2;
constexpr size_t WS_WOUT = 81 * MiB, SZ_WOUT = (size_t)DM * DM * 2;
constexpr size_t WS_X = 96 * MiB;
constexpr size_t WS_XB = 161 * MiB;
constexpr size_t WS_H = 194 * MiB;
constexpr size_t WS_EB = 284 * MiB;
constexpr size_t WS_OAB = 390 * MiB;
constexpr size_t WS_LOGA = 423 * MiB;
constexpr size_t WS_LOGF = 440 * MiB;
constexpr size_t WS_PART = 442 * MiB, SZ_PART = (size_t)MT * 4;
constexpr size_t WS_GU = 450 * MiB;
constexpr size_t WS_GA = 482 * MiB;
constexpr size_t WS_QIN = 484 * MiB, WS_KIN = 492 * MiB;
constexpr size_t WS_GT = 500 * MiB;
constexpr size_t WS_GAG = 508 * MiB;
constexpr size_t WS_END = 510 * MiB;
static_assert(WS_WGU + 4 * SZ_WGU <= WS_WDN && WS_WDN + 4 * SZ_WDN <= WS_WIN && WS_WIN + 2 * SZ_WIN <= WS_WOUT && WS_WOUT + 2 * SZ_WOUT <= WS_X, "ws map 1");
static_assert(WS_X + (size_t)MT * DM * 4 <= WS_XB && WS_XB + (size_t)MT * DM * 2 <= WS_H && WS_H + (size_t)MT * FF * 2 <= WS_EB && WS_EB + (size_t)MT * NIN * 2 <= WS_OAB, "ws map 2");
static_assert(WS_OAB + (size_t)MT * DM * 2 <= WS_LOGA && WS_LOGA + (size_t)MT * 256 * 4 <= WS_LOGF && WS_LOGF + (size_t)MT * 16 * 4 <= WS_PART && WS_PART + 7 * SZ_PART <= WS_END, "ws map 3");

namespace pg8 {
#define PG8_LAS __attribute__((address_space(3)))
typedef unsigned short bf16_t;
typedef short bf16x8 __attribute__((ext_vector_type(8)));
typedef float f32x4 __attribute__((ext_vector_type(4)));
typedef unsigned u32x4 __attribute__((ext_vector_type(4)));
constexpr int BM = 256, BK = 64, HALF = 128, HTB = HALF * BK * 2  , STAGE_BYTES = 8 * HTB, NXCD = 8, WGM = 4;

__host__ __device__ __forceinline__ int lds_byte(int r, int c) { const int st = (r >> 4) * 2 + (c >> 5), rr = r & 15, cc = c & 31, ob = rr * 64 + cc * 2; return st * 1024 + (ob ^ (((ob >> 9) & 1) << 5)); }
__host__ __device__ __forceinline__ void stage_rc(int b, int& R, int& C) { const int st = b / 1024, sb = b % 1024, swz = sb ^ (((sb >> 9) & 1) << 5); R = (st >> 1) * 16 + swz / 64; C = (st & 1) * 32 + (swz % 64) / 2; }
__host__ __device__ __forceinline__ int perm32(int rho) { const int n = rho >> 4, i = rho & 15; return 8 * (i >> 2) + 4 * n + (i & 3); }

struct Unit { int pm, pn; };
struct Gemm { const bf16_t* A; const bf16_t* Bt; int M, N, K; };

struct StaticOrder {
    int nM, nN, nwg, G, c, mix;
    __host__ __device__ void init(int M, int N, int G_, int c_, int mix_ = 0) { nM = M / BM; nN = N / BM; nwg = nM * nN; G = G_; c = c_; mix = mix_; }
    __host__ __device__ bool next(int i, Unit& u) const {
        const long L = (long)i * G + c; if (L >= nwg) return false;
        int wgid = (int)L; { const int q = nwg / NXCD, r = nwg % NXCD, xcd = wgid % NXCD, off = wgid / NXCD; wgid = (xcd < r ? xcd * (q + 1) : r * (q + 1) + (xcd - r) * q) + off; }
        const int nig = WGM * nN, gid = wgid / nig, fm = gid * WGM, gsz = (nM - fm) < WGM ? (nM - fm) : WGM;
        u.pm = fm + ((wgid % nig) % gsz); u.pn = (wgid % nig) / gsz;
        if (mix == 1 && u.pn < 12) u.pn = (u.pn % 3) * 4 + u.pn / 3;
        if (mix == 2 && u.pn >= 6) ++u.pn;
        return true;
    }
    __device__ __forceinline__ void a_ready(const Unit&) const {}
    __device__ __forceinline__ void done(const Unit&) const {}
};

__device__ __forceinline__ unsigned cvt_pk_bf16(float lo, float hi) { unsigned r; asm volatile("v_cvt_pk_bf16_f32 %0, %1, %2" : "=v"(r) : "v"(lo), "v"(hi)); return r; }
typedef float f32x2 __attribute__((ext_vector_type(2)));
typedef float f32x2 __attribute__((ext_vector_type(2)));
typedef unsigned u32x2 __attribute__((ext_vector_type(2)));
__device__ __forceinline__ float row_rinv(const float* part, int row) { return __builtin_amdgcn_rsqf(part[row] * (1.0f / 1024.0f) + EPS); }
constexpr int PRE_LDS = 131072 + 2048;
struct PreRows { const PG8_LAS float* b; };
__device__ __forceinline__ void pre_rows_load(PreRows& p, const float* part, const Unit& u, int wr, int lane, PG8_LAS unsigned char* lds) {
    PG8_LAS unsigned char* dst = lds + PRE_LDS + wr * 512;
    __builtin_amdgcn_global_load_lds((const unsigned*)(part + u.pm * BM + wr * 64 + lane), (PG8_LAS unsigned*)dst, 4, 0, 0);
    __builtin_amdgcn_global_load_lds((const unsigned*)(part + u.pm * BM + HALF + wr * 64 + lane), (PG8_LAS unsigned*)(dst + 256), 4, 0, 0);
    p.b = (const PG8_LAS float*)dst;
}
__device__ __forceinline__ float pre_rinv(const PreRows& p, int ai, int m, int fr) {
    return __builtin_amdgcn_rsqf(p.b[ai * 64 + m * 16 + fr] * (1.0f / 1024.0f) + EPS);
}
struct PreNone {};
__device__ __forceinline__ float silu_f(float x) { return x * __builtin_amdgcn_rcpf(1.0f + __builtin_amdgcn_exp2f(-x * LOG2E)); }
__device__ __forceinline__ float logsigmoid_f(float x) { return fminf(x, 0.f) - __logf(1.0f + __expf(-fabsf(x))); }

__device__ __forceinline__ void st_wt16(void* p, const u32x4 v) { asm volatile("global_store_dwordx4 %0, %1, off sc0 sc1\n\ts_nop 1" :: "v"(p), "v"(v) : "memory"); }
__device__ __forceinline__ void st_wt16(void* p, const f32x4 v) { asm volatile("global_store_dwordx4 %0, %1, off sc0 sc1\n\ts_nop 1" :: "v"(p), "v"(v) : "memory"); }
__device__ __forceinline__ void st_wt8(void* p, const u32x2 v)  { asm volatile("global_store_dwordx2 %0, %1, off sc0 sc1" :: "v"(p), "v"(v) : "memory"); }
struct EpiGU {
    static constexpr bool PERM = true, AFTER_DRAIN = false;
    unsigned char* ws; int pin; PG8_LAS unsigned char* lds;
    typedef PreRows Pre;
    __device__ __forceinline__ void pre_load(Pre& p, const Unit& u, int wr, int lane) const { pre_rows_load(p, (const float*)(ws + WS_PART + (size_t)pin * SZ_PART), u, wr, lane, lds); }
    __device__ __forceinline__ void operator()(const f32x4 (&acc)[2][2][4][2], const Unit& u, int wr, int wc, int fr, int fq, const Pre& pre) const {
        bf16_t* H = (bf16_t*)(ws + WS_H); const float* part = (const float*)(ws + WS_PART + (size_t)pin * SZ_PART);
        const int col0 = u.pn * 128 + wc * 32 + 8 * fq;
        float rr[2][4];
#pragma unroll
        for (int ai = 0; ai < 2; ++ai)
#pragma unroll
            for (int m = 0; m < 4; ++m) rr[ai][m] = pre_rinv(pre, ai, m, fr);
#pragma unroll
        for (int ai = 0; ai < 2; ++ai)
#pragma unroll
            for (int m = 0; m < 4; ++m) {
                const int row = u.pm * BM + ai * HALF + wr * 64 + m * 16 + fr;
                const float r = rr[ai][m];
                u32x4 w;
#pragma unroll
                for (int n = 0; n < 2; ++n) {
                    const f32x4 g4 = acc[ai][0][m][n], u4 = acc[ai][1][m][n];
                    const float rl = -r * LOG2E;
                    f32x4 t4 = g4 * rl;
#pragma unroll
                    for (int i = 0; i < 4; ++i) t4[i] = __builtin_amdgcn_exp2f(t4[i]);
                    t4 = t4 + 1.0f;
#pragma unroll
                    for (int i = 0; i < 4; ++i) t4[i] = __builtin_amdgcn_rcpf(t4[i]);
                    const f32x4 h4 = (g4 * u4) * (t4 * (r * r));
                    if (n == 0) { w.x = cvt_pk_bf16(h4[0], h4[1]); w.y = cvt_pk_bf16(h4[2], h4[3]); } else { w.z = cvt_pk_bf16(h4[0], h4[1]); w.w = cvt_pk_bf16(h4[2], h4[3]); }
                }
                st_wt16(H + (size_t)row * FF + col0, w);
            }
    }
};
__device__ __forceinline__ f32x4 bf4_to_f32(const u32x2 w) {
    return (f32x4){__builtin_bit_cast(float, w.x << 16), __builtin_bit_cast(float, w.x & 0xffff0000u), __builtin_bit_cast(float, w.y << 16), __builtin_bit_cast(float, w.y & 0xffff0000u)};
}
struct EpiRes {
    static constexpr bool PERM = true, AFTER_DRAIN = false;
    unsigned char* ws; int pout; float coef;
    typedef PreNone Pre;
    __device__ __forceinline__ void pre_load(Pre&, const Unit&, int, int) const {}
    __device__ __forceinline__ void operator()(const f32x4 (&acc)[2][2][4][2], const Unit& u, int wr, int wc, int fr, int fq, const Pre&) const {
        bf16_t* XB = (bf16_t*)(ws + WS_XB); float* part_out = (float*)(ws + WS_PART + (size_t)pout * SZ_PART);
        const int ln = fq * 16 + fr;
#pragma unroll
        for (int ai = 0; ai < 2; ++ai) {
            u32x4 xo[4][2];
#pragma unroll
            for (int m = 0; m < 4; ++m)
#pragma unroll
                for (int bj = 0; bj < 2; ++bj)
                    xo[m][bj] = *(const u32x4*)(XB + (size_t)(u.pm * BM + ai * HALF + wr * 64 + m * 16 + fr) * DM + u.pn * BM + bj * HALF + wc * 32 + 8 * fq);
#pragma unroll
            for (int m = 0; m < 4; ++m) {
                const int row = u.pm * BM + ai * HALF + wr * 64 + m * 16 + fr;
                float ss = 0.f;
#pragma unroll
                for (int bj = 0; bj < 2; ++bj) {
                    const int c = u.pn * BM + bj * HALF + wc * 32 + 8 * fq;
                    const f32x4 x0 = bf4_to_f32((u32x2){xo[m][bj].x, xo[m][bj].y}) + acc[ai][bj][m][0] * coef;
                    const f32x4 x1 = bf4_to_f32((u32x2){xo[m][bj].z, xo[m][bj].w}) + acc[ai][bj][m][1] * coef;
                    u32x4 w; w.x = cvt_pk_bf16(x0[0], x0[1]); w.y = cvt_pk_bf16(x0[2], x0[3]); w.z = cvt_pk_bf16(x1[0], x1[1]); w.w = cvt_pk_bf16(x1[2], x1[3]);
                    st_wt16(XB + (size_t)row * DM + c, w);
                    ss += ((x0[0] * x0[0] + x0[1] * x0[1]) + (x0[2] * x0[2] + x0[3] * x0[3])) + ((x1[0] * x1[0] + x1[1] * x1[1]) + (x1[2] * x1[2] + x1[3] * x1[3]));
                }
                ss += __builtin_bit_cast(float, __builtin_amdgcn_ds_bpermute((ln ^ 16) << 2, __builtin_bit_cast(int, ss)));
                ss += __builtin_bit_cast(float, __builtin_amdgcn_ds_bpermute((ln ^ 32) << 2, __builtin_bit_cast(int, ss)));
                if (fq == 0) atomicAdd(part_out + row, ss);
            }
        }
    }
};
struct EpiFinal {
    static constexpr bool PERM = false, AFTER_DRAIN = true;
    unsigned char* ws; float* out; const float* gain; float coef;
    typedef PreNone Pre;
    __device__ __forceinline__ void pre_load(Pre&, const Unit&, int, int) const {}
    __device__ __forceinline__ void fused(f32x4 (&acc)[2][2][4][2], const Unit& u, int wr, int wc, int fr, int fq, PG8_LAS unsigned char*, int, int) const {
        const bf16_t* XB = (const bf16_t*)(ws + WS_XB); float* part = (float*)(ws + WS_PART + 6 * SZ_PART);
        unsigned* cnt = (unsigned*)(ws + 32768) + 16 * u.pm;
        const int ln = fq * 16 + fr;
#pragma unroll
        for (int ai = 0; ai < 2; ++ai) {
            u32x2 xo[4][2][2];
#pragma unroll
            for (int m = 0; m < 4; ++m)
#pragma unroll
                for (int bj = 0; bj < 2; ++bj)
#pragma unroll
                    for (int n = 0; n < 2; ++n)
                        xo[m][bj][n] = *(const u32x2*)(XB + (size_t)(u.pm * BM + ai * HALF + wr * 64 + m * 16 + fr) * DM + u.pn * BM + bj * HALF + wc * 32 + n * 16 + 4 * fq);
#pragma unroll
            for (int m = 0; m < 4; ++m) {
                const int row = u.pm * BM + ai * HALF + wr * 64 + m * 16 + fr;
                float ss = 0.f;
#pragma unroll
                for (int bj = 0; bj < 2; ++bj)
#pragma unroll
                    for (int n = 0; n < 2; ++n) {
                        const f32x4 xn = bf4_to_f32(xo[m][bj][n]) + acc[ai][bj][m][n] * coef;
                        acc[ai][bj][m][n] = xn;
                        ss += (xn[0] * xn[0] + xn[1] * xn[1]) + (xn[2] * xn[2] + xn[3] * xn[3]);
                    }
                ss += __builtin_bit_cast(float, __builtin_amdgcn_ds_bpermute((ln ^ 16) << 2, __builtin_bit_cast(int, ss)));
                ss += __builtin_bit_cast(float, __builtin_amdgcn_ds_bpermute((ln ^ 32) << 2, __builtin_bit_cast(int, ss)));
                if (fq == 0) atomicAdd(part + row, ss);
            }
        }
        asm volatile("s_waitcnt vmcnt(0)" ::: "memory");
        if (ln == 0) __hip_atomic_fetch_add(cnt, 1u, __ATOMIC_RELAXED, __HIP_MEMORY_SCOPE_AGENT);
        if (wr == 0 && wc == 0) {
            for (unsigned spins = 0; spins < (1u << 22); ++spins) {
                if ((unsigned)__builtin_amdgcn_readfirstlane((int)__hip_atomic_load(cnt, __ATOMIC_RELAXED, __HIP_MEMORY_SCOPE_AGENT)) >= 32u) break;
                __builtin_amdgcn_s_sleep(2);
            }
            __builtin_amdgcn_fence(__ATOMIC_ACQUIRE, "agent");
        }
        asm volatile("s_waitcnt vmcnt(0) lgkmcnt(0)" ::: "memory"); __builtin_amdgcn_s_barrier(); asm volatile("" ::: "memory");
        float ssr[2][4]; f32x4 gv[2][2];
#pragma unroll
        for (int ai = 0; ai < 2; ++ai)
#pragma unroll
            for (int m = 0; m < 4; ++m) ssr[ai][m] = part[u.pm * BM + ai * HALF + wr * 64 + m * 16 + fr];
#pragma unroll
        for (int bj = 0; bj < 2; ++bj)
#pragma unroll
            for (int n = 0; n < 2; ++n) gv[bj][n] = *(const f32x4*)(gain + u.pn * BM + bj * HALF + wc * 32 + n * 16 + 4 * fq);
#pragma unroll
        for (int ai = 0; ai < 2; ++ai)
#pragma unroll
            for (int m = 0; m < 4; ++m) {
                const int row = u.pm * BM + ai * HALF + wr * 64 + m * 16 + fr;
                const float r = __builtin_amdgcn_rsqf(ssr[ai][m] * (1.0f / 1024.0f) + EPS);
#pragma unroll
                for (int bj = 0; bj < 2; ++bj)
#pragma unroll
                    for (int n = 0; n < 2; ++n) {
                        const int c = u.pn * BM + bj * HALF + wc * 32 + n * 16 + 4 * fq;
                        st_wt16(out + (size_t)row * DM + c, acc[ai][bj][m][n] * r * gv[bj][n]);
                    }
            }
    }
};
template <int KIND>
__device__ __forceinline__ void in_tile(const f32x4 (&acc)[2][2][4][2], const Unit& u, int wr, int wc, int fr, int fq, const PreRows& pre, bf16_t* EB, int dcol0  ,
                                        float sc, float* o_p, float* o_s, int ocol0  , int opitch, const float* bias, float* LG) {
    float rr[2][4];
#pragma unroll
    for (int ai = 0; ai < 2; ++ai)
#pragma unroll
        for (int m = 0; m < 4; ++m) rr[ai][m] = pre_rinv(pre, ai, m, fr);
    f32x4 bia[2][2] = {};
    if (KIND == 4 || KIND == 5) {
#pragma unroll
        for (int bj = 0; bj < 2; ++bj) { const int cl = bj * HALF + wc * 32 + 8 * fq;
            if (KIND == 4 || cl < 16) { bia[bj][0] = *(const f32x4*)(bias + cl); bia[bj][1] = *(const f32x4*)(bias + cl + 4); } }
    }
#pragma unroll
    for (int ai = 0; ai < 2; ++ai)
#pragma unroll
        for (int m = 0; m < 4; ++m) {
            const int row = u.pm * BM + ai * HALF + wr * 64 + m * 16 + fr;
            const float r = rr[ai][m] * sc;
#pragma unroll
            for (int bj = 0; bj < 2; ++bj) {
                const int cl = bj * HALF + wc * 32 + 8 * fq;
                float v[8];
#pragma unroll
                for (int n = 0; n < 2; ++n)
#pragma unroll
                    for (int i = 0; i < 4; ++i) v[4 * n + i] = acc[ai][bj][m][n][i] * r;
                if (KIND == 4) {
                    const f32x4 b0 = bia[bj][0], b1 = bia[bj][1];
                    f32x4 o0, o1;
#pragma unroll
                    for (int i = 0; i < 4; ++i) { o0[i] = logsigmoid_f(v[i] + b0[i]) * (1.0f / 16.0f); o1[i] = logsigmoid_f(v[4 + i] + b1[i]) * (1.0f / 16.0f); }
                    *(f32x4*)(LG + (size_t)row * 256 + cl) = o0; *(f32x4*)(LG + (size_t)row * 256 + cl + 4) = o1;
                } else if (KIND == 5) {
                    if (cl < 16) {
                        const f32x4 b0 = bia[bj][0], b1 = bia[bj][1];
                        f32x4 o0, o1;
#pragma unroll
                        for (int i = 0; i < 4; ++i) { o0[i] = logsigmoid_f(v[i] + b0[i]); o1[i] = logsigmoid_f(v[4 + i] + b1[i]); }
                        *(f32x4*)(LG + (size_t)row * 16 + cl) = o0; *(f32x4*)(LG + (size_t)row * 16 + cl + 4) = o1;
                        float* dst = (row < MP) ? o_p + (size_t)row * 16 + cl : o_s + (size_t)(row - MP) * 16 + cl;
                        *(f32x4*)dst = o0; *(f32x4*)(dst + 4) = o1;
                    }
                } else {
                    if (KIND == 1) {
                        float t[8];
#pragma unroll
                        for (int e = 0; e < 8; ++e) t[e] = __builtin_amdgcn_exp2f(v[e] * -LOG2E);
#pragma unroll
                        for (int e = 0; e < 8; ++e) t[e] = __builtin_amdgcn_rcpf(t[e] + 1.0f);
#pragma unroll
                        for (int e = 0; e < 8; ++e) v[e] *= t[e];
                    }
                    u32x4 w; w.x = cvt_pk_bf16(v[0], v[1]); w.y = cvt_pk_bf16(v[2], v[3]); w.z = cvt_pk_bf16(v[4], v[5]); w.w = cvt_pk_bf16(v[6], v[7]);
                    st_wt16(EB + (size_t)row * NIN + dcol0 + cl, w);
                    if (KIND == 2) {
                        float* dst = (row < MP) ? o_p + (size_t)row * opitch + ocol0 + cl : o_s + (size_t)(row - MP) * opitch + ocol0 + cl;
                        *(f32x4*)dst = (f32x4){v[0], v[1], v[2], v[3]}; *(f32x4*)(dst + 4) = (f32x4){v[4], v[5], v[6], v[7]};
                    }
                    if (KIND == 3) {
                        float* dst = nullptr;
                        if (row >= MP) dst = o_s + (size_t)(row - MP) * 512 + ocol0 + cl;
                        else { const int t = row & (TSEQ - 1), b = row >> 11; if (t >= TSEQ - 512) dst = o_p + ((size_t)(b * 512 + (t - (TSEQ - 512))) * 512 + ocol0 + cl); }
                        if (dst) { *(f32x4*)dst = (f32x4){v[0], v[1], v[2], v[3]}; *(f32x4*)(dst + 4) = (f32x4){v[4], v[5], v[6], v[7]}; }
                    }
                }
            }
        }
}
struct EpiInEven {
    static constexpr bool PERM = true, AFTER_DRAIN = false;
    unsigned char* ws; float* out; PG8_LAS unsigned char* lds;
    typedef PreRows Pre;
    __device__ __forceinline__ void pre_load(Pre& p, const Unit& u, int wr, int lane) const { pre_rows_load(p, (const float*)(ws + WS_PART + 1 * SZ_PART), u, wr, lane, lds); }
    __device__ __forceinline__ void operator()(const f32x4 (&acc)[2][2][4][2], const Unit& u, int wr, int wc, int fr, int fq, const Pre& part) const {
        const int pn = u.pn;
        bf16_t* EB = (bf16_t*)(ws + WS_EB);
        if (pn == 4 || pn == 5) in_tile<1>(acc, u, wr, wc, fr, fq, part, EB, pn * BM, 1.0f, nullptr, nullptr, 0, 0, nullptr, nullptr);
        else if (pn >= 9) { const bool isv = pn >= 11; in_tile<3>(acc, u, wr, wc, fr, fq, part, EB, pn * BM, 1.0f, out + (isv ? O_PBV : O_PBK), out + (isv ? O_SBV : O_SBK), pn * BM - (isv ? 2816 : 2304), 512, nullptr, nullptr); }
        else in_tile<0>(acc, u, wr, wc, fr, fq, part, EB, pn * BM, (pn == 0) ? 0.125f : ((pn >= 7) ? QSCALE2 : 1.0f), nullptr, nullptr, 0, 0, nullptr, nullptr);
    }
};
struct EpiInOdd {
    static constexpr bool PERM = true, AFTER_DRAIN = false;
    unsigned char* ws; float* out; PG8_LAS unsigned char* lds;
    typedef PreRows Pre;
    __device__ __forceinline__ void pre_load(Pre& p, const Unit& u, int wr, int lane) const { pre_rows_load(p, (const float*)(ws + WS_PART + 4 * SZ_PART), u, wr, lane, lds); }
    __device__ __forceinline__ void operator()(const f32x4 (&acc)[2][2][4][2], const Unit& u, int wr, int wc, int fr, int fq, const Pre& part) const {
        const int pn = u.pn;
        bf16_t* EB = (bf16_t*)(ws + WS_EB);
        if (pn >= 4) { const bool isv = pn >= 8; in_tile<2>(acc, u, wr, wc, fr, fq, part, EB, pn * BM, 1.0f, out + (isv ? O_PFV : O_PFK), out + (isv ? O_SFV : O_SFK), pn * BM - (isv ? 2048 : 1024), 1024, nullptr, nullptr); }
        else in_tile<0>(acc, u, wr, wc, fr, fq, part, EB, pn * BM, QSCALE2, nullptr, nullptr, 0, 0, nullptr, nullptr);
    }
};
template <class Epi, class Sched, bool ALIGN_EPI = false, bool SP2 = false>
__device__ __forceinline__ void gemm_phase(PG8_LAS unsigned char* lds, const Gemm g, const Sched& S, const Epi& E) {
    int tid_ = threadIdx.x; asm volatile("" : "+v"(tid_));
    const int tid = tid_, wid = __builtin_amdgcn_readfirstlane(tid >> 6), lane = tid & 63, wr = wid >> 2, wc = wid & 3, fr = lane & 15, fq = lane >> 4;
    const int K = g.K, nt = K / BK;
    unsigned voffA[2], voffB[2];
#pragma unroll
    for (int i = 0; i < 2; ++i) { int R, C; stage_rc(tid * 16 + i * 8192, R, C); const int Rb = Epi::PERM ? ((R & ~31) + perm32(R & 31)) : R;
        voffA[i] = (unsigned)(R * K + C) * 2u; voffB[i] = (unsigned)(Rb * K + C) * 2u; }
    const size_t kstep = (size_t)(BK * 2);
    const size_t hstep = (size_t)HALF * K * 2;
    const size_t tstep = 2 * hstep;
    const unsigned ldsw = (unsigned)wid * 1024u;
    const int aoff = lds_byte(wr * 64 + fr, fq * 8), boff = lds_byte(wc * 32 + fr, fq * 8);
#define PG8_SA(b, h) (((b) * 2 + (h)) * HTB)
#define PG8_SB(b, h) ((4 + (b) * 2 + (h)) * HTB)
#define PG8_STAGE(bufoff, gbase, voff) do { _Pragma("unroll") for (int _i = 0; _i < 2; ++_i) \
        __builtin_amdgcn_global_load_lds((const unsigned*)((const char*)(gbase) + (voff)[_i]), (PG8_LAS unsigned*)(lds + (bufoff) + ldsw + _i * 8192), 16, 0, 0); } while (0)
#define PG8_LDA(dst, b, h) do { _Pragma("unroll") for (int m = 0; m < 4; ++m) _Pragma("unroll") for (int k = 0; k < 2; ++k) dst[m][k] = *(const PG8_LAS bf16x8*)(lds + PG8_SA(b, h) + aoff + m * 2048 + k * 1024); } while (0)
#define PG8_LDB(dst, b, h) do { _Pragma("unroll") for (int n = 0; n < 2; ++n) _Pragma("unroll") for (int k = 0; k < 2; ++k) dst[n][k] = *(const PG8_LAS bf16x8*)(lds + PG8_SB(b, h) + boff + n * 2048 + k * 1024); } while (0)
#define PG8_MMA(ai, bj, At, Bt) do { __builtin_amdgcn_s_setprio(1); _Pragma("unroll") for (int m = 0; m < 4; ++m) _Pragma("unroll") for (int n = 0; n < 2; ++n) _Pragma("unroll") for (int k = 0; k < 2; ++k) \
        acc[ai][bj][m][n] = __builtin_amdgcn_mfma_f32_16x16x32_bf16(Bt[n][k], At[m][k], acc[ai][bj][m][n], 0, 0, 0); __builtin_amdgcn_s_setprio(0); } while (0)
#define PG8_WAIT_V(n) asm volatile("s_waitcnt vmcnt(" #n ")" ::: "memory")
#define PG8_WAIT_L(n) asm volatile("s_waitcnt lgkmcnt(" #n ")" ::: "memory")
#define PG8_BAR __builtin_amdgcn_s_barrier()
#define PG8_SCHED __builtin_amdgcn_sched_barrier(0)
    Unit cur, nxt; int ui = 0;
    typename Epi::Pre pre{};
    if (!S.next(0, cur)) return;
    f32x4 acc[2][2][4][2];
#pragma unroll
    for (int a = 0; a < 2; ++a)
#pragma unroll
        for (int b = 0; b < 2; ++b)
#pragma unroll
            for (int m = 0; m < 4; ++m)
#pragma unroll
                for (int n = 0; n < 2; ++n) acc[a][b][m][n] = (f32x4){0.f, 0.f, 0.f, 0.f};
    bf16x8 At[4][2], B0[2][2], B1[2][2];
    const char* cA = (const char*)g.A + (size_t)cur.pm * tstep; const char* cB = (const char*)g.Bt + (size_t)cur.pn * tstep;
    S.a_ready(cur);
    if constexpr (SP2) {
        PG8_STAGE(PG8_SB(0, 0), cB, voffB); PG8_STAGE(PG8_SB(0, 1), cB + hstep, voffB); PG8_STAGE(PG8_SA(0, 0), cA, voffA); PG8_STAGE(PG8_SA(0, 1), cA + hstep, voffA);
        if (wr == 1) PG8_BAR;
        PG8_WAIT_V(2); PG8_BAR;
        PG8_STAGE(PG8_SB(1, 0), cB + kstep, voffB); PG8_STAGE(PG8_SA(1, 0), cA + kstep, voffA); PG8_STAGE(PG8_SB(1, 1), cB + hstep + kstep, voffB);
        PG8_WAIT_V(6); PG8_BAR;
    } else {
        PG8_STAGE(PG8_SB(0, 0), cB, voffB); PG8_STAGE(PG8_SA(0, 0), cA, voffA); PG8_STAGE(PG8_SB(0, 1), cB + hstep, voffB); PG8_STAGE(PG8_SA(0, 1), cA + hstep, voffA);
        if (wr == 1) PG8_BAR;
        PG8_WAIT_V(4); PG8_BAR;
        PG8_STAGE(PG8_SB(1, 0), cB + kstep, voffB); PG8_STAGE(PG8_SA(1, 0), cA + kstep, voffA); PG8_STAGE(PG8_SB(1, 1), cB + hstep + kstep, voffB);
        PG8_WAIT_V(6); PG8_BAR;
    }
    for (;;) {
        const bool has_next = S.next(ui + 1, nxt);
        const char* nA = has_next ? (const char*)g.A + (size_t)nxt.pm * tstep : cA; const char* nB = has_next ? (const char*)g.Bt + (size_t)nxt.pn * tstep : cB;
        for (int t = 0; t < nt; t += 2) {
            const bool last = (t == nt - 2);
            const char* a1 = cA + (size_t)(t + 1) * kstep;
            const char* a2 = last ? nA : cA + (size_t)(t + 2) * kstep; const char* b2 = last ? nB : cB + (size_t)(t + 2) * kstep;
            const char* a3 = a2 + kstep; const char* b3 = b2 + kstep;
            if (last && has_next) S.a_ready(nxt);
            if (last) E.pre_load(pre, cur, wr, lane);
            if constexpr (SP2) {
            PG8_LDB(B0, 0, 0); PG8_LDB(B1, 0, 1); PG8_SCHED; PG8_LDA(At, 0, 0); PG8_STAGE(PG8_SA(1, 1), a1 + hstep, voffA);
            PG8_WAIT_V(8); PG8_WAIT_L(0); PG8_BAR; PG8_MMA(0, 0, At, B0); PG8_MMA(0, 1, At, B1); PG8_BAR; PG8_SCHED;
            PG8_LDA(At, 0, 1); PG8_STAGE(PG8_SB(0, 0), b2, voffB); PG8_STAGE(PG8_SB(0, 1), b2 + hstep, voffB); PG8_STAGE(PG8_SA(0, 0), a2, voffA);
            PG8_WAIT_V(8); PG8_WAIT_L(0); PG8_BAR; PG8_MMA(1, 0, At, B0); PG8_MMA(1, 1, At, B1); PG8_BAR; PG8_SCHED;
            PG8_LDB(B0, 1, 0); PG8_LDB(B1, 1, 1); PG8_SCHED; PG8_LDA(At, 1, 0); PG8_STAGE(PG8_SA(0, 1), a2 + hstep, voffA);
            PG8_WAIT_V(8); PG8_WAIT_L(0); PG8_BAR; PG8_MMA(0, 0, At, B0); PG8_MMA(0, 1, At, B1); PG8_BAR; PG8_SCHED;
            PG8_LDA(At, 1, 1); PG8_STAGE(PG8_SB(1, 0), b3, voffB); PG8_STAGE(PG8_SB(1, 1), b3 + hstep, voffB); PG8_STAGE(PG8_SA(1, 0), a3, voffA);
            PG8_WAIT_V(8); PG8_WAIT_L(0); PG8_BAR; PG8_MMA(1, 0, At, B0); PG8_MMA(1, 1, At, B1); PG8_BAR; PG8_SCHED;
            } else {
            PG8_LDB(B0, 0, 0); PG8_SCHED; PG8_LDA(At, 0, 0); PG8_STAGE(PG8_SA(1, 1), a1 + hstep, voffA);
            PG8_WAIT_L(8); PG8_BAR; PG8_WAIT_L(0); PG8_MMA(0, 0, At, B0); PG8_BAR; PG8_SCHED;
            PG8_LDB(B1, 0, 1); PG8_STAGE(PG8_SB(0, 0), b2, voffB);
            PG8_BAR; PG8_WAIT_L(0); PG8_MMA(0, 1, At, B1); PG8_BAR;
            PG8_LDA(At, 0, 1); PG8_STAGE(PG8_SA(0, 0), a2, voffA);
            PG8_BAR; PG8_WAIT_L(0); PG8_MMA(1, 0, At, B0); PG8_BAR; PG8_SCHED;
            PG8_STAGE(PG8_SB(0, 1), b2 + hstep, voffB);
            PG8_WAIT_V(6); PG8_BAR; PG8_MMA(1, 1, At, B1); PG8_BAR;
            PG8_LDB(B0, 1, 0); PG8_SCHED; PG8_LDA(At, 1, 0); PG8_STAGE(PG8_SA(0, 1), a2 + hstep, voffA);
            PG8_WAIT_L(8); PG8_BAR; PG8_WAIT_L(0); PG8_MMA(0, 0, At, B0); PG8_BAR; PG8_SCHED;
            PG8_LDB(B1, 1, 1); PG8_STAGE(PG8_SB(1, 0), b3, voffB);
            PG8_BAR; PG8_WAIT_L(0); PG8_MMA(0, 1, At, B1); PG8_BAR;
            PG8_LDA(At, 1, 1); PG8_STAGE(PG8_SA(1, 0), a3, voffA);
            PG8_BAR; PG8_WAIT_L(0); PG8_MMA(1, 0, At, B0); PG8_BAR; PG8_SCHED;
            PG8_STAGE(PG8_SB(1, 1), b3 + hstep, voffB);
            PG8_WAIT_V(6); PG8_BAR; PG8_MMA(1, 1, At, B1); PG8_BAR;
            }
        }
        if constexpr (ALIGN_EPI) { if (wr == 0) PG8_BAR; }
        if constexpr (!Epi::AFTER_DRAIN) { E(acc, cur, wr, wc, fr, fq, pre); S.done(cur); }
        if (!has_next) break;
#pragma unroll
        for (int a = 0; a < 2; ++a)
#pragma unroll
            for (int b = 0; b < 2; ++b)
#pragma unroll
                for (int m = 0; m < 4; ++m)
#pragma unroll
                    for (int n = 0; n < 2; ++n) acc[a][b][m][n] = (f32x4){0.f, 0.f, 0.f, 0.f};
        cur = nxt; cA = nA; cB = nB; ++ui;
        if constexpr (ALIGN_EPI) { if (wr == 1) PG8_BAR; }
    }
    PG8_WAIT_V(0);
    if constexpr (!ALIGN_EPI) { if (wr == 0) PG8_BAR; }
    PG8_BAR;
    if constexpr (Epi::AFTER_DRAIN) { E.fused(acc, cur, wr, wc, fr, fq, lds, wid, lane); S.done(cur); }
#undef PG8_SA
#undef PG8_SB
#undef PG8_STAGE
#undef PG8_LDA
#undef PG8_LDB
#undef PG8_MMA
#undef PG8_WAIT_V
#undef PG8_WAIT_L
#undef PG8_BAR
#undef PG8_SCHED
}
}
#include <hip/hip_bf16.h>
#include <cmath>
namespace attn_body {
using bf16=__hip_bfloat16;
using bf16x8=__attribute__((ext_vector_type(8)))short;
using s16x4=__attribute__((ext_vector_type(4)))short;
using f32x16=__attribute__((ext_vector_type(16)))float;
using u32x4=__attribute__((ext_vector_type(4)))unsigned;
typedef float f32x4_t __attribute__((ext_vector_type(4)));
constexpr int BATCH=8,NHEAD=16,SEQ=2048,D=64,DM=NHEAD*D,PQ=3328;
constexpr int NW=8,QBLK=32,QB=QBLK*NW,KVBLK=64,NQB=SEQ/QB;
constexpr int ATTN_UNIT_ROWS=QB;
__device__ __forceinline__ int crow(int r,int hi){return (r&3)+8*(r>>2)+4*hi;}
#define SBAR() __builtin_amdgcn_sched_barrier(0)
__device__ __forceinline__ void cmask(f32x16&p0,f32x16&p1,int jb,int qrel,int hi){
  const float NEG=-INFINITY; int kb=64*jb+4*hi;
  #pragma unroll
  for(int r=0;r<16;++r){int kv=kb+(r&3)+8*(r>>2); if(kv>qrel)p0[r]=NEG; if(kv+32>qrel)p1[r]=NEG;}
}

constexpr int NSLOT=3, SLOTB=8192;
constexpr float FOX_SKIP2_=160.0f*1.4426950408889634f;
constexpr int LDS_K=0, LDS_V=NSLOT*SLOTB, LDS_WS=2*NSLOT*SLOTB, LDS_OST=LDS_WS+NW*64*4, LDS_BYTES=LDS_OST+NW*4096;
constexpr float C2=0.125f*1.4426950408889634f;
__device__ __forceinline__ void glds16(const void*gsrc,unsigned lds_dst){unsigned keep;
  asm volatile("s_mov_b32 %0, m0\n\ts_mov_b32 m0, %2\n\ts_nop 0\n\tglobal_load_lds_dwordx4 %1, off\n\ts_mov_b32 m0, %0":"=&s"(keep):"v"(gsrc),"s"(lds_dst):"memory");}
__device__ __forceinline__ float max3f(float a,float b,float c){float r;asm("v_max3_f32 %0, %1, %2, %3":"=v"(r):"v"(a),"v"(b),"v"(c));return r;}
__device__ __forceinline__ float max2f(float a,float b){float r;asm("v_max_f32_e32 %0, %1, %2":"=v"(r):"v"(a),"v"(b));return r;}
__device__ __forceinline__ float fadd_s(float a,float b){float r;asm("v_add_f32_e32 %0, %1, %2":"=v"(r):"v"(a),"v"(b));return r;}
__device__ __forceinline__ float fsub_s(float a,float b){float r;asm("v_sub_f32_e32 %0, %1, %2":"=v"(r):"v"(a),"v"(b));return r;}
typedef float f32x2_t __attribute__((ext_vector_type(2))); typedef __bf16 bf16x2_t __attribute__((ext_vector_type(2)));
__device__ __forceinline__ unsigned cvtpk_s(float lo,float hi){f32x2_t v={lo,hi};bf16x2_t b=__builtin_convertvector(v,bf16x2_t);return __builtin_bit_cast(unsigned,b);}
#define WAIT_BAR(N) asm volatile("s_waitcnt vmcnt(" #N ") lgkmcnt(0)\n\ts_barrier":::"memory")

__device__ __forceinline__ void qkt(f32x16&p0,f32x16&p1,const char*Kslot,const bf16x8*qr,int r32,int hi){
  const char*kb=Kslot+hi*1024+r32*16;
  #pragma unroll
  for(int d0=0;d0<4;++d0){
    const bf16x8 b0=*reinterpret_cast<const bf16x8*>(kb+d0*2048);
    const bf16x8 b1=*reinterpret_cast<const bf16x8*>(kb+d0*2048+512);
    {p0=__builtin_amdgcn_mfma_f32_32x32x16_bf16(b0,qr[d0],p0,0,0,0);p1=__builtin_amdgcn_mfma_f32_32x32x16_bf16(b1,qr[d0],p1,0,0,0);}}
}
typedef __attribute__((address_space(3))) const char* lds_cptr;
typedef short v4i16_t __attribute__((ext_vector_type(4)));
__device__ __forceinline__ void kload8(bf16x8*kf,lds_cptr kp){
  kf[0]=*(const __attribute__((address_space(3))) bf16x8*)(kp);      kf[1]=*(const __attribute__((address_space(3))) bf16x8*)(kp+512);
  kf[2]=*(const __attribute__((address_space(3))) bf16x8*)(kp+2048); kf[3]=*(const __attribute__((address_space(3))) bf16x8*)(kp+2560);
  kf[4]=*(const __attribute__((address_space(3))) bf16x8*)(kp+4096); kf[5]=*(const __attribute__((address_space(3))) bf16x8*)(kp+4608);
  kf[6]=*(const __attribute__((address_space(3))) bf16x8*)(kp+6144); kf[7]=*(const __attribute__((address_space(3))) bf16x8*)(kp+6656);
}
__device__ __forceinline__ void kload2(bf16x8*kf,lds_cptr kp,int j){ kf[2*j]=*(const __attribute__((address_space(3))) bf16x8*)(kp+j*2048); kf[2*j+1]=*(const __attribute__((address_space(3))) bf16x8*)(kp+j*2048+512); }
__device__ __forceinline__ s16x4 vtr(lds_cptr p){ return __builtin_bit_cast(s16x4,__builtin_amdgcn_ds_read_tr16_b64_v4i16((__attribute__((address_space(3))) v4i16_t*)p)); }
__device__ __forceinline__ float rowmax(const f32x16&p0,const f32x16&p1){
  float a=max3f(p0[0],p0[1],p1[0]),b=max3f(p0[2],p0[3],p1[1]);a=max3f(a,p1[2],p1[3]);
  #pragma unroll
  for(int r=4;r<16;r+=4){a=max3f(a,p0[r],p0[r+1]);b=max3f(b,p0[r+2],p0[r+3]);a=max3f(a,p1[r],p1[r+1]);b=max3f(b,p1[r+2],p1[r+3]);}
  const float m=max2f(a,b);
  auto rr=__builtin_amdgcn_permlane32_swap(__float_as_uint(m),__float_as_uint(m),false,false);
  return max2f(__uint_as_float(rr[0]),__uint_as_float(rr[1]));
}
__device__ __forceinline__ void pv(f32x16*o,int vb,bf16x8 pa0,bf16x8 pa1,bf16x8 pa2,bf16x8 pa3){
  #pragma unroll
  for(int d0=0;d0<2;++d0){s16x4 lo[4],hi[4];
    #pragma unroll
    for(int ks=0;ks<4;++ks){
      asm volatile("ds_read_b64_tr_b16 %0,%1 offset:%c2":"=&v"(lo[ks]):"v"(vb),"i"(d0*4096+ks*1024):"memory");
      asm volatile("ds_read_b64_tr_b16 %0,%1 offset:%c2":"=&v"(hi[ks]):"v"(vb),"i"(d0*4096+ks*1024+512):"memory");}
    asm volatile("s_waitcnt lgkmcnt(0)":::"memory");SBAR();
    #define PK(k) (bf16x8){lo[k][0],lo[k][1],lo[k][2],lo[k][3],hi[k][0],hi[k][1],hi[k][2],hi[k][3]}
    o[d0]=__builtin_amdgcn_mfma_f32_32x32x16_bf16(pa0,PK(0),o[d0],0,0,0);
    o[d0]=__builtin_amdgcn_mfma_f32_32x32x16_bf16(pa1,PK(1),o[d0],0,0,0);
    o[d0]=__builtin_amdgcn_mfma_f32_32x32x16_bf16(pa2,PK(2),o[d0],0,0,0);
    o[d0]=__builtin_amdgcn_mfma_f32_32x32x16_bf16(pa3,PK(3),o[d0],0,0,0);
    #undef PK
  }
}

#ifndef ATTN_STORE16
#define ATTN_STORE16(p,v) (*(u32x4*)(p)=(v))
#endif
template<int THRL,int MODE> __device__ __forceinline__ void attn_unit(int b,int h,int qb,const bf16*Q,const bf16*K,const bf16*V,bf16*O,char*shm,const __attribute__((address_space(3))) float*F2){
  int tid_=threadIdx.x; asm volatile("":"+v"(tid_));
  const int tid=tid_,lane=tid&63,r32=lane&31,hi=lane>>5; const int wid=__builtin_amdgcn_readfirstlane(tid>>6);
  const long rowbase=(long)b*SEQ; const int q0=qb*QB;
  int t_lo=(MODE==1&&qb>=2)?4*qb-8:0;
  if(MODE==0){
    const float lim=F2[qb*QB]+FOX_SKIP2_;
    while(t_lo+2<=4*qb && __builtin_amdgcn_readfirstlane(F2[64*(t_lo+2)-1]>lim)) t_lo+=2; }
  const bf16*Qw=Q+(rowbase+q0+wid*QBLK)*PQ+h*D;
  const bf16*Kh=K+(rowbase+64*t_lo)*PQ+h*D,*Vh=V+(rowbase+64*t_lo)*PQ+h*D;
  const unsigned lds0=(unsigned)(uintptr_t)shm;
  float*wsf=(float*)(shm+LDS_WS)+wid*64;
  const bf16*ksrc=Kh+(long)lane*PQ+wid*8;
  const bf16*vsrc=Vh+(long)(16*(wid&3)+(lane>>2))*PQ+(wid>>2)*32+(lane&3)*8;
  const unsigned kdst=lds0+LDS_K+wid*1024, vdst=lds0+LDS_V+wid*1024;
  #define DMA_K(t,slot) glds16(ksrc+(long)(t)*KVBLK*PQ,(unsigned)__builtin_amdgcn_readfirstlane(kdst+(slot)))
  #define DMA_V(t,slot) glds16(vsrc+(long)(t)*KVBLK*PQ,(unsigned)__builtin_amdgcn_readfirstlane(vdst+(slot)))
  const int vb0=(int)(lds0+LDS_V)+((lane>>4)&1)*32+(lane&3)*8+(4*hi+((lane&15)>>2))*64;
  const char*Kbase=shm+LDS_K; bf16x8 kf[8];
  const lds_cptr shm3=(lds_cptr)shm; const lds_cptr kp0=shm3+LDS_K+hi*1024+r32*16; const lds_cptr vp0=shm3+LDS_V+((lane>>4)&1)*32+(lane&3)*8+(4*hi+((lane&15)>>2))*64;
  const int NT=(q0+QB)/KVBLK-t_lo;
  DMA_K(0,0);DMA_V(0,0);DMA_K(1,SLOTB);
  bf16x8 qr[4];
  #pragma unroll
  for(int d0=0;d0<4;++d0)qr[d0]=*reinterpret_cast<const bf16x8*>(&Qw[(long)r32*PQ+d0*16+hi*8]);
  float mhat=0.f,l_reg=0.f;f32x16 o[2];o[0]=f32x16{};o[1]=f32x16{};
  #define BIAS(C0,C1,t) do{ const float nm_=f2q-mhat;          \
    if(MODE==0){ const __attribute__((address_space(3))) float*fp_=F2+64*(t_lo+(t))+4*hi; \
      _Pragma("unroll") for(int g_=0;g_<4;++g_){ const f32x4_t a_=*(const __attribute__((address_space(3))) f32x4_t*)(fp_+8*g_), b_=*(const __attribute__((address_space(3))) f32x4_t*)(fp_+32+8*g_); \
        _Pragma("unroll") for(int i_=0;i_<4;++i_){ C0[4*g_+i_]=nm_-a_[i_]; C1[4*g_+i_]=nm_-b_[i_]; } } } \
    else{ const int dl_=4*qb+(wid>>1)-(t_lo+(t));              \
      if(dl_<0||dl_>8){ const float c_=nm_-4096.f; _Pragma("unroll") for(int r=0;r<16;++r){C0[r]=c_;C1[r]=c_;} } \
      else if(dl_>=3){ const float c_=nm_+F2[256]; _Pragma("unroll") for(int r=0;r<16;++r){C0[r]=c_;C1[r]=c_;} } \
      else{ const __attribute__((address_space(3))) float*tp_=F2+64*dl_+128+32*(wid&1)+r32-4*hi;     \
        _Pragma("unroll") for(int r=0;r<16;++r){ const int j_=(r&3)+8*(r>>2); C0[r]=nm_+tp_[-j_]; C1[r]=nm_+tp_[-j_-32]; } } } }while(0)
  const int qrel=wid*QBLK+r32;
  const float f2q=(MODE==0)?F2[q0+qrel]:0.f;
  #define CMASK(P0,P1,t) do{ if(MODE==0){int jb_=(t)-(NT-4); if(jb_>=0)cmask(P0,P1,jb_,qrel,hi);} }while(0)
  bool resc=false;
  #define START(P0,P1) do{ const float rm=rowmax(P0,P1); resc=false; \
    { const float dl=__builtin_fmaxf(rm,0.f); mhat=fadd_s(mhat,dl); \
      _Pragma("unroll") for(int r=0;r<16;++r){P0[r]=fsub_s(P0[r],dl);P1[r]=fsub_s(P1[r],dl);} \
      } \
    _Pragma("unroll") for(int r=0;r<16;++r)P0[r]=__builtin_amdgcn_exp2f(P0[r]); }while(0)
  #define RESC() do{ if(resc){ asm volatile("s_waitcnt lgkmcnt(0)":::"memory"); \
      _Pragma("unroll") for(int d_=0;d_<2;++d_) _Pragma("unroll") for(int r=0;r<16;++r)o[d_][r]*=wsf[crow(r,hi)]; } }while(0)
  f32x16 pA0,pA1,pB0,pB1;
  int sl_prev=0,sl_cur=0,sl_next=SLOTB;
  #define ROT() do{sl_prev=sl_cur;sl_cur=sl_next;sl_next=(sl_next==(NSLOT-1)*SLOTB)?0:sl_next+SLOTB;}while(0)
  DMA_K(2,2*SLOTB);
  WAIT_BAR(3);
  BIAS(pA0,pA1,0); qkt(pA0,pA1,Kbase,qr,r32,hi);asm volatile("s_nop 15\n\ts_nop 7":"+v"(pA0),"+v"(pA1));CMASK(pA0,pA1,0);
  START(pA0,pA1);
  _Pragma("unroll") for(int r=0;r<16;++r)pA1[r]=__builtin_amdgcn_exp2f(pA1[r]);
  WAIT_BAR(0);
  DMA_K(3,0);DMA_V(1,SLOTB);
  ROT();
  kload8(kf,kp0+sl_cur);
  WAIT_BAR(2);
  s16x4 vlo[8],vhi[8]; u32x4 pw0,pw1,pw2,pw3;
  #define PKW(P,B) cvtpk_s(P[B],P[B+1])
  #define PAF(k) __builtin_bit_cast(bf16x8,pw##k)
  #define VFR(i) (bf16x8){vlo[i][0],vlo[i][1],vlo[i][2],vlo[i][3],vhi[i][0],vhi[i][1],vhi[i][2],vhi[i][3]}
  #define PIN(x) asm volatile("":"+v"(x))
  #define MX3(a,b,c) __builtin_fmaxf(__builtin_fmaxf((a),(b)),(c))
  #define GAPA(MF,A0,A1,A2,A3,W0,W1,PW) do{ MF; sacc+=A0; sacc+=A1; sacc+=A2; sacc+=A3; PIN(sacc); W0; W1; PIN(PW); SBAR(); }while(0)
  #define EX(v) __builtin_amdgcn_exp2f(v)
  #define GAPB(MF,X,B) do{ MF; X[B]=EX(X[B]); X[B+1]=EX(X[B+1]); X[B+2]=EX(X[B+2]); X[B+3]=EX(X[B+3]); PIN(X); SBAR(); }while(0)
  #define VRD(i) do{ vlo[i]=vtr(vp_+(((i)>>2)*4096+((i)&3)*1024)); vhi[i]=vtr(vp_+(((i)>>2)*4096+((i)&3)*1024+512)); }while(0)
  #define KRD(G,j) do{ if(G){ kload2(kf,kp0+sl_next,j); SBAR(); } }while(0)
  #define STEP(C0,C1,P0,P1,t,GK,GV,GL) do{ BIAS(C0,C1,t); SBAR(); \
    const lds_cptr vp_=vp0+sl_prev; \
    VRD(0); SBAR(); float sacc=(P0[0]+P0[1]); \
    GAPA(C0=__builtin_amdgcn_mfma_f32_32x32x16_bf16(kf[0],qr[0],C0,0,0,0), P0[2],P0[3],P0[4],P0[5],     pw0[0]=PKW(P0,0), pw0[1]=PKW(P0,2), pw0); \
    VRD(4); SBAR(); GAPA(C1=__builtin_amdgcn_mfma_f32_32x32x16_bf16(kf[1],qr[0],C1,0,0,0), P0[6],P0[7],P0[8],P0[9],     pw0[2]=PKW(P0,4), pw0[3]=PKW(P0,6), pw0); \
    VRD(1); SBAR(); GAPA(C0=__builtin_amdgcn_mfma_f32_32x32x16_bf16(kf[2],qr[1],C0,0,0,0),   P0[10],P0[11],P0[12],P0[13], pw1[0]=PKW(P0,8), pw1[1]=PKW(P0,10), pw1); \
    VRD(5); SBAR(); GAPA(C1=__builtin_amdgcn_mfma_f32_32x32x16_bf16(kf[3],qr[1],C1,0,0,0),   P0[14],P0[15],P1[0],P1[1],   pw1[2]=PKW(P0,12),pw1[3]=PKW(P0,14), pw1); \
    VRD(2); SBAR(); GAPA(C0=__builtin_amdgcn_mfma_f32_32x32x16_bf16(kf[4],qr[2],C0,0,0,0),   P1[2],P1[3],P1[4],P1[5],     pw2[0]=PKW(P1,0), pw2[1]=PKW(P1,2), pw2); \
    VRD(6); SBAR(); GAPA(C1=__builtin_amdgcn_mfma_f32_32x32x16_bf16(kf[5],qr[2],C1,0,0,0),   P1[6],P1[7],P1[8],P1[9],     pw2[2]=PKW(P1,4), pw2[3]=PKW(P1,6), pw2); \
    VRD(3); SBAR(); GAPA(C0=__builtin_amdgcn_mfma_f32_32x32x16_bf16(kf[6],qr[3],C0,0,0,0),   P1[10],P1[11],P1[12],P1[13], pw3[0]=PKW(P1,8), pw3[1]=PKW(P1,10), pw3); \
    VRD(7); SBAR(); GAPA(C1=__builtin_amdgcn_mfma_f32_32x32x16_bf16(kf[7],qr[3],C1,0,0,0),   P1[14],P1[15],0.f,0.f,       pw3[2]=PKW(P1,12),pw3[3]=PKW(P1,14), pw3); \
    l_reg+=sacc; \
    if(GK){DMA_K((t)+3,sl_cur);} if(GV){DMA_V((t)+1,sl_next);} \
    CMASK(C0,C1,t); \
    { float a=MX3(C0[0],C0[1],C1[0]),b=MX3(C0[2],C0[3],C1[1]); a=MX3(a,C1[2],C1[3]); \
      _Pragma("unroll") for(int r=4;r<16;r+=4){a=MX3(a,C0[r],C0[r+1]);b=MX3(b,C0[r+2],C0[r+3]);a=MX3(a,C1[r],C1[r+1]);b=MX3(b,C1[r+2],C1[r+3]);} \
      float rm=__builtin_fmaxf(a,b); { auto rr=__builtin_amdgcn_permlane32_swap(__float_as_uint(rm),__float_as_uint(rm),false,false); rm=__builtin_fmaxf(__uint_as_float(rr[0]),__uint_as_float(rr[1])); } \
      resc=false; \
      if(__builtin_expect(__any(rm>(float)THRL),0)){ const float dl=__builtin_fmaxf(rm,0.f); mhat+=dl; \
        _Pragma("unroll") for(int r=0;r<16;++r){C0[r]-=dl;C1[r]-=dl;} \
        const float f=__builtin_amdgcn_exp2f(-dl); l_reg*=f; if(hi==0)wsf[r32]=f; resc=true; } } \
    SBAR(); \
    GAPB(o[0]=__builtin_amdgcn_mfma_f32_32x32x16_bf16(PAF(0),VFR(0),o[0],0,0,0), C0,0); \
    GAPB(o[1]=__builtin_amdgcn_mfma_f32_32x32x16_bf16(PAF(0),VFR(4),o[1],0,0,0), C0,4); \
    KRD(GL,0); GAPB(o[0]=__builtin_amdgcn_mfma_f32_32x32x16_bf16(PAF(1),VFR(1),o[0],0,0,0), C0,8); \
    KRD(GL,1); GAPB(o[1]=__builtin_amdgcn_mfma_f32_32x32x16_bf16(PAF(1),VFR(5),o[1],0,0,0), C0,12); \
    KRD(GL,2); GAPB(o[0]=__builtin_amdgcn_mfma_f32_32x32x16_bf16(PAF(2),VFR(2),o[0],0,0,0), C1,0); \
    KRD(GL,3); GAPB(o[1]=__builtin_amdgcn_mfma_f32_32x32x16_bf16(PAF(2),VFR(6),o[1],0,0,0), C1,4); \
    GAPB(o[0]=__builtin_amdgcn_mfma_f32_32x32x16_bf16(PAF(3),VFR(3),o[0],0,0,0), C1,8); \
    GAPB(o[1]=__builtin_amdgcn_mfma_f32_32x32x16_bf16(PAF(3),VFR(7),o[1],0,0,0), C1,12); \
    }while(0)
  int t=1;
  #undef CMASK
  #define CMASK(P0,P1,t) do{}while(0)
  for(;t+5<NT;t+=2){
    STEP(pB0,pB1,pA0,pA1,t,true,true,true);     WAIT_BAR(2); RESC(); ROT();
    STEP(pA0,pA1,pB0,pB1,t+1,true,true,true);   WAIT_BAR(2); RESC(); ROT();
  }
  #undef CMASK
  #define CMASK(P0,P1,t) do{ if(MODE==0){int jb_=(t)-(NT-4); if(jb_>=0)cmask(P0,P1,jb_,qrel,hi);} }while(0)
  #define ENDW(tt) do{ if((tt)+3<NT){WAIT_BAR(2);} else if((tt)+2<NT){WAIT_BAR(1);} else {WAIT_BAR(0);} }while(0)
  for(;t+1<NT;t+=2){
    STEP(pB0,pB1,pA0,pA1,t,(t+3<NT),(t+1<NT),(t+1<NT));       ENDW(t);   RESC(); ROT();
    STEP(pA0,pA1,pB0,pB1,t+1,(t+4<NT),(t+2<NT),(t+2<NT));     ENDW(t+1); RESC(); ROT();
  }
  STEP(pB0,pB1,pA0,pA1,NT-1,false,false,false); RESC();
  { float sacc=pB0[0]+pB0[1]; _Pragma("unroll") for(int r=2;r<16;++r)sacc+=pB0[r]; _Pragma("unroll") for(int r=0;r<16;++r)sacc+=pB1[r]; l_reg+=sacc;
    pw0=(u32x4){PKW(pB0,0),PKW(pB0,2),PKW(pB0,4),PKW(pB0,6)};pw1=(u32x4){PKW(pB0,8),PKW(pB0,10),PKW(pB0,12),PKW(pB0,14)};pw2=(u32x4){PKW(pB1,0),PKW(pB1,2),PKW(pB1,4),PKW(pB1,6)};pw3=(u32x4){PKW(pB1,8),PKW(pB1,10),PKW(pB1,12),PKW(pB1,14)};
    SBAR(); pv(o,vb0+sl_cur,PAF(0),PAF(1),PAF(2),PAF(3)); }
  #undef PKW
  #undef PAF
  #undef VFR
  #undef PIN
  #undef MX3
  #undef GAPA
  #undef GAPB
  #undef EX
  #undef VRD
  #undef KRD
  #undef STEP
  #undef ENDW
  {auto rr=__builtin_amdgcn_permlane32_swap(__float_as_uint(l_reg),__float_as_uint(l_reg),false,false);l_reg=__uint_as_float(rr[0])+__uint_as_float(rr[1]);}
  if(hi==0)wsf[32+r32]=l_reg;asm volatile("s_waitcnt lgkmcnt(0)":::"memory");
  float rli[16];
  #pragma unroll
  for(int r=0;r<16;++r)rli[r]=__builtin_amdgcn_rcpf(wsf[32+crow(r,hi)]);
  bf16*Ow=O+(rowbase+q0+wid*QBLK)*DM+h*D;
  { bf16*stg=(bf16*)(shm+LDS_OST)+wid*2048;
    #pragma unroll
    for(int r=0;r<16;++r){const int orow=crow(r,hi);
      #pragma unroll
      for(int d0=0;d0<2;++d0)stg[orow*64+d0*32+r32]=__float2bfloat16(o[d0][r]*rli[r]);}
    asm volatile("s_waitcnt lgkmcnt(0)":::"memory");
    #pragma unroll
    for(int i=0;i<4;++i){const int row=i*8+(lane>>3),ch=lane&7; const u32x4 v=*(const u32x4*)(stg+row*64+ch*8); ATTN_STORE16(Ow+(long)row*DM+ch*8,v);} }
  asm volatile("s_waitcnt lgkmcnt(0)\n\ts_barrier":::"memory");
  #undef DMA_K
  #undef DMA_V
  #undef CMASK
  #undef START
  #undef RESC
  #undef ROT
  #undef BIAS
}
constexpr int ATTN_LDS_BYTES=LDS_BYTES;
#undef SBAR
#undef WAIT_BAR
}

typedef unsigned short bf16_t;
typedef float f32x4 __attribute__((ext_vector_type(4)));
typedef unsigned u32x4 __attribute__((ext_vector_type(4)));
typedef unsigned u32x2 __attribute__((ext_vector_type(2)));
#define LAS __attribute__((address_space(3)))

constexpr int LDS_BYTES = 147456;
constexpr int NWAVES = 8;

__device__ __forceinline__ unsigned f2bf(float f) { unsigned u = __builtin_bit_cast(unsigned, f); return (u + 0x7fffu + ((u >> 16) & 1u)) >> 16; }
typedef float f32x2_c __attribute__((ext_vector_type(2))); typedef __bf16 bf16x2_c __attribute__((ext_vector_type(2)));
__device__ __forceinline__ unsigned pk2(float lo, float hi) { const f32x2_c v = {lo, hi}; return __builtin_bit_cast(unsigned, __builtin_convertvector(v, bf16x2_c)); }
__device__ __forceinline__ float bf2f(unsigned short h) { return __builtin_bit_cast(float, (unsigned)h << 16); }
__device__ __forceinline__ float shfl_idx(float v, int src_lane) { return __builtin_bit_cast(float, __builtin_amdgcn_ds_bpermute(src_lane << 2, __builtin_bit_cast(int, v))); }
__device__ __forceinline__ float wave_sum(float v, int lane) {
#pragma unroll
    for (int o = 1; o < 64; o <<= 1) v += shfl_idx(v, lane ^ o);
    return v;
}
__device__ __forceinline__ float wave_max(float v, int lane) {
#pragma unroll
    for (int o = 1; o < 64; o <<= 1) v = fmaxf(v, shfl_idx(v, lane ^ o));
    return v;
}
__device__ __forceinline__ float lane_bcast(float v, int l) { return __builtin_bit_cast(float, __builtin_amdgcn_readlane(__builtin_bit_cast(int, v), l)); }

struct Args { const float* in[21]; float* out; unsigned char* ws; int ph_lo, ph_hi; };

struct WDesc { const float* W; const float* g; const float* W2; bf16_t* WT; int K, Nsrc, Ndst, kind; };
__device__ __forceinline__ void prep_item(const WDesc& d, int item, LAS float* scr, int lane) {
    const int nblk = d.Ndst / 32, kb = item / nblk, nb = item % nblk, k0 = 64 * kb, n0 = 32 * nb;
    int sc0 = n0, lim = d.Nsrc;
    if (d.kind == 1) { const int t = n0 >> 8, half = (n0 >> 7) & 1; sc0 = half * FF + t * 128 + (n0 & 127); }
    else if (d.kind == 2) { if (n0 >= 1792) sc0 = n0 - 240; else if (n0 > 1536) {
            if (n0 == 1568 && kb == 0) {
                bf16_t* T = d.WT + (size_t)1600 * d.K;
#pragma unroll
                for (int i = 0; i < 4; ++i) { const int n = 4 * lane + i; float w[16];
#pragma unroll
                    for (int r = 0; r < 16; ++r) w[r] = d.W2[r * 256 + n];
                    u32x4 o0, o1; o0.x = pk2(w[0], w[1]); o0.y = pk2(w[2], w[3]); o0.z = pk2(w[4], w[5]); o0.w = pk2(w[6], w[7]); o1.x = pk2(w[8], w[9]); o1.y = pk2(w[10], w[11]); o1.z = pk2(w[12], w[13]); o1.w = pk2(w[14], w[15]);
                    *(u32x4*)(T + n * 32) = o0; *(u32x4*)(T + n * 32 + 8) = o1; *(u32x4*)(T + n * 32 + 16) = (u32x4){0u, 0u, 0u, 0u}; *(u32x4*)(T + n * 32 + 24) = (u32x4){0u, 0u, 0u, 0u}; }
            }
            return; }
        else if (n0 == 1536) lim = 1552; }
    else if (d.kind == 3) { if (n0 >= 3104) return; }
    {
        const int kr = lane >> 3, c4 = (lane & 7) * 4, col = sc0 + c4;
        const bool ok = col + 3 < lim;
        f32x4 v[8]; float gg[8];
#pragma unroll
        for (int i = 0; i < 8; ++i) v[i] = ok ? __builtin_nontemporal_load((const f32x4*)(d.W + (size_t)(k0 + 8 * i + kr) * d.Nsrc + col)) : (f32x4){0.f, 0.f, 0.f, 0.f};
        if (d.g) {
#pragma unroll
            for (int i = 0; i < 8; ++i) gg[i] = d.g[k0 + 8 * i + kr];
        } else {
#pragma unroll
            for (int i = 0; i < 8; ++i) gg[i] = 1.0f;
        }
#pragma unroll
        for (int i = 0; i < 8; ++i) { LAS float* p = scr + (8 * i + kr) * 33 + c4; p[0] = v[i][0] * gg[i]; p[1] = v[i][1] * gg[i]; p[2] = v[i][2] * gg[i]; p[3] = v[i][3] * gg[i]; }
    }
    asm volatile("s_waitcnt lgkmcnt(0)" ::: "memory");
    const int c = lane & 7;
#pragma unroll
    for (int j = 0; j < 4; ++j) {
        const int n = (lane >> 3) + 8 * j; const LAS float* s = scr + (8 * c) * 33 + n;
        u32x4 o; o.x = pk2(s[0 * 33], s[1 * 33]); o.y = pk2(s[2 * 33], s[3 * 33]); o.z = pk2(s[4 * 33], s[5 * 33]); o.w = pk2(s[6 * 33], s[7 * 33]);
        pg8::st_wt16(d.WT + (size_t)(n0 + n) * d.K + k0 + 8 * c, o);
    }
    asm volatile("s_waitcnt lgkmcnt(0)" ::: "memory");
}
constexpr int I_GU = 16 * 176, I_DN = 44 * 32, I_IN = 16 * 104, I_OUT = 16 * 32;
constexpr int IT_GU = 0, IT_DN = 4 * I_GU, IT_IN = IT_DN + 4 * I_DN, IT_OUT = IT_IN + 2 * I_IN, IT_END = IT_OUT + 2 * I_OUT;
__device__ __forceinline__ void convert_items(const Args& a, LAS unsigned char* lds, int lo, int hi, int w, int nw, int wave, int lane) {
    LAS float* scr = (LAS float*)(lds + wave * 16384);
    unsigned char* ws = a.ws;
    const float* norm_g = a.in[8];
    for (int it = lo + w; it < hi; it += nw) {
        int r = it; WDesc d;
        if (r < 4 * I_GU) { const int i = r / I_GU; r -= i * I_GU;
            d = WDesc{a.in[9] + (size_t)i * DM * 2 * FF, norm_g + ((i >> 1) * 3 + (i & 1) * 2) * DM, nullptr, (bf16_t*)(ws + WS_WGU + i * SZ_WGU), DM, 2 * FF, 2 * FF, 1}; }
        else if ((r -= 4 * I_GU) < 4 * I_DN) { const int i = r / I_DN; r -= i * I_DN;
            d = WDesc{a.in[10] + (size_t)i * FF * DM, nullptr, nullptr, (bf16_t*)(ws + WS_WDN + i * SZ_WDN), FF, DM, DM, 0}; }
        else if ((r -= 4 * I_DN) < I_IN) d = WDesc{a.in[11], norm_g + 1 * DM, a.in[12], (bf16_t*)(ws + WS_WIN), DM, 3088, NIN, 2};
        else if ((r -= I_IN) < I_IN)     d = WDesc{a.in[17], norm_g + 4 * DM, nullptr, (bf16_t*)(ws + WS_WIN + SZ_WIN), DM, 3088, NIN, 3};
        else if ((r -= I_IN) < I_OUT)    d = WDesc{a.in[16], nullptr, nullptr, (bf16_t*)(ws + WS_WOUT), DM, DM, DM, 0};
        else { r -= I_OUT;               d = WDesc{a.in[19], nullptr, nullptr, (bf16_t*)(ws + WS_WOUT + SZ_WOUT), DM, DM, DM, 0}; }
        prep_item(d, r, scr, lane);
    }
}
__device__ __forceinline__ void convert_job(const Args& a, LAS unsigned char* lds, int job, int w, int nw, int wave, int lane) {
    switch (job) {
        case 0:  convert_items(a, lds, IT_GU, IT_GU + I_GU, w, nw, wave, lane); break;
        case 1:  convert_items(a, lds, IT_DN, IT_DN + I_DN, w, nw, wave, lane);
                 convert_items(a, lds, IT_IN, IT_IN + I_IN, w, nw, wave, lane);
                 convert_items(a, lds, IT_OUT, IT_OUT + I_OUT, w, nw, wave, lane);
                 convert_items(a, lds, IT_GU + I_GU, IT_GU + 2 * I_GU, w, nw, wave, lane); break;
        case 3:  convert_items(a, lds, IT_DN + I_DN, IT_DN + 2 * I_DN, w, nw, wave, lane);
                 convert_items(a, lds, IT_GU + 2 * I_GU, IT_GU + 3 * I_GU, w, nw, wave, lane); break;
        case 4:  convert_items(a, lds, IT_DN + 2 * I_DN, IT_DN + 3 * I_DN, w, nw, wave, lane);
                 convert_items(a, lds, IT_IN + I_IN, IT_IN + 2 * I_IN, w, nw, wave, lane);
                 convert_items(a, lds, IT_OUT + I_OUT, IT_OUT + 2 * I_OUT, w, nw, wave, lane);
                 convert_items(a, lds, IT_GU + 3 * I_GU, IT_GU + 4 * I_GU, w, nw, wave, lane); break;
        default: convert_items(a, lds, IT_DN + 3 * I_DN, IT_DN + 4 * I_DN, w, nw, wave, lane); break;
    }
}
__device__ __forceinline__ void p0_prologue(const Args& a, LAS unsigned char* lds, int gw, int NGW, int wave, int lane) {
    unsigned char* ws = a.ws;
    convert_job(a, lds, 0, gw, NGW, wave, lane);
    { int t9 = threadIdx.x; asm volatile("" : "+v"(t9)); lane = t9 & 63; }
    { float* pz = (float*)(ws + WS_PART + SZ_PART); for (int i = gw * 64 + lane; i < 6 * MT; i += NGW * 64) pz[i] = 0.f; }
    bf16_t* XB = (bf16_t*)(ws + WS_XB); float* part0 = (float*)(ws + WS_PART);
    for (int row = gw; row < MT; row += NGW) {
        const float* src = (row < MP) ? a.in[0] + (size_t)row * DM : a.in[1] + (size_t)(row - MP) * DM;
        float ss = 0.f;
        f32x4 xv[4];
#pragma unroll
        for (int j = 0; j < 4; ++j) xv[j] = __builtin_nontemporal_load((const f32x4*)src + lane + 64 * j);
#pragma unroll
        for (int j = 0; j < 4; ++j) {
            const f32x4 v = xv[j];
            ss += (v[0] * v[0] + v[1] * v[1]) + (v[2] * v[2] + v[3] * v[3]);
            u32x2 w; w.x = pk2(v[0], v[1]); w.y = pk2(v[2], v[3]);
            ((u32x2*)(XB + (size_t)row * DM))[lane + 64 * j] = w;
        }
        ss = wave_sum(ss, lane);
        if (lane == 0) part0[row] = ss;
    }
}
__device__ __forceinline__ void final_norm(const Args& a, int gw, int NGW, int lane) {
    const bf16_t* XB = (const bf16_t*)(a.ws + WS_XB); const float* part = (const float*)(a.ws + WS_PART + 6 * SZ_PART); const float* g = a.in[20];
    for (int row = gw; row < MT; row += NGW) {
        const float r = 1.0f / sqrtf(part[row] * (1.0f / 1024.0f) + EPS);
#pragma unroll
        for (int j = 0; j < 4; ++j) {
            const u32x2 w = ((const u32x2*)(XB + (size_t)row * DM))[lane + 64 * j]; const f32x4 gg = ((const f32x4*)g)[lane + 64 * j];
            const f32x4 v = {__builtin_bit_cast(float, w.x << 16), __builtin_bit_cast(float, w.x & 0xffff0000u), __builtin_bit_cast(float, w.y << 16), __builtin_bit_cast(float, w.y & 0xffff0000u)};
            ((f32x4*)(a.out + O_YP + (size_t)row * DM))[lane + 64 * j] = v * r * gg;
        }
    }
}
__device__ __forceinline__ float scan_incl(float v, int lane) {
#pragma unroll
    for (int o = 1; o < 64; o <<= 1) { const float t = shfl_idx(v, lane - o); if (lane >= o) v += t; }
    return v;
}
__device__ __forceinline__ float scan_incl_rev(float v, int lane) {
#pragma unroll
    for (int o = 1; o < 64; o <<= 1) { const float t = shfl_idx(v, lane + o); if (lane + o < 64) v += t; }
    return v;
}

typedef short bf16x8_t __attribute__((ext_vector_type(8)));
typedef float f32x16_t __attribute__((ext_vector_type(16)));
__device__ __forceinline__ int crow_(int r, int hi) { return (r & 3) + 8 * (r >> 2) + 4 * hi; }
template <int KS> __device__ __forceinline__ f32x16_t mma_tile(const LAS bf16_t* A, int lda, const LAS bf16_t* Bt, int ldb, f32x16_t acc, int r32, int hi, int aswz = 0, int bswz = 0) {
#pragma unroll
    for (int ks = 0; ks < KS; ++ks) {
        const bf16x8_t a = *(const LAS bf16x8_t*)(A + r32 * lda + 8 * ((2 * ks + hi) ^ aswz));
        const bf16x8_t b = *(const LAS bf16x8_t*)(Bt + r32 * ldb + 8 * ((2 * ks + hi) ^ bswz));
        acc = __builtin_amdgcn_mfma_f32_32x32x16_bf16(a, b, acc, 0, 0, 0);
    }
    return acc;
}
constexpr int G_BC = 0, G_QIN = 16384, G_KIN = 25600, G_ATT = 34816, G_VT = 44032, G_ST = 62464, G_SSQ = 80896, G_ATL = 81920, G_END = 90112;
__device__ __forceinline__ void unpack8(const u32x4 w, float (&k)[8]) {
    k[0] = __builtin_bit_cast(float, w.x << 16); k[1] = __builtin_bit_cast(float, w.x & 0xffff0000u); k[2] = __builtin_bit_cast(float, w.y << 16); k[3] = __builtin_bit_cast(float, w.y & 0xffff0000u);
    k[4] = __builtin_bit_cast(float, w.z << 16); k[5] = __builtin_bit_cast(float, w.z & 0xffff0000u); k[6] = __builtin_bit_cast(float, w.w << 16); k[7] = __builtin_bit_cast(float, w.w & 0xffff0000u);
}
template <int L> __device__ __forceinline__ void gla_bcum(LAS float* bc, const float* LOGA, size_t row0, int h, int lane) {
    float la[L];
#pragma unroll
    for (int j = 0; j < L; ++j) la[j] = LOGA[(row0 + j) * 256 + h * 64 + lane];
    float run = 0.f;
#pragma unroll
    for (int j = 0; j < L; ++j) { run += la[j]; bc[j * 64 + lane] = run; }
}
__device__ __forceinline__ void put_vt(LAS bf16_t* Vt, int ldj, int v0, int j, const u32x4 a, const u32x4 b) {
    const unsigned w[8] = {a.x, a.y, a.z, a.w, b.x, b.y, b.z, b.w};
#pragma unroll
    for (int e = 0; e < 8; ++e) { Vt[(v0 + 2 * e) * ldj + j] = (bf16_t)(w[e] & 0xffffu); Vt[(v0 + 2 * e + 1) * ldj + j] = (bf16_t)(w[e] >> 16); }
}
template <int L> __device__ __forceinline__ void gla_u_unit(LAS unsigned char* lds, const bf16_t* EB, const float* LOGA, size_t row0, int h, float* Uout, float* ATOT, const float* s0, float* sfin) {
    int tid_ = threadIdx.x; asm volatile("" : "+v"(tid_));
    const int tid = tid_, lane = tid & 63, wave = __builtin_amdgcn_readfirstlane(tid >> 6), r32 = lane & 31, hi = lane >> 5;
    constexpr int LDJ = L + 8;
    LAS float* bc = (LAS float*)(lds + G_BC); LAS bf16_t* KsT = (LAS bf16_t*)(lds + G_KIN); LAS bf16_t* Vt = (LAS bf16_t*)(lds + G_VT);
    if (wave == 0) gla_bcum<L>(bc, LOGA, row0, h, lane);
    __syncthreads();
    {
        const int j = tid >> 3, c8 = tid & 7;
        if (j < L) {
            const size_t row = row0 + j;
            float kf[8]; unpack8(*(const u32x4*)(EB + row * NIN + 256 + h * 64 + 8 * c8), kf);
            const f32x4 b0 = *(const LAS f32x4*)(bc + j * 64 + 8 * c8), b1 = *(const LAS f32x4*)(bc + j * 64 + 8 * c8 + 4);
            const f32x4 l0 = *(const LAS f32x4*)(bc + (L - 1) * 64 + 8 * c8), l1 = *(const LAS f32x4*)(bc + (L - 1) * 64 + 8 * c8 + 4);
#pragma unroll
            for (int e = 0; e < 4; ++e) {
                KsT[(8 * c8 + e) * LDJ + j] = (bf16_t)f2bf(kf[e] * __expf(l0[e] - b0[e]));
                KsT[(8 * c8 + 4 + e) * LDJ + j] = (bf16_t)f2bf(kf[4 + e] * __expf(l1[e] - b1[e]));
            }
            const u32x4 va = *(const u32x4*)(EB + row * NIN + 512 + h * 128 + 16 * c8), vb = *(const u32x4*)(EB + row * NIN + 512 + h * 128 + 16 * c8 + 8);
            put_vt(Vt, LDJ, 16 * c8, j, va, vb);
        }
    }
    __syncthreads();
    const int kt = wave >> 2, vt = wave & 3;
    f32x16_t acc = {};
    acc = mma_tile<L / 16>(KsT + 32 * kt * LDJ, LDJ, Vt + 32 * vt * LDJ, LDJ, acc, r32, hi);
#pragma unroll
    for (int r = 0; r < 16; ++r) {
        const int k = 32 * kt + crow_(r, hi), v = 32 * vt + r32;
        if (s0 == nullptr) Uout[k * 128 + v] = acc[r];
        else sfin[k * 128 + v] = __expf(bc[(L - 1) * 64 + k]) * s0[k * 128 + v] + acc[r];
    }
    if (s0 == nullptr && tid < 64) ATOT[tid] = __expf(bc[(L - 1) * 64 + tid]);
    __syncthreads();
}
template <int L> __device__ __forceinline__ void gla_o_unit(LAS unsigned char* lds, const bf16_t* EB, const float* LOGA, size_t row0, int h, int n, const float* Ub, const float* Ab, const float* s0,
                                                            const float* gnorm, bf16_t* OAB, float* pstate) {
    int tid_ = threadIdx.x; asm volatile("" : "+v"(tid_));
    const int tid = tid_, lane = tid & 63, wave = __builtin_amdgcn_readfirstlane(tid >> 6), r32 = lane & 31, hi = lane >> 5;
    constexpr int LDJ = L + 8, NIT = (L + 31) / 32, LDK = 72;
    LAS float* bc = (LAS float*)(lds + G_BC); LAS bf16_t* Qin = (LAS bf16_t*)(lds + G_QIN); LAS bf16_t* Kin = (LAS bf16_t*)(lds + G_KIN); LAS bf16_t* att = (LAS bf16_t*)(lds + G_ATT);
    LAS bf16_t* Vt = (LAS bf16_t*)(lds + G_VT); LAS bf16_t* St = (LAS bf16_t*)(lds + G_ST); LAS float* ssq = (LAS float*)(lds + G_SSQ); LAS float* atl = (LAS float*)(lds + G_ATL);
    if (wave == 0) gla_bcum<L>(bc, LOGA, row0, h, lane);
    const int nat = s0 ? 0 : (pstate ? n + 1 : n);
    for (int i = tid; i < nat * 64; i += 512) atl[i] = Ab[i];
    __syncthreads();
    {
        float S[16];
        const int k0 = tid >> 7, v = tid & 127;
        if (s0) {
#pragma unroll
            for (int i = 0; i < 16; ++i) S[i] = s0[tid + 512 * i];
        } else {
#pragma unroll
            for (int i = 0; i < 16; ++i) S[i] = 0.f;
            for (int m = 0; m < n; ++m) {
                const float* um = Ub + (size_t)m * 8192 + tid;
#pragma unroll
                for (int i = 0; i < 16; ++i) S[i] = atl[m * 64 + k0 + 4 * i] * S[i] + um[512 * i];
            }
            if (pstate) {
                const float* um = Ub + (size_t)n * 8192 + tid;
#pragma unroll
                for (int i = 0; i < 16; ++i) pstate[tid + 512 * i] = atl[n * 64 + k0 + 4 * i] * S[i] + um[512 * i];
            }
        }
#pragma unroll
        for (int i = 0; i < 16; ++i) St[v * LDK + k0 + 4 * i] = (bf16_t)f2bf(S[i]);
    }
    {
        const int j = tid >> 3, c8 = tid & 7;
        if (j < L) {
            const size_t row = row0 + j;
            float qf[8], kf[8]; unpack8(*(const u32x4*)(EB + row * NIN + h * 64 + 8 * c8), qf); unpack8(*(const u32x4*)(EB + row * NIN + 256 + h * 64 + 8 * c8), kf);
            const f32x4 b0 = *(const LAS f32x4*)(bc + j * 64 + 8 * c8), b1 = *(const LAS f32x4*)(bc + j * 64 + 8 * c8 + 4);
            float qi[8], ki[8];
#pragma unroll
            for (int e = 0; e < 4; ++e) { const float e0 = __expf(b0[e]), e1 = __expf(b1[e]); qi[e] = qf[e] * e0; qi[4 + e] = qf[4 + e] * e1; ki[e] = kf[e] * __builtin_amdgcn_rcpf(e0); ki[4 + e] = kf[4 + e] * __builtin_amdgcn_rcpf(e1); }
            u32x4 qw, kw; qw.x = pk2(qi[0], qi[1]); qw.y = pk2(qi[2], qi[3]); qw.z = pk2(qi[4], qi[5]); qw.w = pk2(qi[6], qi[7]);
            kw.x = pk2(ki[0], ki[1]); kw.y = pk2(ki[2], ki[3]); kw.z = pk2(ki[4], ki[5]); kw.w = pk2(ki[6], ki[7]);
            *(LAS u32x4*)(Qin + j * LDK + 8 * c8) = qw; *(LAS u32x4*)(Kin + j * LDK + 8 * c8) = kw;
            const u32x4 va = *(const u32x4*)(EB + row * NIN + 512 + h * 128 + 16 * c8), vb = *(const u32x4*)(EB + row * NIN + 512 + h * 128 + 16 * c8 + 8);
            put_vt(Vt, LDJ, 16 * c8, j, va, vb);
        } else if (j < 32 * NIT) {
            const u32x4 z = {0u, 0u, 0u, 0u};
            *(LAS u32x4*)(Qin + j * LDK + 8 * c8) = z; *(LAS u32x4*)(Kin + j * LDK + 8 * c8) = z;
        }
    }
    __syncthreads();
    const int vt = wave >> 1, it = wave & 1;
    f32x16_t acc = {};
    if (it < NIT) acc = mma_tile<4>(St + 32 * vt * LDK, LDK, Qin + 32 * it * LDK, LDK, acc, r32, hi);
    if (wave < NIT * NIT) {
        const int ti = wave / NIT, tj = wave % NIT;
        f32x16_t s = {};
        s = mma_tile<4>(Qin + 32 * ti * LDK, LDK, Kin + 32 * tj * LDK, LDK, s, r32, hi);
        const int j = 32 * tj + r32;
        if (j < L) {
#pragma unroll
            for (int r = 0; r < 16; ++r) { const int i = 32 * ti + crow_(r, hi); att[i * LDJ + j] = (bf16_t)f2bf(i >= j ? s[r] : 0.f); }
        }
    }
    __syncthreads();
    if (it < NIT) acc = mma_tile<L / 16>(Vt + 32 * vt * LDJ, LDJ, att + 32 * it * LDJ, LDJ, acc, r32, hi);
    {
        float ss = 0.f;
#pragma unroll
        for (int r = 0; r < 16; ++r) ss += acc[r] * acc[r];
        ss += shfl_idx(ss, lane ^ 32);
        if (it < NIT && hi == 0) ssq[vt * 64 + 32 * it + r32] = ss;
    }
    u32x2 gwv[4]; f32x4 gnv[4];
#pragma unroll
    for (int gq = 0; gq < 4; ++gq) { const int v0 = 32 * vt + 8 * gq + 4 * hi; const int ic = (32 * it + r32 < L) ? 32 * it + r32 : 0;
        gwv[gq] = *(const u32x2*)(EB + (row0 + ic) * NIN + 1024 + h * 128 + v0); gnv[gq] = *(const f32x4*)(gnorm + v0); }
    __syncthreads();
    if (it < NIT) {
        const int i = 32 * it + r32;
        if (i < L) {
            const float tot = (ssq[i] + ssq[64 + i]) + (ssq[128 + i] + ssq[192 + i]);
            const float rr = __builtin_amdgcn_rsqf(tot * (1.0f / 128.0f) + EPS);
            const size_t row = row0 + i;
#pragma unroll
            for (int g = 0; g < 4; ++g) {
                const int v0 = 32 * vt + 8 * g + 4 * hi;
                const u32x2 gw = gwv[g]; const f32x4 gn = gnv[g];
                const float o0 = acc[4 * g + 0] * rr * gn[0] * __builtin_bit_cast(float, gw.x << 16), o1 = acc[4 * g + 1] * rr * gn[1] * __builtin_bit_cast(float, gw.x & 0xffff0000u);
                const float o2 = acc[4 * g + 2] * rr * gn[2] * __builtin_bit_cast(float, gw.y << 16), o3 = acc[4 * g + 3] * rr * gn[3] * __builtin_bit_cast(float, gw.y & 0xffff0000u);
                u32x2 ow; ow.x = pk2(o0, o1); ow.y = pk2(o2, o3);
                *(u32x2*)(OAB + row * DM + h * 128 + v0) = ow;
            }
        }
    }
    __syncthreads();
}

__device__ __forceinline__ void gla_m1_group(LAS unsigned char* lds, const bf16_t* EB, const float* LOGA, int bh, int g4, bf16_t* QIN, bf16_t* KIN, float* GU, float* GA, float* GT, float* GAG) {
    int tid_ = threadIdx.x; asm volatile("" : "+v"(tid_));
    const int tid = tid_, lane = tid & 63, wave = __builtin_amdgcn_readfirstlane(tid >> 6), r32 = lane & 31, hi = lane >> 5;
    constexpr int LDJ = 72;
    LAS float* bc = (LAS float*)(lds + G_BC); LAS bf16_t* KsT = (LAS bf16_t*)(lds + G_KIN); LAS bf16_t* Vt = (LAS bf16_t*)(lds + G_VT); LAS float* tot = (LAS float*)(lds + G_ATL);
    const int b = bh >> 2, h = bh & 3, kt = wave >> 2, vt = wave & 3;
    const int j = tid >> 3, c8 = tid & 7;
    const int jsw = (((j >> 3) ^ c8) << 3) | (j & 7);
    f32x16_t T = {};
    float blsum = 0.f;
    struct In { float la[8]; u32x4 q, k, va, vb; };
    auto load_in = [&](In& s, int n) {
        const size_t row0 = (size_t)b * TSEQ + 64 * n, row = row0 + j;
#pragma unroll
        for (int i = 0; i < 8; ++i) s.la[i] = LOGA[(row0 + 8 * wave + i) * 256 + h * 64 + lane];
        s.q = *(const u32x4*)(EB + row * NIN + h * 64 + 8 * c8); s.k = *(const u32x4*)(EB + row * NIN + 256 + h * 64 + 8 * c8);
        s.va = *(const u32x4*)(EB + row * NIN + 512 + h * 128 + 16 * c8); s.vb = *(const u32x4*)(EB + row * NIN + 512 + h * 128 + 16 * c8 + 8);
    };
    In in[2];
    load_in(in[0], 4 * g4);
#pragma unroll
    for (int c = 0; c < 4; ++c) {
        In& s = in[c & 1];
        const int n = 4 * g4 + c; const size_t row0 = (size_t)b * TSEQ + 64 * n;
        {
            float run = 0.f;
#pragma unroll
            for (int i = 0; i < 8; ++i) { run += s.la[i]; s.la[i] = run; }
            tot[wave * 64 + lane] = run;
            __syncthreads();
            float off = 0.f;
            for (int w2 = 0; w2 < wave; ++w2) off += tot[w2 * 64 + lane];
#pragma unroll
            for (int i = 0; i < 8; ++i) bc[(8 * wave + i) * 64 + lane] = s.la[i] + off;
        }
        __syncthreads();
        {
            const size_t row = row0 + j;
            float qf[8], kf[8]; unpack8(s.q, qf); unpack8(s.k, kf);
            const f32x4 b0 = *(const LAS f32x4*)(bc + j * 64 + 8 * c8), b1 = *(const LAS f32x4*)(bc + j * 64 + 8 * c8 + 4);
            const f32x4 l0 = *(const LAS f32x4*)(bc + 63 * 64 + 8 * c8), l1 = *(const LAS f32x4*)(bc + 63 * 64 + 8 * c8 + 4);
            float qi[8], ki[8];
#pragma unroll
            for (int e = 0; e < 4; ++e) {
                const float e0 = __expf(b0[e]), e1 = __expf(b1[e]), r0 = __builtin_amdgcn_rcpf(e0), r1 = __builtin_amdgcn_rcpf(e1);
                qi[e] = qf[e] * e0; qi[4 + e] = qf[4 + e] * e1; ki[e] = kf[e] * r0; ki[4 + e] = kf[4 + e] * r1;
                KsT[(8 * c8 + e) * LDJ + jsw] = (bf16_t)f2bf(ki[e] * __expf(l0[e])); KsT[(8 * c8 + 4 + e) * LDJ + jsw] = (bf16_t)f2bf(ki[4 + e] * __expf(l1[e]));
            }
            u32x4 qw, kw; qw.x = pk2(qi[0], qi[1]); qw.y = pk2(qi[2], qi[3]); qw.z = pk2(qi[4], qi[5]); qw.w = pk2(qi[6], qi[7]);
            kw.x = pk2(ki[0], ki[1]); kw.y = pk2(ki[2], ki[3]); kw.z = pk2(ki[4], ki[5]); kw.w = pk2(ki[6], ki[7]);
            *(u32x4*)(QIN + row * 256 + h * 64 + 8 * c8) = qw; *(u32x4*)(KIN + row * 256 + h * 64 + 8 * c8) = kw;
            put_vt(Vt, LDJ, 16 * c8, jsw, s.va, s.vb);
        }
        if (c < 3) load_in(in[(c + 1) & 1], n + 1);
        __syncthreads();
        {
            f32x16_t acc = {};
            acc = mma_tile<4>(KsT + 32 * kt * LDJ, LDJ, Vt + 32 * vt * LDJ, LDJ, acc, r32, hi, (4 * kt + (r32 >> 3)) & 7, (2 * vt + (r32 >> 4)) & 7);
            float* Un = GU + (size_t)(bh * 32 + n) * 8192;
#pragma unroll
            for (int r = 0; r < 16; ++r) {
                const int k = 32 * kt + crow_(r, hi), v = 32 * vt + r32;
                Un[k * 128 + v] = acc[r];
                T[r] = __expf(bc[63 * 64 + k]) * T[r] + acc[r];
            }
            if (tid < 64) { const float bl = bc[63 * 64 + tid]; GA[(size_t)(bh * 32 + n) * 64 + tid] = __expf(bl); blsum += bl; }
        }
        __syncthreads();
    }
    {
        float* Tg = GT + (size_t)(bh * 8 + g4) * 8192;
#pragma unroll
        for (int r = 0; r < 16; ++r) __hip_atomic_store(Tg + (32 * kt + crow_(r, hi)) * 128 + 32 * vt + r32, T[r], __ATOMIC_RELAXED, __HIP_MEMORY_SCOPE_AGENT);
        if (tid < 64) __hip_atomic_store(GAG + (size_t)(bh * 8 + g4) * 64 + tid, __expf(blsum), __ATOMIC_RELAXED, __HIP_MEMORY_SCOPE_AGENT);
    }
}
__device__ __forceinline__ void gla_m2_group(LAS unsigned char* lds, const bf16_t* EB, int bh, int g4, const bf16_t* QIN, const bf16_t* KIN, const float* GU, const float* GA, const float* GT, const float* GAG,
                                             const float* gnorm, bf16_t* OAB, float* pstate) {
    int tid_ = threadIdx.x; asm volatile("" : "+v"(tid_));
    const int tid = tid_, lane = tid & 63, wave = __builtin_amdgcn_readfirstlane(tid >> 6), r32 = lane & 31, hi = lane >> 5;
    constexpr int LDJ = 72, LDK = 72;
    LAS bf16_t* Qin = (LAS bf16_t*)(lds + G_QIN); LAS bf16_t* Kin = (LAS bf16_t*)(lds + G_KIN); LAS bf16_t* att = (LAS bf16_t*)(lds + G_ATT);
    LAS bf16_t* Vt = (LAS bf16_t*)(lds + G_VT); LAS bf16_t* St = (LAS bf16_t*)(lds + G_ST); LAS float* ssq = (LAS float*)(lds + G_SSQ); LAS float* atl = (LAS float*)(lds + G_ATL);
    const int b = bh >> 2, h = bh & 3, k0 = 16 * (tid >> 7), v = tid & 127, vt = wave >> 1, it = wave & 1;
    const int j = tid >> 3, c8 = tid & 7, jsw = (((j >> 3) ^ c8) << 3) | (j & 7);
    struct In { float un[16]; u32x4 q, k, va, vb; u32x2 gw[4]; };
    auto load_in = [&](In& s, int n) {
        const size_t row0 = (size_t)b * TSEQ + 64 * n, row = row0 + j;
        s.q = *(const u32x4*)(QIN + row * 256 + h * 64 + 8 * c8); s.k = *(const u32x4*)(KIN + row * 256 + h * 64 + 8 * c8);
        s.va = *(const u32x4*)(EB + row * NIN + 512 + h * 128 + 16 * c8); s.vb = *(const u32x4*)(EB + row * NIN + 512 + h * 128 + 16 * c8 + 8);
#pragma unroll
        for (int g = 0; g < 4; ++g) s.gw[g] = *(const u32x2*)(EB + (row0 + 32 * it + r32) * NIN + 1024 + h * 128 + 32 * vt + 8 * g + 4 * hi);
        const float* up = GU + (size_t)(bh * 32 + n) * 8192 + k0 * 128 + v;
#pragma unroll
        for (int i = 0; i < 16; ++i) s.un[i] = up[128 * i];
    };
    In in[2];
    load_in(in[0], 4 * g4);
    f32x4 gnv[4];
#pragma unroll
    for (int g = 0; g < 4; ++g) gnv[g] = *(const f32x4*)(gnorm + 32 * vt + 8 * g + 4 * hi);
    for (int i = tid; i < g4 * 64; i += 512) atl[i] = GAG[(size_t)bh * 8 * 64 + i];
    for (int i = tid; i < 4 * 64; i += 512) atl[g4 * 64 + i] = GA[(size_t)(bh * 32 + 4 * g4) * 64 + i];
    __syncthreads();
    float S[16];
#pragma unroll
    for (int i = 0; i < 16; ++i) S[i] = 0.f;
    for (int g = 0; g < g4; ++g) {
        const float* tg = GT + (size_t)(bh * 8 + g) * 8192 + k0 * 128 + v;
        float tgv[16];
#pragma unroll
        for (int i = 0; i < 16; ++i) tgv[i] = tg[128 * i];
#pragma unroll
        for (int i = 0; i < 16; ++i) S[i] = atl[g * 64 + k0 + i] * S[i] + tgv[i];
    }
#pragma unroll
    for (int c = 0; c < 4; ++c) {
        In& s = in[c & 1];
        const int n = 4 * g4 + c; const size_t row0 = (size_t)b * TSEQ + 64 * n;
        { u32x4 w0, w1; w0.x = pk2(S[0], S[1]); w0.y = pk2(S[2], S[3]); w0.z = pk2(S[4], S[5]); w0.w = pk2(S[6], S[7]);
          w1.x = pk2(S[8], S[9]); w1.y = pk2(S[10], S[11]); w1.z = pk2(S[12], S[13]); w1.w = pk2(S[14], S[15]);
          *(LAS u32x4*)(St + v * LDK + k0) = w0; *(LAS u32x4*)(St + v * LDK + k0 + 8) = w1; }
        *(LAS u32x4*)(Qin + j * LDK + 8 * c8) = s.q; *(LAS u32x4*)(Kin + j * LDK + 8 * c8) = s.k;
        put_vt(Vt, LDJ, 16 * c8, jsw, s.va, s.vb);
        if (c < 3) load_in(in[(c + 1) & 1], n + 1);
        __syncthreads();
        f32x16_t acc = {};
        acc = mma_tile<4>(St + 32 * vt * LDK, LDK, Qin + 32 * it * LDK, LDK, acc, r32, hi);
        if (wave < 4) {
            const int ti = wave >> 1, tj = wave & 1;
            f32x16_t sc = {};
            sc = mma_tile<4>(Qin + 32 * ti * LDK, LDK, Kin + 32 * tj * LDK, LDK, sc, r32, hi);
            const int jj = 32 * tj + r32;
#pragma unroll
            for (int r = 0; r < 16; ++r) { const int i = 32 * ti + crow_(r, hi); att[i * LDJ + jj] = (bf16_t)f2bf(i >= jj ? sc[r] : 0.f); }
        }
        __syncthreads();
        acc = mma_tile<4>(Vt + 32 * vt * LDJ, LDJ, att + 32 * it * LDJ, LDJ, acc, r32, hi, (2 * vt + (r32 >> 4)) & 7, 0);
        {
            float ss = 0.f;
#pragma unroll
            for (int r = 0; r < 16; ++r) ss += acc[r] * acc[r];
            ss += shfl_idx(ss, lane ^ 32);
            if (hi == 0) ssq[vt * 64 + 32 * it + r32] = ss;
        }
        __syncthreads();
        {
            const int i = 32 * it + r32;
            const float tot = (ssq[i] + ssq[64 + i]) + (ssq[128 + i] + ssq[192 + i]);
            const float rr = __builtin_amdgcn_rsqf(tot * (1.0f / 128.0f) + EPS);
            const size_t row = row0 + i;
#pragma unroll
            for (int g = 0; g < 4; ++g) {
                const int v0 = 32 * vt + 8 * g + 4 * hi;
                const u32x2 gw = s.gw[g];
                const f32x4 gn = gnv[g];
                const float o0 = acc[4 * g + 0] * rr * gn[0] * __builtin_bit_cast(float, gw.x << 16), o1 = acc[4 * g + 1] * rr * gn[1] * __builtin_bit_cast(float, gw.x & 0xffff0000u);
                const float o2 = acc[4 * g + 2] * rr * gn[2] * __builtin_bit_cast(float, gw.y << 16), o3 = acc[4 * g + 3] * rr * gn[3] * __builtin_bit_cast(float, gw.y & 0xffff0000u);
                u32x2 ow; ow.x = pk2(o0, o1); ow.y = pk2(o2, o3);
                *(u32x2*)(OAB + row * DM + h * 128 + v0) = ow;
            }
        }
#pragma unroll
        for (int i = 0; i < 16; ++i) S[i] = atl[(g4 + c) * 64 + k0 + i] * S[i] + s.un[i];
    }
    if (pstate) {
#pragma unroll
        for (int i = 0; i < 16; ++i) pstate[(k0 + i) * 128 + v] = S[i];
    }
    __syncthreads();
}

constexpr int SA_CB = 0, SA_OW = 16384, SA_MW = 81920, SA_LW = 82944, SA_FQ = 83968, SA_TOT = 84096, SA_END = 84224;
constexpr float FOX_SKIP2 = 160.0f * LOG2E;
template <int MODE> __device__ __forceinline__ void sample_attn_unit(LAS unsigned char* lds, const bf16_t* EB, int qcol, int kcol, int vcol, const float* ck, const float* cv, int kstr, int Lc,
                                                                       int b, int h, const float* clf  , const float* LOGF, const float* relb, bf16_t* OAB, int ocol) {
    int tid_ = threadIdx.x; asm volatile("" : "+v"(tid_));
    const int tid = tid_, lane = tid & 63, wave = __builtin_amdgcn_readfirstlane(tid >> 6), r32 = lane & 31, hi = lane >> 5;
    const size_t row0 = (size_t)MP + b * SSEQ;
    LAS float* cb = (LAS float*)(lds + SA_CB); LAS float* ow = (LAS float*)(lds + SA_OW); LAS float* mw = (LAS float*)(lds + SA_MW); LAS float* lw = (LAS float*)(lds + SA_LW);
    LAS float* fqb = (LAS float*)(lds + SA_FQ); LAS float* tot = (LAS float*)(lds + SA_TOT);
    if (MODE == 0) {
        float carry = 0.f;
        float lfv[8];
#pragma unroll
        for (int c = 0; c < 8; ++c) lfv[c] = clf[(size_t)(512 * wave + 64 * c + lane) * 16 + h];
#pragma unroll
        for (int c = 7; c >= 0; --c) {
            const int key = 512 * wave + 64 * c + lane;
            const float lf = lfv[c];
            const float suf = scan_incl_rev(lf, lane);
            cb[key] = carry + suf - lf;
            carry += lane_bcast(suf, 0);
        }
        if (lane == 0) tot[wave] = carry;
        if (wave == 0) { const float lf = (lane < 16) ? LOGF[(row0 + lane) * 16 + h] : 0.f; const float fq = scan_incl(lf, lane); if (lane < 16) fqb[lane] = -fq * LOG2E; }
        __syncthreads();
        float off = 0.f;
        for (int w2 = wave + 1; w2 < 8; ++w2) off += tot[w2];
        for (int c = 0; c < 8; ++c) { const int key = 512 * wave + 64 * c + lane; cb[key] = (cb[key] + off) * LOG2E; }
    } else {
        for (int x = tid; x < 320; x += NWAVES * 64) cb[x] = relb[h * 257 + (x < 256 ? x : 256)] * LOG2E;
    }
    __syncthreads();
    int s_first = 0;
    if (MODE == 0) {
        LAS int* smin = (LAS int*)(lds + SA_TOT + 64);
        if (tid == 0) *smin = Lc / 32 - 1;
        __syncthreads();
        if (tid < Lc / 32 && cb[32 * tid + 31] >= -FOX_SKIP2) atomicMin((int*)smin, tid);
        __syncthreads();
        s_first = __builtin_amdgcn_readfirstlane(*smin);
    }
    bf16x8_t qf[4];
#pragma unroll
    for (int ds = 0; ds < 4; ++ds) qf[ds] = *(const bf16x8_t*)(EB + (row0 + (r32 & 15)) * NIN + qcol + h * 64 + 16 * ds + 8 * hi);
    float m = -INFINITY, l = 0.f; f32x16_t o0 = {}, o1 = {};
    const int q = r32;
    auto softmax_pv = [&](f32x16_t s, const bf16x8_t (&vf)[2][2]) {
        float mx = s[0];
#pragma unroll
        for (int r = 1; r < 16; ++r) mx = fmaxf(mx, s[r]);
        mx = fmaxf(mx, shfl_idx(mx, lane ^ 32));
        const float mn = fmaxf(m, mx), alpha = __builtin_amdgcn_exp2f(m - mn);
        float ps = 0.f; float p[16];
#pragma unroll
        for (int r = 0; r < 16; ++r) { p[r] = __builtin_amdgcn_exp2f(s[r] - mn); ps += p[r]; }
        l = l * alpha + ps; m = mn;
#pragma unroll
        for (int r = 0; r < 16; ++r) { o0[r] *= alpha; o1[r] *= alpha; }
        u32x4 w0, w1; w0.x = pk2(p[0], p[1]); w0.y = pk2(p[2], p[3]); w0.z = pk2(p[4], p[5]); w0.w = pk2(p[6], p[7]);
        w1.x = pk2(p[8], p[9]); w1.y = pk2(p[10], p[11]); w1.z = pk2(p[12], p[13]); w1.w = pk2(p[14], p[15]);
        const bf16x8_t pf0 = __builtin_bit_cast(bf16x8_t, w0), pf1 = __builtin_bit_cast(bf16x8_t, w1);
        o0 = __builtin_amdgcn_mfma_f32_32x32x16_bf16(vf[0][0], pf0, o0, 0, 0, 0); o0 = __builtin_amdgcn_mfma_f32_32x32x16_bf16(vf[0][1], pf1, o0, 0, 0, 0);
        o1 = __builtin_amdgcn_mfma_f32_32x32x16_bf16(vf[1][0], pf0, o1, 0, 0, 0); o1 = __builtin_amdgcn_mfma_f32_32x32x16_bf16(vf[1][1], pf1, o1, 0, 0, 0);
    };
    const int n_sub = Lc / 32 - s_first;
    const int NS = (((n_sub + 7) >> 3) + 1) & ~1;
    auto load_kv = [&](f32x4 (&ka)[4][2], float (&vv)[2][2][8], int key0) {
        const float* kp = ck + (size_t)(key0 + r32) * kstr + 8 * hi;
#pragma unroll
        for (int ds = 0; ds < 4; ++ds) { ka[ds][0] = *(const f32x4*)(kp + 16 * ds); ka[ds][1] = *(const f32x4*)(kp + 16 * ds + 4); }
#pragma unroll
        for (int db = 0; db < 2; ++db)
#pragma unroll
            for (int ks = 0; ks < 2; ++ks)
#pragma unroll
                for (int j = 0; j < 8; ++j) vv[db][ks][j] = cv[(size_t)(key0 + 16 * ks + 8 * (j >> 2) + 4 * hi + (j & 3)) * kstr + 32 * db + r32];
    };
    auto step = [&](const f32x4 (&ka)[4][2], const float (&vv)[2][2][8], int key0) {
        f32x16_t s = {};
#pragma unroll
        for (int ds = 0; ds < 4; ++ds) {
            u32x4 w; w.x = pk2(ka[ds][0][0], ka[ds][0][1]); w.y = pk2(ka[ds][0][2], ka[ds][0][3]); w.z = pk2(ka[ds][1][0], ka[ds][1][1]); w.w = pk2(ka[ds][1][2], ka[ds][1][3]);
            s = __builtin_amdgcn_mfma_f32_32x32x16_bf16(__builtin_bit_cast(bf16x8_t, w), qf[ds], s, 0, 0, 0);
        }
        bf16x8_t vf[2][2];
#pragma unroll
        for (int db = 0; db < 2; ++db)
#pragma unroll
            for (int ks = 0; ks < 2; ++ks) { u32x4 w; w.x = pk2(vv[db][ks][0], vv[db][ks][1]); w.y = pk2(vv[db][ks][2], vv[db][ks][3]); w.z = pk2(vv[db][ks][4], vv[db][ks][5]); w.w = pk2(vv[db][ks][6], vv[db][ks][7]);
                vf[db][ks] = __builtin_bit_cast(bf16x8_t, w); }
        if (MODE == 0) {
#pragma unroll
            for (int g = 0; g < 4; ++g) { const f32x4 bb = *(const LAS f32x4*)(cb + key0 + 8 * g + 4 * hi);
#pragma unroll
                for (int e = 0; e < 4; ++e) s[4 * g + e] += bb[e]; }
        } else {
#pragma unroll
            for (int r = 0; r < 16; ++r) { const int ix = (Lc - (key0 + crow_(r, hi))) + (q & 15) + 128; s[r] += cb[ix > 256 ? 256 : ix]; }
        }
        softmax_pv(s, vf);
    };
    {
        f32x4 kaA[4][2], kaB[4][2]; float vvA[2][2][8], vvB[2][2][8];
        const int kbase = 32 * (s_first + wave * NS);
        if (kbase < Lc) load_kv(kaA, vvA, kbase);
        for (int sub = 0; sub < NS; sub += 2) {
            const int kA = kbase + 32 * sub, kB = kA + 32, kC = kA + 64;
            if (kB < Lc) load_kv(kaB, vvB, kB);
            if (kA < Lc) step(kaA, vvA, kA);
            if (sub + 2 < NS && kC < Lc) load_kv(kaA, vvA, kC);
            if (kB < Lc) step(kaB, vvB, kB);
        }
    }
    if (wave == 0) {
        f32x16_t s = {};
#pragma unroll
        for (int ds = 0; ds < 4; ++ds) { const bf16x8_t kf = *(const bf16x8_t*)(EB + (row0 + (r32 & 15)) * NIN + kcol + h * 64 + 16 * ds + 8 * hi); s = __builtin_amdgcn_mfma_f32_32x32x16_bf16(kf, qf[ds], s, 0, 0, 0); }
        bf16x8_t vf[2][2];
#pragma unroll
        for (int db = 0; db < 2; ++db)
#pragma unroll
            for (int ks = 0; ks < 2; ++ks) { bf16x8_t t;
#pragma unroll
                for (int j = 0; j < 8; ++j) t[j] = (short)EB[(row0 + ((16 * ks + 8 * (j >> 2) + 4 * hi + (j & 3)) & 15)) * NIN + vcol + h * 64 + 32 * db + r32];
                vf[db][ks] = t; }
#pragma unroll
        for (int r = 0; r < 16; ++r) {
            const int kn = crow_(r, hi);
            float bias;
            if (MODE == 0) bias = (kn < 16 && kn <= (q & 15)) ? fqb[kn & 15] : -INFINITY;
            else bias = (kn < 16) ? cb[(q & 15) - (kn & 15) + 128] : -INFINITY;
            s[r] += bias;
        }
        softmax_pv(s, vf);
    }
    {
        const float lt = l + shfl_idx(l, lane ^ 32);
        if (hi == 0) { mw[wave * 32 + q] = m; lw[wave * 32 + q] = lt; }
#pragma unroll
        for (int r = 0; r < 16; ++r) { ow[(wave * 64 + crow_(r, hi)) * 32 + q] = o0[r]; ow[(wave * 64 + 32 + crow_(r, hi)) * 32 + q] = o1[r]; }
    }
    __syncthreads();
    {
        const int qq = tid & 15, d0 = tid >> 4;
        float mm = mw[qq];
#pragma unroll
        for (int w = 1; w < 8; ++w) mm = fmaxf(mm, mw[w * 32 + qq]);
        float lt = 0.f, a0 = 0.f, a1 = 0.f;
#pragma unroll
        for (int w = 0; w < 8; ++w) { const float sc = __builtin_amdgcn_exp2f(mw[w * 32 + qq] - mm); lt += sc * lw[w * 32 + qq]; a0 += sc * ow[(w * 64 + d0) * 32 + qq]; a1 += sc * ow[(w * 64 + 32 + d0) * 32 + qq]; }
        const float inv = 1.0f / lt;
        OAB[(row0 + qq) * DM + ocol + h * 64 + d0] = (bf16_t)f2bf(a0 * inv); OAB[(row0 + qq) * DM + ocol + h * 64 + 32 + d0] = (bf16_t)f2bf(a1 * inv);
    }
    __syncthreads();
}

__device__ __forceinline__ void mini_gemm_unit(LAS unsigned char* lds, const bf16_t* A, const bf16_t* Bt, int K, int rb, int cbk, const float* xold, unsigned char* ws, int pout, float coef, const float* fin_gain, float* fin_out) {
    int tid_ = threadIdx.x; asm volatile("" : "+v"(tid_));
    const int tid = tid_, lane = tid & 63, wave = __builtin_amdgcn_readfirstlane(tid >> 6), r32 = lane & 31, hi = lane >> 5;
    const int kw = K >> 3;
    const bf16_t* ap = A + (size_t)(32 * rb + r32) * K + wave * kw + 8 * hi;
    const bf16_t* bp = Bt + (size_t)(32 * cbk + r32) * K + wave * kw + 8 * hi;
    f32x16_t acc0 = {};
    const int nks = kw / 16;
    for (int k0 = 0; k0 < nks; k0 += 12) {
        bf16x8_t a[12], b[12];
#pragma unroll
        for (int s = 0; s < 12; ++s) if (k0 + s < nks) { a[s] = *(const bf16x8_t*)(ap + 16 * (k0 + s)); b[s] = *(const bf16x8_t*)(bp + 16 * (k0 + s)); }
#pragma unroll
        for (int s = 0; s < 12; ++s) if (k0 + s < nks) acc0 = __builtin_amdgcn_mfma_f32_32x32x16_bf16(a[s], b[s], acc0, 0, 0, 0);
    }
    LAS float* red = (LAS float*)lds;
#pragma unroll
    for (int r = 0; r < 16; ++r) red[(wave * 32 + crow_(r, hi)) * 32 + r32] = acc0[r];
    __syncthreads();
    {
        const int row = tid >> 4, c2 = (tid & 15) * 2;
        typedef float f32x2_m __attribute__((ext_vector_type(2)));
        f32x2_m s = *(const LAS f32x2_m*)(red + row * 32 + c2);
#pragma unroll
        for (int w = 1; w < 8; ++w) s += *(const LAS f32x2_m*)(red + (w * 32 + row) * 32 + c2);
        const int grow = 32 * rb + row, col = 32 * cbk + c2;
        bf16_t* XB = (bf16_t*)(ws + WS_XB) + (size_t)(MP + grow) * DM + col;
        f32x2_m xo;
        if (xold) xo = *(const f32x2_m*)(xold + (size_t)grow * DM + col);
        else { const unsigned w = *(const unsigned*)XB; xo = (f32x2_m){__builtin_bit_cast(float, w << 16), __builtin_bit_cast(float, w & 0xffff0000u)}; }
        const f32x2_m xn = xo + s * coef;
        if (!fin_gain) *(unsigned*)XB = pk2(xn[0], xn[1]);
        float ss = xn[0] * xn[0] + xn[1] * xn[1];
        ss += shfl_idx(ss, lane ^ 1); ss += shfl_idx(ss, lane ^ 2); ss += shfl_idx(ss, lane ^ 4); ss += shfl_idx(ss, lane ^ 8);
        float* prow = (float*)(ws + WS_PART + (size_t)pout * SZ_PART) + (MP + grow);
        if ((tid & 15) == 0) atomicAdd(prow, ss);
        if (fin_gain) {
            unsigned* cnt = (unsigned*)(ws + 40960) + 16 * rb;
            asm volatile("s_waitcnt vmcnt(0)" ::: "memory");
            __syncthreads();
            if (tid == 0) {
                __hip_atomic_fetch_add(cnt, 1u, __ATOMIC_RELAXED, __HIP_MEMORY_SCOPE_AGENT);
                for (unsigned spins = 0; spins < (1u << 22); ++spins) { if (__hip_atomic_load(cnt, __ATOMIC_RELAXED, __HIP_MEMORY_SCOPE_AGENT) >= 32u) break; __builtin_amdgcn_s_sleep(2); }
                __builtin_amdgcn_fence(__ATOMIC_ACQUIRE, "agent");
                asm volatile("s_waitcnt vmcnt(0)" ::: "memory");
            }
            __syncthreads();
            const float r = __builtin_amdgcn_rsqf(__hip_atomic_load(prow, __ATOMIC_RELAXED, __HIP_MEMORY_SCOPE_AGENT) * (1.0f / 1024.0f) + EPS);
            const f32x2_m g = *(const f32x2_m*)(fin_gain + col);
            *(f32x2_m*)(fin_out + (size_t)grow * DM + col) = xn * r * g;
        }
    }
    __syncthreads();
}

template <int ODD>
__device__ __forceinline__ void proj16_tiles(LAS unsigned char* lds, unsigned char* ws, float* out, const float* bias, int base  , int only_q0) {
    int tid_ = threadIdx.x; asm volatile("" : "+v"(tid_));
    const int tid = tid_, lane = tid & 63, wave = __builtin_amdgcn_readfirstlane(tid >> 6), r16 = lane & 15, kq = lane >> 4, q = wave & 3, kh = wave >> 2;
    const int tile = (only_q0 && q != 0) ? -1 : base + 256 * q;
    const bf16_t* XB = (const bf16_t*)(ws + WS_XB);
    const bf16_t* W16 = (const bf16_t*)(ws + WS_WIN + (ODD ? SZ_WIN : 0)) + (size_t)(ODD ? 3072 : 1536) * DM;
    const float* part = (const float*)(ws + WS_PART + (size_t)(ODD ? 4 : 1) * SZ_PART);
    LAS float* red = (LAS float*)lds;
    LAS float* art = red + 1024;
    LAS unsigned char* wsm = lds + 8192;
    LAS unsigned char* tsm = lds + 8192 + 16 * 2064;
    float pss = 0.f; bf16x8_t xa[16];
    if (tile >= 0) {
        pss = part[16 * tile + r16];
        const bf16_t* xp = XB + (size_t)(16 * tile + r16) * DM + 512 * kh + 8 * kq;
#pragma unroll
        for (int s = 0; s < 16; ++s) xa[s] = *(const bf16x8_t*)(xp + 32 * s);
    }
    {
        u32x4 wv[4], tv[2];
#pragma unroll
        for (int i = 0; i < 4; ++i) wv[i] = *(const u32x4*)(W16 + (size_t)(tid + 512 * i) * 8);
        if (!ODD) {
            const bf16_t* T = (const bf16_t*)(ws + WS_WIN) + (size_t)1600 * DM;
#pragma unroll
            for (int i = 0; i < 2; ++i) tv[i] = *(const u32x4*)(T + (size_t)(tid + 512 * i) * 8);
        }
#pragma unroll
        for (int i = 0; i < 4; ++i) { const int idx = tid + 512 * i; *(LAS u32x4*)(wsm + (idx >> 7) * 2064 + (idx & 127) * 16) = wv[i]; }
        if (!ODD) {
#pragma unroll
            for (int i = 0; i < 2; ++i) { const int idx = tid + 512 * i; *(LAS u32x4*)(tsm + (idx >> 2) * 80 + (idx & 3) * 16) = tv[i]; }
        }
    }
    __syncthreads();
    f32x4 acc = {0.f, 0.f, 0.f, 0.f};
    if (tile >= 0) {
        const LAS unsigned char* wl = wsm + r16 * 2064 + (512 * kh + 8 * kq) * 2;
#pragma unroll
        for (int s = 0; s < 16; ++s) acc = __builtin_amdgcn_mfma_f32_16x16x32_bf16(*(const LAS bf16x8_t*)(wl + 64 * s), xa[s], acc, 0, 0, 0);
        if (kh == 1) *(LAS f32x4*)(red + (q * 64 + lane) * 4) = acc;
    }
    __syncthreads();
    if (kh == 0 && tile >= 0) {
        acc += *(const LAS f32x4*)(red + (q * 64 + lane) * 4);
        const int row = 16 * tile + r16;
        const float rinv = __builtin_amdgcn_rsqf(pss * (1.0f / 1024.0f) + EPS);
        if (ODD) {
            const f32x4 bo = *(const f32x4*)(bias + 4 * kq);
            f32x4 o;
#pragma unroll
            for (int i = 0; i < 4; ++i) o[i] = pg8::logsigmoid_f(acc[i] * rinv + bo[i]);
            *(f32x4*)((float*)(ws + WS_LOGF) + (size_t)row * 16 + 4 * kq) = o;
            float* dst = (row < MP) ? out + O_PFL + (size_t)row * 16 + 4 * kq : out + O_SFL + (size_t)(row - MP) * 16 + 4 * kq;
            *(f32x4*)dst = o;
        } else {
            *(LAS f32x4*)(art + (q * 16 + r16) * 16 + 4 * kq) = acc * rinv;
        }
    }
    if (!ODD) {
        __syncthreads();
        if (tile >= 0) {
            f32x4 bv[8];
#pragma unroll
            for (int jj = 0; jj < 8; ++jj) bv[jj] = *(const f32x4*)(bias + 16 * (8 * kh + jj) + 4 * kq);
            u32x4 rw = {0u, 0u, 0u, 0u};
            if (kq < 2) { const LAS float* ar = art + (q * 16 + r16) * 16 + 8 * kq; const f32x4 a0 = *(const LAS f32x4*)ar, a1 = *(const LAS f32x4*)(ar + 4);
                          rw.x = pk2(a0[0], a0[1]); rw.y = pk2(a0[2], a0[3]); rw.z = pk2(a1[0], a1[1]); rw.w = pk2(a1[2], a1[3]); }
            const bf16x8_t rb = __builtin_bit_cast(bf16x8_t, rw);
            float* LG = (float*)(ws + WS_LOGA) + (size_t)(16 * tile + r16) * 256 + 4 * kq;
#pragma unroll
            for (int jj = 0; jj < 8; ++jj) {
                const bf16x8_t wf = *(const LAS bf16x8_t*)(tsm + (16 * (8 * kh + jj) + r16) * 80 + 16 * kq);
                const f32x4 d = __builtin_amdgcn_mfma_f32_16x16x32_bf16(wf, rb, (f32x4){0.f, 0.f, 0.f, 0.f}, 0, 0, 0);
                f32x4 o;
#pragma unroll
                for (int i = 0; i < 4; ++i) o[i] = pg8::logsigmoid_f(d[i] + bv[jj][i]) * (1.0f / 16.0f);
                *(f32x4*)(LG + 16 * (8 * kh + jj)) = o;
            }
        }
    }
    __syncthreads();
}
template <int ODD>
__device__ __forceinline__ void sample_in_unit(LAS unsigned char* lds, unsigned char* ws, float* out, int u) {
    int tid_ = threadIdx.x; asm volatile("" : "+v"(tid_));
    const int tid = tid_, lane = tid & 63, wave = __builtin_amdgcn_readfirstlane(tid >> 6), r32 = lane & 31, hi = lane >> 5;
    const int rb = u / 24, cb = u - 24 * rb;
    const int col0 = 128 * cb + ((!ODD && cb >= 12) ? 256 : 0);
    const bf16_t* ap = (const bf16_t*)(ws + WS_XB) + (size_t)(MP + 32 * rb + r32) * DM + wave * 128 + 8 * hi;
    const bf16_t* bp = (const bf16_t*)(ws + WS_WIN + (ODD ? SZ_WIN : 0)) + (size_t)(col0 + r32) * DM + wave * 128 + 8 * hi;
    f32x16_t acc[4] = {};
#pragma unroll 2
    for (int ks = 0; ks < 8; ++ks) {
        const bf16x8_t a = *(const bf16x8_t*)(ap + 16 * ks);
        bf16x8_t b[4];
#pragma unroll
        for (int j = 0; j < 4; ++j) b[j] = *(const bf16x8_t*)(bp + (size_t)32 * j * DM + 16 * ks);
#pragma unroll
        for (int j = 0; j < 4; ++j) acc[j] = __builtin_amdgcn_mfma_f32_32x32x16_bf16(a, b[j], acc[j], 0, 0, 0);
    }
    LAS float* red = (LAS float*)lds;
#pragma unroll
    for (int j = 0; j < 4; ++j)
#pragma unroll
        for (int r = 0; r < 16; ++r) red[(wave * 32 + crow_(r, hi)) * 128 + 32 * j + r32] = acc[j][r];
    __syncthreads();
    {
        const int row = tid >> 4, c8 = (tid & 15) * 8;
        f32x4 s0 = *(const LAS f32x4*)(red + row * 128 + c8), s1 = *(const LAS f32x4*)(red + row * 128 + c8 + 4);
#pragma unroll
        for (int w = 1; w < 8; ++w) { s0 += *(const LAS f32x4*)(red + (w * 32 + row) * 128 + c8); s1 += *(const LAS f32x4*)(red + (w * 32 + row) * 128 + c8 + 4); }
        const int srow = 32 * rb + row;
        const float* part = (const float*)(ws + WS_PART + (size_t)(ODD ? 4 : 1) * SZ_PART);
        float sc = 1.0f; bool silu = false; float* fo = nullptr; int fpitch = 0, fcol = 0;
        if (ODD) {
            if (col0 < 1024) sc = QSCALE2;
            else if (col0 < 2048) { fo = out + O_SFK; fpitch = 1024; fcol = col0 - 1024; }
            else { fo = out + O_SFV; fpitch = 1024; fcol = col0 - 2048; }
        } else {
            if (col0 < 256) sc = 0.125f;
            else if (col0 >= 1024 && col0 < 1536) silu = true;
            else if (col0 >= 1792 && col0 < 2304) sc = QSCALE2;
            else if (col0 >= 2304 && col0 < 2816) { fo = out + O_SBK; fpitch = 512; fcol = col0 - 2304; }
            else if (col0 >= 2816) { fo = out + O_SBV; fpitch = 512; fcol = col0 - 2816; }
        }
        const float r = __builtin_amdgcn_rsqf(part[MP + srow] * (1.0f / 1024.0f) + EPS) * sc;
        float v[8];
#pragma unroll
        for (int i = 0; i < 4; ++i) { v[i] = s0[i] * r; v[4 + i] = s1[i] * r; }
        if (silu) {
#pragma unroll
            for (int e = 0; e < 8; ++e) v[e] = pg8::silu_f(v[e]);
        }
        u32x4 w; w.x = pk2(v[0], v[1]); w.y = pk2(v[2], v[3]); w.z = pk2(v[4], v[5]); w.w = pk2(v[6], v[7]);
        *(u32x4*)((bf16_t*)(ws + WS_EB) + (size_t)(MP + srow) * NIN + col0 + c8) = w;
        if (fo) { float* dst = fo + (size_t)srow * fpitch + fcol + c8; *(f32x4*)dst = (f32x4){v[0], v[1], v[2], v[3]}; *(f32x4*)(dst + 4) = (f32x4){v[4], v[5], v[6], v[7]}; }
    }
    __syncthreads();
}

__device__ __forceinline__ void fox_f2(LAS float* F2, LAS float* tot, const float* LOGF, int b, int h, int tid) {
    const int lane = tid & 63, w = tid >> 6;
    float carry = 0.f;
    float lfv[4];
#pragma unroll
    for (int c = 0; c < 4; ++c) lfv[c] = LOGF[((size_t)b * TSEQ + 256 * w + 64 * c + lane) * 16 + h];
#pragma unroll
    for (int c = 0; c < 4; ++c) {
        const int t = 256 * w + 64 * c + lane;
        const float F = carry + scan_incl(lfv[c], lane);
        F2[t] = F; carry = lane_bcast(F, 63);
    }
    if (lane == 0) tot[w] = carry;
    __syncthreads();
    float off = 0.f;
    for (int w2 = 0; w2 < w; ++w2) off += tot[w2];
#pragma unroll
    for (int c = 0; c < 4; ++c) { const int t = 256 * w + 64 * c + lane; F2[t] = (F2[t] + off) * LOG2E; }
    __syncthreads();
}

#define XB_TMO      128
#define XB_XCNT(j)  (256  + 64 * (j))
#define XB_XSUB(j)  (1280 + 64 * (j))
#define XB_XGEN(j)  (2304 + 64 * (j))
#define XB_TOP      3328
#define XB_TOPGEN   3392
#define XCD_BAR_WORDS 3456
#define XB_SPIN_CAP (1u << 18)

__device__ __forceinline__ unsigned xb_ld(unsigned* p)              { return __hip_atomic_load(p, __ATOMIC_RELAXED, __HIP_MEMORY_SCOPE_AGENT); }
__device__ __forceinline__ unsigned xb_add(unsigned* p, unsigned v) { return __hip_atomic_fetch_add(p, v, __ATOMIC_RELAXED, __HIP_MEMORY_SCOPE_AGENT); }
__device__ __forceinline__ unsigned xb_xcc_id() { return (unsigned)__builtin_amdgcn_s_getreg((3 << 11) | 20) & 0xFu; }
#define XB_SPIN(cond, bar) do { unsigned _sp = 0; while (cond) { __builtin_amdgcn_s_sleep(1); \
    if ((++_sp & 255u) == 0u) { if (xb_ld(&(bar)[XB_TMO])) break; if (_sp > XB_SPIN_CAP) { atomicAdd(&(bar)[XB_TMO], 1u); break; } } } } while (0)

struct XcdBarrier {
    unsigned* bar; unsigned x;
    volatile LAS unsigned* st;
};

__device__ __forceinline__ XcdBarrier xcd_barrier_post(unsigned* bar, volatile LAS unsigned* st) {
    XcdBarrier b; b.bar = bar; b.x = xb_xcc_id(); b.st = st;
    if (threadIdx.x == 0) (void)xb_add(&bar[XB_XCNT(b.x)], 1u);
    return b;
}
__device__ __forceinline__ void xcd_barrier_complete(unsigned* bar, unsigned x, unsigned& nloc, unsigned& nx) {
    const unsigned G = gridDim.x * gridDim.y * gridDim.z;
    unsigned sum, cnt, mine, sp = 0u;
    for (;;) {
        sum = 0u; cnt = 0u; mine = 0u;
#pragma unroll
        for (unsigned j = 0; j < 16; ++j) { const unsigned c = xb_ld(&bar[XB_XCNT(j)]); sum += c; cnt += (c > 0u) ? 1u : 0u; mine = (j == x) ? c : mine; }
        if (sum == G) break;
        __builtin_amdgcn_s_sleep(1);
        if ((++sp & 255u) == 0u) { if (xb_ld(&bar[XB_TMO])) break; if (sp > XB_SPIN_CAP) { atomicAdd(&bar[XB_TMO], 1u); break; } }
    }
    nloc = mine > 0u ? mine : 1u; nx = cnt > 0u ? cnt : 1u;
}

__device__ __forceinline__ void xcd_barrier(const XcdBarrier& b) {
    asm volatile("s_waitcnt vmcnt(0)" ::: "memory");
    __syncthreads();
    if (threadIdx.x == 0) {
        unsigned* bar = b.bar;
        __builtin_amdgcn_s_waitcnt(0);
        unsigned nloc = b.st[0], nx = b.st[1];
        if (nloc == 0u) { xcd_barrier_complete(bar, b.x, nloc, nx); b.st[0] = nloc; b.st[1] = nx; }
        const unsigned old = xb_add(&bar[XB_XSUB(b.x)], 1u);
        const unsigned gen = old / nloc;
        if (old + 1u == (gen + 1u) * nloc) {
            __builtin_amdgcn_fence(__ATOMIC_RELEASE, "agent");
            asm volatile("s_waitcnt vmcnt(0)" ::: "memory");
            const unsigned og = xb_add(&bar[XB_TOP], 1u);
            const unsigned tg = og / nx;
            if (og + 1u == (tg + 1u) * nx) xb_add(&bar[XB_TOPGEN], 1u);
            else XB_SPIN(xb_ld(&bar[XB_TOPGEN]) == tg, bar);
            __builtin_amdgcn_fence(__ATOMIC_ACQUIRE, "agent");
            xb_add(&bar[XB_XGEN(b.x)], 1u);
            asm volatile("s_waitcnt vmcnt(0)" ::: "memory");
        } else {
            asm volatile("buffer_inv sc1" ::: "memory");
            XB_SPIN(xb_ld(&bar[XB_XGEN(b.x)]) == gen, bar);
            asm volatile("s_waitcnt vmcnt(0)" ::: "memory");
        }
    }
    __syncthreads();
}

constexpr int LDS_MISC = 131072 + 512;
__device__ __forceinline__ void grid_bar(unsigned char* ws, LAS unsigned char* lds) {
    XcdBarrier b; b.bar = (unsigned*)ws; b.x = xb_xcc_id(); b.st = (volatile LAS unsigned*)(lds + LDS_MISC);
    xcd_barrier(b);
}

#ifndef EN_MASK
#define EN_MASK 255
#endif

__global__ void __launch_bounds__(NWAVES * 64, 2) mega_fwd(Args args) {
    extern __shared__ __attribute__((aligned(16))) unsigned char lds_raw[];
    LAS unsigned char* lds = (LAS unsigned char*)lds_raw;
    cg::grid_group grid = cg::this_grid();
    const int ph_hi = ((const Args*)__builtin_amdgcn_kernarg_segment_ptr())->ph_hi;
    if (threadIdx.x < 32) ((LAS unsigned*)(lds + 131072))[threadIdx.x + 128] = 0u;
    __syncthreads();
    (void)xcd_barrier_post((unsigned*)((const Args*)__builtin_amdgcn_kernarg_segment_ptr())->ws, (volatile LAS unsigned*)(lds + LDS_MISC));
    for (int ph = ((const Args*)__builtin_amdgcn_kernarg_segment_ptr())->ph_lo; ph < ph_hi; ++ph) {
        unsigned zero; asm volatile("s_mov_b32 %0, 0" : "=s"(zero));
        const Args& A = *(const Args*)((const char*)__builtin_amdgcn_kernarg_segment_ptr() + zero);
        int tid = threadIdx.x; asm volatile("" : "+v"(tid));
        const int lane = tid & 63, wave = __builtin_amdgcn_readfirstlane(tid >> 6);
        int G = gridDim.x, bx = blockIdx.x; asm volatile("" : "+s"(G), "+s"(bx));
        const int gw = bx * NWAVES + wave, NGW = G * NWAVES;
        unsigned char* ws = A.ws; float* out = A.out;
        int kind, idx = 0;
        switch (ph) {
            case 0: kind = 0; break;
            case 1: kind = 1; idx = 0; break;  case 6: kind = 1; idx = 1; break;  case 8: kind = 1; idx = 2; break;  case 13: kind = 1; idx = 3; break;
            case 2: kind = 2; idx = 0; break;  case 7: kind = 2; idx = 1; break;  case 9: kind = 2; idx = 2; break;  case 14: kind = 2; idx = 3; break;
            case 3: kind = 3; break;  case 4: kind = 4; break;  case 5: kind = 5; idx = 0; break;
            case 10: kind = 6; break; case 11: kind = 7; break; case 12: kind = 5; idx = 1; break;
            default: kind = 8; break;
        }
        if (kind == 0 && (EN_MASK & 1)) {
            p0_prologue(A, lds, gw, NGW, wave, lane);
        } else if (kind == 1 && (EN_MASK & 2)) {
            const int pin = (idx == 0) ? 0 : (idx == 1) ? 2 : (idx == 2) ? 3 : 5;
            pg8::Gemm g{(const bf16_t*)(ws + WS_XB), (const bf16_t*)(ws + WS_WGU + idx * SZ_WGU), MT, 2 * FF, DM}; pg8::StaticOrder S; S.init(MT, 2 * FF, G, bx);
            pg8::EpiGU E{ws, pin, lds};
            pg8::gemm_phase<pg8::EpiGU, pg8::StaticOrder, true, true>(lds, g, S, E);
            { constexpr int NU = (MT / 256) * (2 * FF / 256); const int first_idle = NU % G;
              const int job = (idx == 0) ? 1 : (idx == 1) ? 3 : (idx == 2) ? 4 : 5;
              if (job >= 0 && bx >= first_idle) { int t5 = threadIdx.x; asm volatile("" : "+v"(t5)); convert_job(A, lds, job, (bx - first_idle) * NWAVES + __builtin_amdgcn_readfirstlane(t5 >> 6), (G - first_idle) * NWAVES, __builtin_amdgcn_readfirstlane(t5 >> 6), t5 & 63); } }
        } else if ((kind == 2 || kind == 5) && (EN_MASK & 4)) {
            const bool dn = kind == 2;
            const int pout = dn ? ((idx == 0) ? 1 : (idx == 1) ? 3 : (idx == 2) ? 4 : 6) : ((idx == 0) ? 2 : 5);
            const bool first = dn && idx == 0;
            const bf16_t* Ap = (const bf16_t*)(dn ? ws + WS_H : ws + WS_OAB); const bf16_t* Btp = (const bf16_t*)(dn ? ws + WS_WDN + idx * SZ_WDN : ws + WS_WOUT + idx * SZ_WOUT);
            const int Kd = dn ? FF : DM;
            { const int vcu = (G % 8 == 0) ? (bx % 8) * (G / 8) + bx / 8 : bx;
              const bool fin = dn && idx == 3 && G == 256;
              for (int u = vcu; u < 256; u += G) mini_gemm_unit(lds, Ap + (size_t)MP * Kd, Btp, Kd, u >> 5, u & 31, nullptr, ws, pout, dn ? 0.5f : 1.0f, fin ? A.in[20] : nullptr, out + O_YS); }
            pg8::Gemm g{Ap, Btp, MP, DM, Kd}; pg8::StaticOrder S; S.init(MP, DM, G, bx);
            if (dn && idx == 3 && G == 256) {
                pg8::EpiFinal E{ws, out + O_YP, A.in[20], 0.5f};
                pg8::gemm_phase<pg8::EpiFinal, pg8::StaticOrder, true, true>(lds, g, S, E);
            } else {
                pg8::EpiRes E{ws, pout, dn ? 0.5f : 1.0f};
                pg8::gemm_phase<pg8::EpiRes, pg8::StaticOrder, true, true>(lds, g, S, E);
            }
        } else if ((kind == 3 || kind == 6) && (EN_MASK & 8)) {
            const bool odd = kind == 6;
            for (int base = bx; base < 256; base += G) { if (odd) proj16_tiles<1>(lds, ws, out, A.in[18], base, 0); else proj16_tiles<0>(lds, ws, out, A.in[13], base, 0); }
            for (int u = bx; u < 208; u += G) {
                if (u < 192) { if (odd) sample_in_unit<1>(lds, ws, out, u); else sample_in_unit<0>(lds, ws, out, u); }
                else { if (odd) proj16_tiles<1>(lds, ws, out, A.in[18], 1024 + (u - 192), 1); else proj16_tiles<0>(lds, ws, out, A.in[13], 1024 + (u - 192), 1); }
            }
            pg8::Gemm g{(const bf16_t*)(ws + WS_XB), (const bf16_t*)(ws + WS_WIN + (odd ? SZ_WIN : 0)), MP, 3072, DM}; pg8::StaticOrder S; S.init(MP, 3072, G, bx, odd ? 1 : 2);
            if (odd) { pg8::EpiInOdd E{ws, out, lds}; pg8::gemm_phase<pg8::EpiInOdd, pg8::StaticOrder, true, true>(lds, g, S, E); }
            else     { pg8::EpiInEven E{ws, out, lds}; pg8::gemm_phase<pg8::EpiInEven, pg8::StaticOrder, true, true>(lds, g, S, E); }
        } else if (kind == 4 && (EN_MASK & 32)) {
            const bf16_t* EB = (const bf16_t*)(ws + WS_EB); bf16_t* OAB = (bf16_t*)(ws + WS_OAB); const float* LOGA = (const float*)(ws + WS_LOGA);
            float* GU = (float*)(ws + WS_GU); float* GA = (float*)(ws + WS_GA);
            const int vcu = (G % 8 == 0) ? (bx % 8) * (G / 8) + bx / 8 : bx;
            unsigned* gflag = (unsigned*)(ws + 49152);
            for (int id = vcu; id < 256; id += G) {
                gla_m1_group(lds, EB, LOGA, id >> 3, id & 7, (bf16_t*)(ws + WS_QIN), (bf16_t*)(ws + WS_KIN), GU, GA, (float*)(ws + WS_GT), (float*)(ws + WS_GAG));
                asm volatile("s_waitcnt vmcnt(0)" ::: "memory");
                __syncthreads();
                { int t7 = threadIdx.x; asm volatile("" : "+v"(t7));
                  if (t7 == 0) __hip_atomic_store(gflag + id, 1u, __ATOMIC_RELAXED, __HIP_MEMORY_SCOPE_AGENT); }
            }
            if (G == 256 && (vcu & 3) < 2) { const int w = vcu >> 2, b = w >> 2, h = w & 3;
                if ((vcu & 3) == 0) gla_u_unit<16>(lds, EB, LOGA, (size_t)MP + b * SSEQ, h, nullptr, nullptr, A.in[2] + (size_t)w * 8192, out + O_SSG + (size_t)w * 8192);
                else gla_o_unit<16>(lds, EB, LOGA, (size_t)MP + b * SSEQ, h, 0, nullptr, nullptr, A.in[2] + (size_t)w * 8192, A.in[14], OAB, nullptr);
            } else if (G != 256) {
                for (int w = vcu; w < 64; w += G) { const int b = w >> 2, h = w & 3;
                    gla_u_unit<16>(lds, EB, LOGA, (size_t)MP + b * SSEQ, h, nullptr, nullptr, A.in[2] + (size_t)w * 8192, out + O_SSG + (size_t)w * 8192);
                    gla_o_unit<16>(lds, EB, LOGA, (size_t)MP + b * SSEQ, h, 0, nullptr, nullptr, A.in[2] + (size_t)w * 8192, A.in[14], OAB, nullptr); }
            }
            {
                LAS float* tab = (LAS float*)(lds + 86016);
                const attn_body::bf16* Qp = (const attn_body::bf16*)EB;
                for (int pr = vcu; pr < 4 * NBATCH * 8; pr += G) {
                    const int bh = pr >> 2, pidx = pr & 3, b = bh >> 3, h = bh & 7;
                    { int tid4 = threadIdx.x; asm volatile("" : "+v"(tid4));
                      for (int x = tid4; x < 320; x += NWAVES * 64) tab[x] = A.in[15][h * 257 + (x < 256 ? x : 256)] * LOG2E;
                      __syncthreads(); }
                    for (int i = 0; i < 2; ++i) {
                        const int qb = (pidx == 0) ? (i == 0 ? 2 : 0) : (pidx == 1) ? (i == 0 ? 3 : 1) : (pidx == 2) ? 4 + i : 6 + i;
                        attn_body::attn_unit<8, 1>(b, h, qb, Qp + 1792, Qp + 2304, Qp + 2816, (attn_body::bf16*)OAB + 512, (char*)lds_raw, tab);
                    }
                }
            }
            for (int u = vcu; u < SBATCH * 8; u += G) { const int b = u >> 3, h = u & 7;
                sample_attn_unit<1>(lds, EB, 1792, 2304, 2816, A.in[3] + ((size_t)b * 512 * 8 + h) * 64, A.in[4] + ((size_t)b * 512 * 8 + h) * 64, 512, 512, b, h, nullptr, nullptr, A.in[15], OAB, 512); }
            for (int id = vcu; id < 256; id += G) { const int bh = id >> 3, g4 = id & 7;
                { int t8 = threadIdx.x; asm volatile("" : "+v"(t8));
                  if (t8 == 0) {
                      for (int g = 0; g < g4; ++g)
                          for (unsigned spins = 0; spins < (1u << 22); ++spins) { if (__hip_atomic_load(gflag + bh * 8 + g, __ATOMIC_RELAXED, __HIP_MEMORY_SCOPE_AGENT) != 0u) break; __builtin_amdgcn_s_sleep(2); }
                      __builtin_amdgcn_fence(__ATOMIC_ACQUIRE, "agent"); asm volatile("s_waitcnt vmcnt(0)" ::: "memory");
                  } }
                __syncthreads();
                gla_m2_group(lds, EB, bh, g4, (const bf16_t*)(ws + WS_QIN), (const bf16_t*)(ws + WS_KIN), GU, GA, (const float*)(ws + WS_GT), (const float*)(ws + WS_GAG), A.in[14], OAB, (g4 == 7) ? out + O_PSG + (size_t)bh * 8192 : nullptr); }
        } else if (kind == 7 && (EN_MASK & 64)) {
            const bf16_t* EB = (const bf16_t*)(ws + WS_EB); bf16_t* OAB = (bf16_t*)(ws + WS_OAB); const float* LOGF = (const float*)(ws + WS_LOGF);
            const int vcu = (G % 8 == 0) ? (bx % 8) * (G / 8) + bx / 8 : bx;
            LAS float* F2 = (LAS float*)(lds + 86016); LAS float* tot = (LAS float*)(lds + 86016 + 8192);
            const attn_body::bf16* Qp = (const attn_body::bf16*)EB;
            for (int pr = vcu; pr < 2 * NBATCH * 16; pr += G) {
                const int p = pr >> 1, e = pr & 1;
                if (e == 0) {
                    for (int u = 2 * p; u < 2 * p + 2; ++u) { const int b = u >> 4, h = u & 15;
                        sample_attn_unit<0>(lds, EB, 0, 1024, 2048, A.in[5] + ((size_t)b * PAST * 16 + h) * 64, A.in[6] + ((size_t)b * PAST * 16 + h) * 64, 1024, PAST, b, h, A.in[7] + (size_t)b * PAST * 16, LOGF, nullptr, OAB, 0); }
                }
                const int b = p >> 4, h = p & 15;
                { int tid3 = threadIdx.x; asm volatile("" : "+v"(tid3)); fox_f2(F2, tot, LOGF, b, h, tid3); }
                unsigned* cnt = (unsigned*)(ws + 16384) + 16 * p; LAS unsigned* slot = (LAS unsigned*)(lds + 86016 + 8192 + 64);
                for (;;) {
                    { int t6 = threadIdx.x; asm volatile("" : "+v"(t6)); if (t6 == 0) *slot = atomicAdd(cnt, 1u); }
                    __syncthreads();
                    const unsigned idxq = (unsigned)__builtin_amdgcn_readfirstlane((int)*slot);
                    __syncthreads();
                    if (idxq >= 8u) break;
                    attn_body::attn_unit<8, 0>(b, h, 7 - (int)idxq, Qp, Qp + 1024, Qp + 2048, (attn_body::bf16*)OAB, (char*)lds_raw, F2);
                }
            }
        } else if (kind == 8 && (EN_MASK & 128)) {
            if (G != 256) final_norm(A, gw, NGW, lane);
        }
        if (ph + 1 < ph_hi) { if (ph_hi > 4096) grid.sync(); else grid_bar(ws, lds); }
    }
}

#ifndef N_LAUNCHES
#define N_LAUNCHES 1
#endif
constexpr int NPHASES = 16;
extern "C" void kernel_launch(void* const* d_in, const int* in_sizes, int n_in, void* d_out, int out_size, void* d_ws, size_t ws_size, hipStream_t stream) {
    static int grid = 0;
    if (grid == 0) {
        if (n_in != 21 || (size_t)out_size != O_END || ws_size < WS_END) { fprintf(stderr, "kernel_launch: unexpected problem: n_in %d out %d (want %zu) ws %zu (want >= %zu)\n", n_in, out_size, (size_t)O_END, ws_size, (size_t)WS_END); grid = -1; return; }
        int dev = 0, cus = 0, per_cu = 0;
        if (hipGetDevice(&dev) != hipSuccess || hipDeviceGetAttribute(&cus, hipDeviceAttributeMultiprocessorCount, dev) != hipSuccess) { grid = -1; return; }
        if (hipFuncSetAttribute((const void*)mega_fwd, hipFuncAttributeMaxDynamicSharedMemorySize, LDS_BYTES) != hipSuccess) { fprintf(stderr, "kernel_launch: hipFuncSetAttribute failed\n"); grid = -1; return; }
        if (hipOccupancyMaxActiveBlocksPerMultiprocessor(&per_cu, (const void*)mega_fwd, NWAVES * 64, LDS_BYTES) != hipSuccess || per_cu < 1) { fprintf(stderr, "kernel_launch: occupancy query says %d\n", per_cu); per_cu = 1; }
        (void)hipGetLastError();
        if (per_cu > 1) per_cu = 1;
        grid = cus * per_cu;
        fprintf(stderr, "kernel_launch: grid %d\n", grid);
    }
    if (grid < 0) return;
    if (hipMemsetAsync(d_ws, 0, 65536, stream) != hipSuccess) { fprintf(stderr, "kernel_launch: hipMemsetAsync failed\n"); return; }
    Args a{};
    for (int i = 0; i < 21; ++i) a.in[i] = (const float*)d_in[i];
    a.out = (float*)d_out; a.ws = (unsigned char*)d_ws;
    if (N_LAUNCHES == 1) {
        a.ph_lo = 0; a.ph_hi = (grid == 256) ? NPHASES - 1 : NPHASES;
        void* kargs[] = {&a};
        hipError_t e = hipLaunchCooperativeKernel((const void*)mega_fwd, dim3(grid), dim3(NWAVES * 64), kargs, LDS_BYTES, stream);
        if (e != hipSuccess) fprintf(stderr, "kernel_launch: cooperative launch failed: %s (grid %d)\n", hipGetErrorString(e), grid);
    } else {
        for (int p = 0; p < NPHASES; ++p) { a.ph_lo = p; a.ph_hi = p + 1; hipLaunchKernelGGL(mega_fwd, dim3(grid), dim3(NWAVES * 64), LDS_BYTES, stream, a); }
    }
}
```
